# Optimizing an MI355X kernel written in HIP

```python
import math
import jax, jax.numpy as jnp
from jax import lax
import numpy as np

D_MODEL = 1024
BATCH = 8
SEQ = 2048
DEPTH = 1
DEC_BATCH = 16
DEC_SEQ = 32
PAST_LEN = 2048

CHUNK = 64
Q_BLOCK = 128
DA_HEADS = 8
DA_HD = 64
DA_V = 2 * DA_HD
LRU_W = D_MODEL
LRU_BLOCKS = 8
LRU_BW = LRU_W // LRU_BLOCKS
CONV_W = 4
LRU_C = 8.0
XA_HEADS = 4
XA_HD = 256
N_MEM = 256
N_BUCKETS = 32
MAX_DISTANCE = 128
D_FF = ((8 * D_MODEL + 3 * 256 - 1) // (3 * 256)) * 256
N_BRANCH = 3
EPS = 1e-6
DA_QK_W = DA_HEADS * 2 * DA_HD
DA_V_W = DA_HEADS * DA_V
XA_W = XA_HEADS * XA_HD
IN_SPLITS = (DA_QK_W, 2 * DA_QK_W, 2 * DA_QK_W + DA_V_W, 2 * DA_QK_W + DA_V_W + LRU_W, 2 * DA_QK_W + DA_V_W + 2 * LRU_W)
IN_W = 2 * DA_QK_W + DA_V_W + 2 * LRU_W + XA_W

kernel_name = "hybrid_diffattn_rglru_streaming_step"


def rms_norm(x, g):
    x32 = x.astype(jnp.float32)
    y = x32 * lax.rsqrt(jnp.mean(x32 * x32, axis=-1, keepdims=True) + EPS)
    return (y * g.astype(jnp.float32)).astype(x.dtype)


def rel_bucket(rel):
    half = N_BUCKETS // 2
    max_exact = half // 2
    n = jnp.abs(rel)
    nf = jnp.maximum(n, 1).astype(jnp.float32)
    large = max_exact + (jnp.log(nf / max_exact) / math.log(MAX_DISTANCE / max_exact) * (half - max_exact)).astype(jnp.int32)
    large = jnp.minimum(large, half - 1)
    return jnp.where(rel > 0, half, 0) + jnp.where(n < max_exact, n, large)


def rel_bias(q_pos, k_pos, rel_table):
    b = rel_bucket(k_pos[None, :] - q_pos[:, None])
    return jnp.moveaxis(rel_table[b], -1, 0).astype(jnp.float32)


def diff_attention(q, k, v, q_pos, k_pos, rel_table, lam, subln_g, lambda_init):
    logits = jnp.einsum("bqhcd,bkhcd->bhcqk", q, k).astype(jnp.float32) * (DA_HD ** -0.5)
    logits = logits + rel_bias(q_pos, k_pos, rel_table)[None, :, None]
    visible = (k_pos[None, :] // CHUNK) <= (q_pos[:, None] // CHUNK)
    logits = jnp.where(visible, logits, -1e30)
    p = jax.nn.softmax(logits, axis=-1)
    w = p[:, :, 0] - lam * p[:, :, 1]
    out = jnp.einsum("bhqk,bkhe->bqhe", w.astype(v.dtype), v)
    return rms_norm(out, subln_g) * (1.0 - lambda_init)


def blocked_queries(attend, q, q_pos):
    B, S = q.shape[:2]
    nb = S // Q_BLOCK
    qb = jnp.moveaxis(q.reshape((B, nb, Q_BLOCK) + q.shape[2:]), 1, 0)
    pb = q_pos.reshape(nb, Q_BLOCK)
    out = lax.map(lambda a: attend(a[0], a[1]), (qb, pb))
    return jnp.moveaxis(out, 0, 1).reshape((B, S) + out.shape[3:])


def lru_combine(left, right):
    a_l, b_l = left
    a_r, b_r = right
    return a_l * a_r, a_r * b_l + b_r


def rglru_branch(xb, gb, conv_state, h0, conv_w, conv_b, w_rg_a, b_rg_a, w_rg_x, b_rg_x, rg_lambda):
    B, S, _ = xb.shape
    xpad = jnp.concatenate([conv_state.astype(xb.dtype), xb], axis=1)
    xc = conv_b + sum(xpad[:, j:j + S] * conv_w[j] for j in range(CONV_W))
    new_conv = xpad[:, -(CONV_W - 1):]
    xh = xc.reshape(B, S, LRU_BLOCKS, LRU_BW)
    r = jax.nn.sigmoid((jnp.einsum("bsni,nij->bsnj", xh, w_rg_a).reshape(B, S, LRU_W) + b_rg_a).astype(jnp.float32))
    i = jax.nn.sigmoid((jnp.einsum("bsni,nij->bsnj", xh, w_rg_x).reshape(B, S, LRU_W) + b_rg_x).astype(jnp.float32))
    log_a = -LRU_C * r * jax.nn.softplus(-rg_lambda.astype(jnp.float32))
    a = jnp.exp(log_a)
    mult = jnp.sqrt(-jnp.expm1(2.0 * log_a))
    u = mult * (i * xc.astype(jnp.float32))
    u = u.at[:, 0].add(a[:, 0] * h0.astype(jnp.float32))
    _, h = lax.associative_scan(lru_combine, (a, u), axis=1)
    out = h.astype(xb.dtype) * jax.nn.gelu(gb)
    return out, new_conv, h[:, -1]


def memory_kv(mem, g, w_mem_kv):
    B, M, _ = mem.shape
    kv = (rms_norm(mem, g) @ w_mem_kv).reshape(B, M, 2, XA_HEADS, XA_HD)
    return kv[:, :, 0], kv[:, :, 1]


def cross_attention(q, mem_k, mem_v):
    logits = jnp.einsum("bqhd,bmhd->bhqm", q, mem_k).astype(jnp.float32) * (XA_HD ** -0.5)
    p = jax.nn.softmax(logits, axis=-1)
    return jnp.einsum("bhqm,bmhd->bqhd", p.astype(mem_v.dtype), mem_v)


def layer_forward(x, pos, past_k, past_v, past_pos, conv_state, h0, mem_k, mem_v, rel_table, lp, lambda_init):
    B, S, _ = x.shape
    h = rms_norm(x, lp["norm_mix"])
    q, k, v, xb, gb, qc = jnp.split(h @ lp["w_in"], IN_SPLITS, axis=-1)
    q = q.reshape(B, S, DA_HEADS, 2, DA_HD)
    k = k.reshape(B, S, DA_HEADS, 2, DA_HD)
    v = v.reshape(B, S, DA_HEADS, DA_V)
    if past_k is None:
        k_all, v_all, k_pos = k, v, pos
    else:
        k_all = jnp.concatenate([past_k.astype(k.dtype), k], axis=1)
        v_all = jnp.concatenate([past_v.astype(v.dtype), v], axis=1)
        k_pos = jnp.concatenate([past_pos, pos])
    lam = (jnp.exp(jnp.sum(lp["lambda_q1"] * lp["lambda_k1"]).astype(jnp.float32))
           - jnp.exp(jnp.sum(lp["lambda_q2"] * lp["lambda_k2"]).astype(jnp.float32)) + lambda_init)

    def attend(qq, pp):
        return diff_attention(qq, k_all, v_all, pp, k_pos, rel_table, lam, lp["subln_g"], lambda_init)

    if S > Q_BLOCK:
        a_out = blocked_queries(attend, q, pos)
    else:
        a_out = attend(q, pos)
    if conv_state is None:
        conv_state = jnp.zeros((B, CONV_W - 1, LRU_W), xb.dtype)
        h0 = jnp.zeros((B, LRU_W), jnp.float32)
    b_out, new_conv, h_last = rglru_branch(xb, gb, conv_state, h0, lp["conv_w"], lp["conv_b"], lp["w_rg_a"],
                                           lp["b_rg_a"], lp["w_rg_x"], lp["b_rg_x"], lp["rg_lambda"])
    c_out = cross_attention(qc.reshape(B, S, XA_HEADS, XA_HD), mem_k.astype(x.dtype), mem_v.astype(x.dtype))
    ya = a_out.reshape(B, S, DA_V_W) @ lp["w_proj_a"]
    yb = b_out @ lp["w_proj_b"]
    yc = c_out.reshape(B, S, XA_W) @ lp["w_proj_c"]
    gates = jax.nn.sigmoid((h @ lp["w_gate"] + lp["b_gate"]).astype(jnp.float32)).astype(x.dtype)
    gates = gates.reshape(B, S, N_BRANCH, D_MODEL)
    merged = gates[:, :, 0] * ya + gates[:, :, 1] * yb + gates[:, :, 2] * yc
    x = x + merged @ lp["w_out"]
    h2 = rms_norm(x, lp["norm_ffn"])
    g_ff, u_ff = jnp.split(h2 @ lp["w_ffn_in"], 2, axis=-1)
    x = x + (jax.nn.silu(g_ff) * u_ff) @ lp["w_ffn_out"]
    return x, k, v, new_conv, h_last


def setup_inputs(seed: int = 0) -> dict:
    key = jax.random.key(seed)
    ks = jax.random.split(key, 40)
    f32 = jnp.float32
    nrm = lambda i, shape, s: jax.random.normal(ks[i], shape, f32) * s
    gain = lambda i, shape: 1.0 + 0.05 * jax.random.normal(ks[i], shape, f32)
    u = jax.random.uniform(ks[39], (DEPTH, LRU_W), f32, 0.9, 0.999)
    s = u ** (1.0 / LRU_C)
    return {
        "x_prompt": nrm(0, (BATCH, SEQ, D_MODEL), 1.0),
        "x_sample": nrm(1, (DEC_BATCH, DEC_SEQ, D_MODEL), 1.0),
        "mem_prompt": nrm(2, (BATCH, N_MEM, D_MODEL), 1.0),
        "cache_k": nrm(3, (DEPTH, DEC_BATCH, PAST_LEN, DA_HEADS, 2, DA_HD), 1.0),
        "cache_v": nrm(4, (DEPTH, DEC_BATCH, PAST_LEN, DA_HEADS, DA_V), 1.0),
        "state_conv": nrm(5, (DEPTH, DEC_BATCH, CONV_W - 1, LRU_W), 1.0),
        "state_lru": nrm(6, (DEPTH, DEC_BATCH, LRU_W), 0.5),
        "cache_mem_k": nrm(7, (DEPTH, DEC_BATCH, N_MEM, XA_HEADS, XA_HD), 1.0),
        "cache_mem_v": nrm(8, (DEPTH, DEC_BATCH, N_MEM, XA_HEADS, XA_HD), 1.0),
        "rel_table": nrm(9, (N_BUCKETS, DA_HEADS), 0.5),
        "norm_mix": gain(10, (DEPTH, D_MODEL)),
        "w_in": nrm(11, (DEPTH, D_MODEL, IN_W), D_MODEL ** -0.5),
        "lambda_q1": nrm(12, (DEPTH, DA_HD), 0.1),
        "lambda_k1": nrm(13, (DEPTH, DA_HD), 0.1),
        "lambda_q2": nrm(14, (DEPTH, DA_HD), 0.1),
        "lambda_k2": nrm(15, (DEPTH, DA_HD), 0.1),
        "subln_g": gain(16, (DEPTH, DA_V)),
        "conv_w": nrm(17, (DEPTH, CONV_W, LRU_W), CONV_W ** -0.5),
        "conv_b": nrm(18, (DEPTH, LRU_W), 0.01),
        "w_rg_a": nrm(19, (DEPTH, LRU_BLOCKS, LRU_BW, LRU_BW), LRU_BW ** -0.5),
        "b_rg_a": nrm(20, (DEPTH, LRU_W), 0.01),
        "w_rg_x": nrm(21, (DEPTH, LRU_BLOCKS, LRU_BW, LRU_BW), LRU_BW ** -0.5),
        "b_rg_x": nrm(22, (DEPTH, LRU_W), 0.01),
        "rg_lambda": jnp.log(s / (1.0 - s)),
        "norm_mem": gain(23, (DEPTH, D_MODEL)),
        "w_mem_kv": nrm(24, (DEPTH, D_MODEL, 2 * XA_W), D_MODEL ** -0.5),
        "w_proj_a": nrm(25, (DEPTH, DA_V_W, D_MODEL), DA_V_W ** -0.5),
        "w_proj_b": nrm(26, (DEPTH, LRU_W, D_MODEL), LRU_W ** -0.5),
        "w_proj_c": nrm(27, (DEPTH, XA_W, D_MODEL), XA_W ** -0.5),
        "w_gate": nrm(28, (DEPTH, D_MODEL, N_BRANCH * D_MODEL), D_MODEL ** -0.5),
        "b_gate": nrm(29, (DEPTH, N_BRANCH * D_MODEL), 0.01),
        "w_out": nrm(30, (DEPTH, D_MODEL, D_MODEL), D_MODEL ** -0.5),
        "norm_ffn": gain(31, (DEPTH, D_MODEL)),
        "w_ffn_in": nrm(32, (DEPTH, D_MODEL, 2 * D_FF), D_MODEL ** -0.5),
        "w_ffn_out": nrm(33, (DEPTH, D_FF, D_MODEL), D_FF ** -0.5),
        "norm_final": gain(34, (D_MODEL,)),
    }


def reference(x_prompt, x_sample, mem_prompt, cache_k, cache_v, state_conv, state_lru, cache_mem_k, cache_mem_v,
              rel_table, norm_mix, w_in, lambda_q1, lambda_k1, lambda_q2, lambda_k2, subln_g, conv_w, conv_b,
              w_rg_a, b_rg_a, w_rg_x, b_rg_x, rg_lambda, norm_mem, w_mem_kv, w_proj_a, w_proj_b, w_proj_c,
              w_gate, b_gate, w_out, norm_ffn, w_ffn_in, w_ffn_out, norm_final):
    past_len = cache_k.shape[2]
    pos_p = jnp.arange(x_prompt.shape[1], dtype=jnp.int32)
    past_pos = jnp.arange(past_len, dtype=jnp.int32)
    pos_s = past_len + jnp.arange(x_sample.shape[1], dtype=jnp.int32)
    xp, xs = x_prompt, x_sample
    kp_l, vp_l, cp_l, hp_l, mkp_l, mvp_l = [], [], [], [], [], []
    ks_l, vs_l, cs_l, hs_l = [], [], [], []
    for l in range(DEPTH):
        lambda_init = 0.8 - 0.6 * math.exp(-0.3 * l)
        lp = dict(norm_mix=norm_mix[l], w_in=w_in[l], lambda_q1=lambda_q1[l], lambda_k1=lambda_k1[l],
                  lambda_q2=lambda_q2[l], lambda_k2=lambda_k2[l], subln_g=subln_g[l], conv_w=conv_w[l],
                  conv_b=conv_b[l], w_rg_a=w_rg_a[l], b_rg_a=b_rg_a[l], w_rg_x=w_rg_x[l], b_rg_x=b_rg_x[l],
                  rg_lambda=rg_lambda[l], w_proj_a=w_proj_a[l], w_proj_b=w_proj_b[l], w_proj_c=w_proj_c[l],
                  w_gate=w_gate[l], b_gate=b_gate[l], w_out=w_out[l], norm_ffn=norm_ffn[l],
                  w_ffn_in=w_ffn_in[l], w_ffn_out=w_ffn_out[l])
        mk, mv = memory_kv(mem_prompt, norm_mem[l], w_mem_kv[l])
        xp, kp, vp, cp, hp = layer_forward(xp, pos_p, None, None, None, None, None, mk, mv, rel_table, lp, lambda_init)
        kp_l.append(kp); vp_l.append(vp); cp_l.append(cp); hp_l.append(hp); mkp_l.append(mk); mvp_l.append(mv)
        xs, ks_, vs_, cs_, hs_ = layer_forward(xs, pos_s, cache_k[l], cache_v[l], past_pos, state_conv[l],
                                               state_lru[l], cache_mem_k[l], cache_mem_v[l], rel_table, lp, lambda_init)
        ks_l.append(ks_); vs_l.append(vs_); cs_l.append(cs_); hs_l.append(hs_)
    y_prompt = rms_norm(xp, norm_final)
    y_sample = rms_norm(xs, norm_final)
    return (y_prompt, y_sample,
            jnp.stack(kp_l), jnp.stack(vp_l), jnp.stack(cp_l), jnp.stack(hp_l), jnp.stack(mkp_l), jnp.stack(mvp_l),
            jnp.stack(ks_l), jnp.stack(vs_l), jnp.stack(cs_l), jnp.stack(hs_l))
```

```cpp
#include <hip/hip_runtime.h>
#include <cstdio>
#include <cstdint>

#ifndef MK_N_LAUNCHES
#define MK_N_LAUNCHES 1
#endif

#define LAS __attribute__((address_space(3)))
#define GAS __attribute__((address_space(1)))
typedef unsigned short bf16_t;
typedef short bf16x8 __attribute__((ext_vector_type(8)));
typedef short s16x4 __attribute__((ext_vector_type(4)));
typedef float f32x2 __attribute__((ext_vector_type(2)));
typedef float f32x4 __attribute__((ext_vector_type(4)));
typedef float f32x16 __attribute__((ext_vector_type(16)));
typedef unsigned u32x2 __attribute__((ext_vector_type(2)));
typedef unsigned u32x4 __attribute__((ext_vector_type(4)));
typedef __bf16 bf16x2_t __attribute__((ext_vector_type(2)));

constexpr int DM = 1024, TP = 16384, TS = 512, TT = TP + TS, TMEM = 2048, TALL = TT + TMEM;
constexpr int SEQ = 2048, NBATCH = 8, DSEQ = 32, DBATCH = 16, PAST = 2048;
constexpr int INW = 6144, GATEW = 3072, DFF = 2816;
constexpr float EPS = 1e-6f;
constexpr float LOG2E = 1.4426950408889634f;
constexpr float QSCALE = 0.125f * LOG2E;
constexpr float CSCALE = 0.0625f * LOG2E;
constexpr float LAMBDA_INIT = 0.2f;

constexpr size_t O_YP = 0, O_YS = 16777216, O_KP = 17301504, O_VP = 34078720, O_CP = 50855936, O_HP = 50880512,
                 O_MKP = 50888704, O_MVP = 52985856, O_KS = 55083008, O_VS = 55607296, O_CS = 56131584, O_HS = 56180736, O_END = 56197120;

constexpr size_t MiB = 1u << 20;
constexpr size_t WS_CTL = 0, CTL_ZERO_BYTES = 1 * MiB;
constexpr size_t WS_WCAT = 1 * MiB;
constexpr size_t WS_WP = 23 * MiB;
constexpr size_t WS_WO = 29 * MiB;
constexpr size_t WS_WFI = 31 * MiB;
constexpr size_t WS_WFO = 42 * MiB;
constexpr size_t WS_WRG = 47 * MiB + 512 * 1024;
constexpr size_t WS_XN = 48 * MiB;
constexpr size_t WS_MK = 85 * MiB, WS_MV = 89 * MiB;
constexpr size_t WS_Q = 93 * MiB, WS_K = 126 * MiB, WS_V = 159 * MiB, WS_XB = 192 * MiB, WS_GG = 225 * MiB, WS_QC = 258 * MiB;
constexpr size_t WS_G = 291 * MiB;
constexpr size_t WS_AO = 390 * MiB, WS_BO = 423 * MiB, WS_CO = 456 * MiB;
constexpr size_t WS_MG = 48 * MiB;
constexpr size_t WS_X1B = 291 * MiB;
constexpr size_t WS_X1 = 192 * MiB;
constexpr size_t WS_ACT = 93 * MiB;
constexpr size_t WS_SS = 489 * MiB;
constexpr size_t WS_END = 491 * MiB;
constexpr int CW_BAR = 4096, CW_QUEUE = 16384;

constexpr int RING_BYTES = 131072, EXTRA_OFF = RING_BYTES, MISC_OFF = EXTRA_OFF + 320, LAM_OFF = EXTRA_OFF + 512, LUT_OFF = EXTRA_OFF + 1024;
constexpr int LDS_BYTES = 147456;
constexpr int NWAVES = 8;

__device__ __forceinline__ unsigned pk_bf16(float lo, float hi) { f32x2 v = {lo, hi}; bf16x2_t b = __builtin_convertvector(v, bf16x2_t); return __builtin_bit_cast(unsigned, b); }
__device__ __forceinline__ float bf_lo(unsigned u) { return __uint_as_float(u << 16); }
__device__ __forceinline__ float bf_hi(unsigned u) { return __uint_as_float(u & 0xffff0000u); }
__device__ __forceinline__ float bf2f(bf16_t v) { return __uint_as_float(((unsigned)v) << 16); }
__device__ __forceinline__ float fexp2(float x) { return __builtin_amdgcn_exp2f(x); }
__device__ __forceinline__ float frcp(float x) { return __builtin_amdgcn_rcpf(x); }
__device__ __forceinline__ float sigmoidf_(float x) { return frcp(1.0f + fexp2(-x * LOG2E)); }
__device__ __forceinline__ float gelu_tanh(float x) { const float z = 1.5957691216057308f * (x + 0.044715f * x * x * x); return x * frcp(1.0f + fexp2(-z * LOG2E)); }
__device__ __forceinline__ int crow(int r, int hi) { return (r & 3) + 8 * (r >> 2) + 4 * hi; }
__device__ __forceinline__ u32x4 pack8(f32x4 a, f32x4 b) { u32x4 w; w.x = pk_bf16(a[0], a[1]); w.y = pk_bf16(a[2], a[3]); w.z = pk_bf16(b[0], b[1]); w.w = pk_bf16(b[2], b[3]); return w; }
__device__ __forceinline__ void unpack8(u32x4 w, float* f) { f[0] = bf_lo(w.x); f[1] = bf_hi(w.x); f[2] = bf_lo(w.y); f[3] = bf_hi(w.y); f[4] = bf_lo(w.z); f[5] = bf_hi(w.z); f[6] = bf_lo(w.w); f[7] = bf_hi(w.w); }
__device__ __forceinline__ float wave_sum(float v) {
#pragma unroll
    for (int o = 1; o < 64; o <<= 1) v += __shfl_xor(v, o);
    return v;
}
__device__ __forceinline__ s16x4 vtr(const LAS unsigned char* p) { return __builtin_bit_cast(s16x4, __builtin_amdgcn_ds_read_tr16_b64_v4i16((LAS s16x4*)p)); }
#define MFMA32(a, b, c) __builtin_amdgcn_mfma_f32_32x32x16_bf16((a), (b), (c), 0, 0, 0)

namespace pg8 {
constexpr int BM = 256, BK = 64, HALF = 128, HTB = HALF * BK * 2, STAGE_BYTES = 8 * HTB, NXCD = 8, WGM = 8;
__host__ __device__ __forceinline__ int lds_byte(int r, int c) { const int st = (r >> 4) * 2 + (c >> 5), rr = r & 15, cc = c & 31, ob = rr * 64 + cc * 2; return st * 1024 + (ob ^ (((ob >> 9) & 1) << 5)); }
__host__ __device__ __forceinline__ void stage_rc(int b, int& R, int& C) { const int st = b / 1024, sb = b % 1024, swz = sb ^ (((sb >> 9) & 1) << 5); R = (st >> 1) * 16 + swz / 64; C = (st & 1) * 32 + (swz % 64) / 2; }
__host__ __device__ __forceinline__ int perm32(int rho) { const int n = rho >> 4, i = rho & 15; return 8 * (i >> 2) + 4 * n + (i & 3); }

struct Unit { const char* A; const char* B; int pm, pn, kind; };

__device__ __forceinline__ void tile_order(int L, int nM, int nN, int& pm, int& pn) {
    const int nwg = nM * nN; int wgid = L;
    { const int q = nwg / NXCD, r = nwg % NXCD, xcd = wgid % NXCD, off = wgid / NXCD; wgid = (xcd < r ? xcd * (q + 1) : r * (q + 1) + (xcd - r) * q) + off; }
    const int nig = WGM * nN, gid = wgid / nig, fm = gid * WGM, gsz = (nM - fm) < WGM ? (nM - fm) : WGM;
    pm = fm + ((wgid % nig) % gsz); pn = (wgid % nig) / gsz;
}

template <class Epi, class Sched>
__device__ __forceinline__ void gemm_phase(LAS unsigned char* lds, const int K, const Sched& S, const Epi& E) {
    const int tid = threadIdx.x, wid = __builtin_amdgcn_readfirstlane(tid >> 6), lane = tid & 63, wr = wid >> 2, wc = wid & 3, fr = lane & 15, fq = lane >> 4;
    const int nt = K / BK;
    unsigned voffA[2], voffB[2];
#pragma unroll
    for (int i = 0; i < 2; ++i) { int R, C; stage_rc(tid * 16 + i * 8192, R, C); const int Rb = (R & ~31) + perm32(R & 31);
        voffA[i] = (unsigned)(R * K + C) * 2u; voffB[i] = (unsigned)(Rb * K + C) * 2u; }
    const size_t kstep = (size_t)(BK * 2);
    const size_t hstep = (size_t)HALF * K * 2;
    const unsigned ldsw = (unsigned)wid * 1024u;
    const int aoff = lds_byte(wr * 64 + fr, fq * 8), boff = lds_byte(wc * 32 + fr, fq * 8);
#define PG8_SA(b, h) (((b) * 2 + (h)) * HTB)
#define PG8_SB(b, h) ((4 + (b) * 2 + (h)) * HTB)
#define PG8_STAGE(bufoff, gbase, voff) do { _Pragma("unroll") for (int _i = 0; _i < 2; ++_i) \
        __builtin_amdgcn_global_load_lds((const unsigned*)((const char*)(gbase) + (voff)[_i]), (LAS unsigned*)(lds + (bufoff) + ldsw + _i * 8192), 16, 0, 0); } while (0)
#define PG8_LDA(dst, b, h) do { _Pragma("unroll") for (int m = 0; m < 4; ++m) _Pragma("unroll") for (int k = 0; k < 2; ++k) dst[m][k] = *(const LAS bf16x8*)(lds + PG8_SA(b, h) + aoff + m * 2048 + k * 1024); } while (0)
#define PG8_LDB(dst, b, h) do { _Pragma("unroll") for (int n = 0; n < 2; ++n) _Pragma("unroll") for (int k = 0; k < 2; ++k) dst[n][k] = *(const LAS bf16x8*)(lds + PG8_SB(b, h) + boff + n * 2048 + k * 1024); } while (0)
#define PG8_MMA(ai, bj, At, Bt) do { __builtin_amdgcn_s_setprio(1); _Pragma("unroll") for (int m = 0; m < 4; ++m) _Pragma("unroll") for (int n = 0; n < 2; ++n) _Pragma("unroll") for (int k = 0; k < 2; ++k) \
        acc[ai][bj][m][n] = __builtin_amdgcn_mfma_f32_16x16x32_bf16(Bt[n][k], At[m][k], acc[ai][bj][m][n], 0, 0, 0); __builtin_amdgcn_s_setprio(0); } while (0)
#define PG8_WAIT_V(n) asm volatile("s_waitcnt vmcnt(" #n ")" ::: "memory")
#define PG8_WAIT_L(n) asm volatile("s_waitcnt lgkmcnt(" #n ")" ::: "memory")
#define PG8_BAR __builtin_amdgcn_s_barrier()
#define PG8_SCHED __builtin_amdgcn_sched_barrier(0)
#define PG8_ZERO() do { _Pragma("unroll") for (int a = 0; a < 2; ++a) _Pragma("unroll") for (int b = 0; b < 2; ++b) _Pragma("unroll") for (int m = 0; m < 4; ++m) _Pragma("unroll") for (int n = 0; n < 2; ++n) acc[a][b][m][n] = (f32x4){0.f, 0.f, 0.f, 0.f}; } while (0)
    Unit cur, nxt; int ui = 0;
    if (!S.next(0, cur)) return;
    f32x4 acc[2][2][4][2];
    PG8_ZERO();
    bf16x8 At[4][2], B0[2][2], B1[2][2];
    const char* cA = cur.A; const char* cB = cur.B;
    PG8_STAGE(PG8_SB(0, 0), cB, voffB); PG8_STAGE(PG8_SB(0, 1), cB + hstep, voffB); PG8_STAGE(PG8_SA(0, 0), cA, voffA); PG8_STAGE(PG8_SA(0, 1), cA + hstep, voffA);
    if (wr == 1) PG8_BAR;
    PG8_WAIT_V(2); PG8_BAR;
    PG8_STAGE(PG8_SB(1, 0), cB + kstep, voffB); PG8_STAGE(PG8_SA(1, 0), cA + kstep, voffA); PG8_STAGE(PG8_SB(1, 1), cB + hstep + kstep, voffB);
    PG8_WAIT_V(6); PG8_BAR;
    for (;;) {
        const bool has_next = S.next(ui + 1, nxt);
        const char* nA = has_next ? nxt.A : cA; const char* nB = has_next ? nxt.B : cB;
        for (int t = 0; t < nt; t += 2) {
            const bool last = (t == nt - 2);
            const char* a1 = cA + (size_t)(t + 1) * kstep;
            const char* a2 = last ? nA : cA + (size_t)(t + 2) * kstep; const char* b2 = last ? nB : cB + (size_t)(t + 2) * kstep;
            const char* a3 = a2 + kstep; const char* b3 = b2 + kstep;
            PG8_LDB(B0, 0, 0); PG8_LDB(B1, 0, 1); PG8_SCHED; PG8_LDA(At, 0, 0); PG8_STAGE(PG8_SA(1, 1), a1 + hstep, voffA);
            PG8_WAIT_V(8); PG8_WAIT_L(0); PG8_BAR; PG8_MMA(0, 0, At, B0); PG8_MMA(0, 1, At, B1); PG8_BAR; PG8_SCHED;
            PG8_LDA(At, 0, 1); PG8_STAGE(PG8_SB(0, 0), b2, voffB); PG8_STAGE(PG8_SB(0, 1), b2 + hstep, voffB); PG8_STAGE(PG8_SA(0, 0), a2, voffA);
            PG8_WAIT_V(8); PG8_WAIT_L(0); PG8_BAR; PG8_MMA(1, 0, At, B0); PG8_MMA(1, 1, At, B1); PG8_BAR; PG8_SCHED;
            PG8_LDB(B0, 1, 0); PG8_LDB(B1, 1, 1); PG8_SCHED; PG8_LDA(At, 1, 0); PG8_STAGE(PG8_SA(0, 1), a2 + hstep, voffA);
            PG8_WAIT_V(8); PG8_WAIT_L(0); PG8_BAR; PG8_MMA(0, 0, At, B0); PG8_MMA(0, 1, At, B1); PG8_BAR; PG8_SCHED;
            PG8_LDA(At, 1, 1); PG8_STAGE(PG8_SB(1, 0), b3, voffB); PG8_STAGE(PG8_SB(1, 1), b3 + hstep, voffB); PG8_STAGE(PG8_SA(1, 0), a3, voffA);
            PG8_WAIT_V(8); PG8_WAIT_L(0); PG8_BAR; PG8_MMA(1, 0, At, B0); PG8_MMA(1, 1, At, B1); PG8_BAR; PG8_SCHED;
        }
        if (wr == 0) PG8_BAR;
        const bool zero = E(acc, cur, wr, wc, fr, fq);
        if (!has_next) break;
        if (zero) PG8_ZERO();
        cur = nxt; cA = nA; cB = nB; ++ui;
        if (wr == 1) PG8_BAR;
    }
    PG8_WAIT_V(0);
    PG8_BAR;
#undef PG8_SA
#undef PG8_SB
#undef PG8_STAGE
#undef PG8_LDA
#undef PG8_LDB
#undef PG8_MMA
#undef PG8_WAIT_V
#undef PG8_WAIT_L
#undef PG8_BAR
#undef PG8_SCHED
#undef PG8_ZERO
}
}

#define TILE_FOR(...) \
    _Pragma("unroll") for (int ai = 0; ai < 2; ++ai) _Pragma("unroll") for (int m = 0; m < 4; ++m) { const int row = rowb + ai * 128 + m * 16; \
    _Pragma("unroll") for (int bj = 0; bj < 2; ++bj) { const int col = colb + bj * 128; f32x4& v0 = acc[ai][bj][m][0]; f32x4& v1 = acc[ai][bj][m][1]; __VA_ARGS__ } }

#define XB_TMO      128
#define XB_XCNT(j)  (256  + 64 * (j))
#define XB_XSUB(j)  (1280 + 64 * (j))
#define XB_XGEN(j)  (2304 + 64 * (j))
#define XB_TOP      3328
#define XB_TOPGEN   3392
#define XCD_BAR_WORDS 3456
#define XB_SPIN_CAP (1u << 18)
__device__ __forceinline__ unsigned xb_ld(unsigned* p)              { return __hip_atomic_load(p, __ATOMIC_RELAXED, __HIP_MEMORY_SCOPE_AGENT); }
__device__ __forceinline__ unsigned xb_add(unsigned* p, unsigned v) { return __hip_atomic_fetch_add(p, v, __ATOMIC_RELAXED, __HIP_MEMORY_SCOPE_AGENT); }
__device__ __forceinline__ unsigned xb_xcc_id() { return (unsigned)__builtin_amdgcn_s_getreg((3 << 11) | 20) & 0xFu; }
#define XB_SPIN(cond, bar) do { unsigned _sp = 0; while (cond) { __builtin_amdgcn_s_sleep(1); \
    if ((++_sp & 255u) == 0u) { if (xb_ld(&(bar)[XB_TMO])) break; if (_sp > XB_SPIN_CAP) { atomicAdd(&(bar)[XB_TMO], 1u); break; } } } } while (0)
struct XcdBarrier { unsigned* bar; unsigned x; volatile LAS unsigned* st; };
__device__ __forceinline__ XcdBarrier xcd_barrier_post(unsigned* bar, volatile LAS unsigned* st) {
    XcdBarrier b; b.bar = bar; b.x = xb_xcc_id(); b.st = st;
    if (threadIdx.x == 0) (void)xb_add(&bar[XB_XCNT(b.x)], 1u);
    return b;
}
__device__ __forceinline__ void xcd_barrier_complete(unsigned* bar, unsigned x, unsigned& nloc, unsigned& nx) {
    const unsigned G = gridDim.x * gridDim.y * gridDim.z;
    unsigned sum, cnt, mine, sp = 0u;
    for (;;) {
        sum = 0u; cnt = 0u; mine = 0u;
#pragma unroll
        for (unsigned j = 0; j < 16; ++j) { const unsigned c = xb_ld(&bar[XB_XCNT(j)]); sum += c; cnt += (c > 0u) ? 1u : 0u; mine = (j == x) ? c : mine; }
        if (sum == G) break;
        __builtin_amdgcn_s_sleep(1);
        if ((++sp & 255u) == 0u) { if (xb_ld(&bar[XB_TMO])) break; if (sp > XB_SPIN_CAP) { atomicAdd(&bar[XB_TMO], 1u); break; } }
    }
    nloc = mine > 0u ? mine : 1u; nx = cnt > 0u ? cnt : 1u;
}
__device__ __forceinline__ void xcd_barrier(const XcdBarrier& b) {
    asm volatile("s_waitcnt vmcnt(0)" ::: "memory");
    __syncthreads();
    if (threadIdx.x == 0) {
        unsigned* bar = b.bar;
        __builtin_amdgcn_s_waitcnt(0);
        unsigned nloc = b.st[0], nx = b.st[1];
        if (nloc == 0u) { xcd_barrier_complete(bar, b.x, nloc, nx); b.st[0] = nloc; b.st[1] = nx; }
        const unsigned old = xb_add(&bar[XB_XSUB(b.x)], 1u);
        const unsigned gen = old / nloc;
        if (old + 1u == (gen + 1u) * nloc) {
            __builtin_amdgcn_fence(__ATOMIC_RELEASE, "agent");
            asm volatile("s_waitcnt vmcnt(0)" ::: "memory");
            const unsigned og = xb_add(&bar[XB_TOP], 1u);
            const unsigned tg = og / nx;
            if (og + 1u == (tg + 1u) * nx) xb_add(&bar[XB_TOPGEN], 1u);
            else XB_SPIN(xb_ld(&bar[XB_TOPGEN]) == tg, bar);
            __builtin_amdgcn_fence(__ATOMIC_ACQUIRE, "agent");
            xb_add(&bar[XB_XGEN(b.x)], 1u);
            asm volatile("s_waitcnt vmcnt(0)" ::: "memory");
        } else {
            XB_SPIN(xb_ld(&bar[XB_XGEN(b.x)]) == gen, bar);
            __builtin_amdgcn_fence(__ATOMIC_ACQUIRE, "agent");
            asm volatile("s_waitcnt vmcnt(0)" ::: "memory");
        }
    }
    __syncthreads();
}

struct Args { const float* in[36]; float* out; unsigned char* ws; int ph_lo, ph_hi, li, pad; };
enum { I_XP = 0, I_XS, I_MEM, I_CK, I_CV, I_SCONV, I_SLRU, I_CMK, I_CMV, I_REL, I_NMIX, I_WIN, I_LQ1, I_LK1, I_LQ2, I_LK2, I_SUBG, I_CONVW, I_CONVB,
       I_WRGA, I_BRGA, I_WRGX, I_BRGX, I_RGL, I_NMEM, I_WMEM, I_WPA, I_WPB, I_WPC, I_WGATE, I_BGATE, I_WOUT, I_NFFN, I_WFI, I_WFO, I_NFIN };

__device__ __forceinline__ void transpose_item(const float* W, int K, int N, bf16_t* WT, int kb, int nb, int dst_row0, const float* kscale, LAS float* scr, int lane) {
    const int k0 = 64 * kb, n0 = 32 * nb;
#pragma unroll 8
    for (int i = 0; i < 32; ++i) { const int kk = 2 * i + (lane >> 5); scr[kk * 33 + (lane & 31)] = W[(size_t)(k0 + kk) * N + n0 + (lane & 31)]; }
    asm volatile("s_waitcnt lgkmcnt(0)" ::: "memory");
    const int c = lane & 7;
    float sc[8];
#pragma unroll
    for (int e = 0; e < 8; ++e) sc[e] = kscale ? kscale[k0 + 8 * c + e] : 1.0f;
#pragma unroll
    for (int j = 0; j < 4; ++j) { const int n = (lane >> 3) + 8 * j; const LAS float* s = scr + (8 * c) * 33 + n;
        u32x4 o; o.x = pk_bf16(s[0 * 33] * sc[0], s[1 * 33] * sc[1]); o.y = pk_bf16(s[2 * 33] * sc[2], s[3 * 33] * sc[3]);
        o.z = pk_bf16(s[4 * 33] * sc[4], s[5 * 33] * sc[5]); o.w = pk_bf16(s[6 * 33] * sc[6], s[7 * 33] * sc[7]);
        *(u32x4*)(WT + (size_t)(dst_row0 + n) * K + k0 + 8 * c) = o; }
    asm volatile("s_waitcnt lgkmcnt(0)" ::: "memory");
}
__device__ __forceinline__ void norm_row_bf16(const float* xrow, const float* gain, bf16_t* orow, int lane) {
    const f32x4* xr = (const f32x4*)xrow + lane; const f32x4* gr = (const f32x4*)gain + lane;
    f32x4 v[4]; float s = 0.f;
#pragma unroll
    for (int j = 0; j < 4; ++j) { v[j] = xr[64 * j]; s += (v[j].x * v[j].x + v[j].y * v[j].y) + (v[j].z * v[j].z + v[j].w * v[j].w); }
    const float rstd = 1.0f / sqrtf(wave_sum(s) * (1.0f / 1024.0f) + EPS);
    u32x2* o8 = (u32x2*)orow + lane;
#pragma unroll
    for (int j = 0; j < 4; ++j) { const f32x4 g = gr[64 * j]; u32x2 w; w.x = pk_bf16(v[j].x * rstd * g.x, v[j].y * rstd * g.y); w.y = pk_bf16(v[j].z * rstd * g.z, v[j].w * rstd * g.w); o8[64 * j] = w; }
}
__device__ __forceinline__ void p0_prologue(const Args& a, LAS unsigned char* lds, int gw, int NGW, int wave, int lane) {
    LAS float* scr = (LAS float*)(lds + wave * 16384);
    unsigned char* ws = a.ws;
    constexpr int I0 = 16 * 192, I1 = 16 * 96, I2 = 16 * 64, I3 = 16 * 32, I7 = 16 * 176, I8 = 44 * 32, I9 = 64;
    constexpr int NITEMS = I0 + I1 + I2 + 4 * I3 + I7 + I8 + 2 * I9;
    for (int it = gw; it < NITEMS; it += NGW) {
        int r = it;
        if (r < I0) { transpose_item(a.in[I_WIN], 1024, INW, (bf16_t*)(ws + WS_WCAT), r / 192, r % 192, 32 * (r % 192), nullptr, scr, lane); continue; } r -= I0;
        if (r < I1) { transpose_item(a.in[I_WGATE], 1024, GATEW, (bf16_t*)(ws + WS_WCAT), r / 96, r % 96, 6144 + 32 * (r % 96), nullptr, scr, lane); continue; } r -= I1;
        if (r < I2) { transpose_item(a.in[I_WMEM], 1024, 2048, (bf16_t*)(ws + WS_WCAT), r / 64, r % 64, 9216 + 32 * (r % 64), nullptr, scr, lane); continue; } r -= I2;
        if (r < I3) { transpose_item(a.in[I_WPA], 1024, 1024, (bf16_t*)(ws + WS_WP), r / 32, r % 32, 32 * (r % 32), nullptr, scr, lane); continue; } r -= I3;
        if (r < I3) { transpose_item(a.in[I_WPB], 1024, 1024, (bf16_t*)(ws + WS_WP), r / 32, r % 32, 1024 + 32 * (r % 32), nullptr, scr, lane); continue; } r -= I3;
        if (r < I3) { transpose_item(a.in[I_WPC], 1024, 1024, (bf16_t*)(ws + WS_WP), r / 32, r % 32, 2048 + 32 * (r % 32), nullptr, scr, lane); continue; } r -= I3;
        if (r < I3) { transpose_item(a.in[I_WOUT], 1024, 1024, (bf16_t*)(ws + WS_WO), r / 32, r % 32, 32 * (r % 32), nullptr, scr, lane); continue; } r -= I3;
        if (r < I7) { const int nb = r % 176, n0 = 32 * nb; const int ch0 = n0 < DFF ? n0 : n0 - DFF; const int dst = 256 * (ch0 / 128) + (n0 < DFF ? 0 : 128) + (ch0 % 128);
            transpose_item(a.in[I_WFI], 1024, 2 * DFF, (bf16_t*)(ws + WS_WFI), r / 176, nb, dst, a.in[I_NFFN], scr, lane); continue; } r -= I7;
        if (r < I8) { transpose_item(a.in[I_WFO], DFF, 1024, (bf16_t*)(ws + WS_WFO), r / 32, r % 32, 32 * (r % 32), nullptr, scr, lane); continue; } r -= I8;
        if (r < I9) { const int n = r / 8, s = r % 8;
          transpose_item(a.in[I_WRGA] + (size_t)n * 128 * 128, 128, 128, (bf16_t*)(ws + WS_WRG) + (size_t)n * 128 * 128, s / 4, s % 4, 32 * (s % 4), nullptr, scr, lane); continue; } r -= I9;
        { const int n = r / 8, s = r % 8;
          transpose_item(a.in[I_WRGX] + (size_t)n * 128 * 128, 128, 128, (bf16_t*)(ws + WS_WRG) + (size_t)(8 + n) * 128 * 128, s / 4, s % 4, 32 * (s % 4), nullptr, scr, lane); }
    }
    bf16_t* XN = (bf16_t*)(ws + WS_XN);
    for (int m = gw; m < TALL; m += NGW) {
        if (m < TP) norm_row_bf16(a.in[I_XP] + (size_t)m * DM, a.in[I_NMIX], XN + (size_t)m * DM, lane);
        else if (m < TT) norm_row_bf16(a.in[I_XS] + (size_t)(m - TP) * DM, a.in[I_NMIX], XN + (size_t)m * DM, lane);
        else norm_row_bf16(a.in[I_MEM] + (size_t)(m - TT) * DM, a.in[I_NMEM], XN + (size_t)m * DM, lane);
    }
}

struct Sched1 {
    const char* A; const char* B; int G, c;
    __device__ __forceinline__ bool next(int i, pg8::Unit& u) const {
        const int L = i * G + c;
        if (L < 66 * 36) { int pm, pn; pg8::tile_order(L, 66, 36, pm, pn); u.pm = pm; u.pn = pn; u.kind = pn >> 2;
            u.A = A + (size_t)pm * 256 * 1024 * 2; u.B = B + (size_t)pn * 256 * 1024 * 2; return true; }
        const int L2 = L - 66 * 36;
        if (L2 < 64) { int pm, pn; pg8::tile_order(L2, 8, 8, pm, pn); u.pm = pm; u.pn = pn; u.kind = 9;
            u.A = A + (size_t)(66 + pm) * 256 * 1024 * 2; u.B = B + (size_t)(36 + pn) * 256 * 1024 * 2; return true; }
        return false;
    }
};
struct Epi1 {
    bf16_t *Q, *Kb, *Vb, *XB, *GG, *QC, *G, *MK, *MV; float* out; const float* bgate;
    __device__ __forceinline__ bool operator()(f32x4 (&acc)[2][2][4][2], const pg8::Unit& u, int wr, int wc, int fr, int fq) const {
        const int rowb = u.pm * 256 + wr * 64 + fr, colb = (u.pn & 3) * 256 + wc * 32 + 8 * fq;
        const int kind = u.kind;
        if (kind == 0) { TILE_FOR( *(u32x4*)(Q + (size_t)row * DM + col) = pack8(v0 * QSCALE, v1 * QSCALE); ) }
        else if (kind == 1 || kind == 2) {
            bf16_t* B = kind == 1 ? Kb : Vb; const size_t op = kind == 1 ? O_KP : O_VP, os = kind == 1 ? O_KS : O_VS;
            TILE_FOR( *(u32x4*)(B + (size_t)row * DM + col) = pack8(v0, v1);
                      float* o = out + (row < TP ? op + (size_t)row * DM : os + (size_t)(row - TP) * DM) + col; *(f32x4*)o = v0; *(f32x4*)(o + 4) = v1; ) }
        else if (kind == 3) {
            TILE_FOR( *(u32x4*)(XB + (size_t)row * DM + col) = pack8(v0, v1);
                      if (row < TP) { const int s = row & (SEQ - 1); if (s >= SEQ - 3) { float* o = out + O_CP + (size_t)((row >> 11) * 3 + (s - (SEQ - 3))) * DM + col; *(f32x4*)o = v0; *(f32x4*)(o + 4) = v1; } }
                      else { const int rs = row - TP, s = rs & (DSEQ - 1); if (s >= DSEQ - 3) { float* o = out + O_CS + (size_t)((rs >> 5) * 3 + (s - (DSEQ - 3))) * DM + col; *(f32x4*)o = v0; *(f32x4*)(o + 4) = v1; } } ) }
        else if (kind == 4) {
            TILE_FOR( f32x4 g0, g1;
                      _Pragma("unroll") for (int j = 0; j < 4; ++j) { g0[j] = gelu_tanh(v0[j]); g1[j] = gelu_tanh(v1[j]); }
                      *(u32x4*)(GG + (size_t)row * DM + col) = pack8(g0, g1); ) }
        else if (kind == 5) { TILE_FOR( *(u32x4*)(QC + (size_t)row * DM + col) = pack8(v0 * CSCALE, v1 * CSCALE); ) }
        else if (kind <= 8) {
            const int gofs = (kind - 6) * 1024;
            TILE_FOR( const f32x4 b0 = *(const f32x4*)(bgate + gofs + col); const f32x4 b1 = *(const f32x4*)(bgate + gofs + col + 4); f32x4 g0, g1;
                      _Pragma("unroll") for (int j = 0; j < 4; ++j) { g0[j] = sigmoidf_(v0[j] + b0[j]); g1[j] = sigmoidf_(v1[j] + b1[j]); }
                      *(u32x4*)(G + (size_t)row * GATEW + gofs + col) = pack8(g0, g1); ) }
        else {
            bf16_t* B = u.pn < 4 ? MK : MV; const size_t ob = u.pn < 4 ? O_MKP : O_MVP;
            TILE_FOR( *(u32x4*)(B + (size_t)row * DM + col) = pack8(v0, v1);
                      float* o = out + ob + (size_t)row * DM + col; *(f32x4*)o = v0; *(f32x4*)(o + 4) = v1; ) }
        return true;
    }
};

struct Sched2 {
    const char* A0; const char* A1; const char* A2; const char* B; int G, c;
    __device__ __forceinline__ bool next(int i, pg8::Unit& u) const {
        const int j = i / 3, br = i - 3 * j; const int L = j * G + c;
        if (L >= 66 * 4) return false;
        int pm, pn; pg8::tile_order(L, 66, 4, pm, pn); u.pm = pm; u.pn = pn; u.kind = br;
        u.A = (br == 0 ? A0 : br == 1 ? A1 : A2) + (size_t)pm * 256 * 1024 * 2; u.B = B + (size_t)(br * 1024 + pn * 256) * 1024 * 2; return true;
    }
};
struct Epi2 {
    const bf16_t* G; bf16_t* MG; float* P;
    __device__ __forceinline__ bool operator()(f32x4 (&acc)[2][2][4][2], const pg8::Unit& u, int wr, int wc, int fr, int fq) const {
        const int rowb = u.pm * 256 + wr * 64 + fr, colb = u.pn * 256 + wc * 32 + 8 * fq;
        const int br = u.kind;
        TILE_FOR( const u32x4 gc = *(const u32x4*)(G + (size_t)row * GATEW + br * 1024 + col); float c[8]; unpack8(gc, c);
                  float* pp = P + (size_t)row * DM + col; f32x4 o0, o1;
                  _Pragma("unroll") for (int j = 0; j < 4; ++j) { o0[j] = v0[j] * c[j]; o1[j] = v1[j] * c[4 + j]; }
                  if (br > 0) { o0 += *(const f32x4*)pp; o1 += *(const f32x4*)(pp + 4); }
                  if (br < 2) { *(f32x4*)pp = o0; *(f32x4*)(pp + 4) = o1; }
                  else *(u32x4*)(MG + (size_t)row * DM + col) = pack8(o0, o1); )
        return true;
    }
};

struct SchedT {
    const char* A; const char* B; int nM, nN, K, G, c;
    __device__ __forceinline__ bool next(int i, pg8::Unit& u) const {
        const int L = i * G + c; if (L >= nM * nN) return false;
        int pm, pn; pg8::tile_order(L, nM, nN, pm, pn); u.pm = pm; u.pn = pn; u.kind = 0;
        u.A = A + (size_t)pm * 256 * K * 2; u.B = B + (size_t)pn * 256 * K * 2; return true;
    }
};
struct Epi3 {
    const float* xp; const float* xs; float* X1; bf16_t* X1B; float* SS;
    __device__ __forceinline__ bool operator()(f32x4 (&acc)[2][2][4][2], const pg8::Unit& u, int wr, int wc, int fr, int fq) const {
        const int rowb = u.pm * 256 + wr * 64 + fr, colb = u.pn * 256 + wc * 32 + 8 * fq;
#pragma unroll
        for (int ai = 0; ai < 2; ++ai)
#pragma unroll
            for (int m = 0; m < 4; ++m) { const int row = rowb + ai * 128 + m * 16; float ss = 0.f;
                const float* xr = row < TP ? xp + (size_t)row * DM : xs + (size_t)(row - TP) * DM;
#pragma unroll
                for (int bj = 0; bj < 2; ++bj) { const int col = colb + bj * 128;
                    const f32x4 a0 = acc[ai][bj][m][0] + *(const f32x4*)(xr + col), a1 = acc[ai][bj][m][1] + *(const f32x4*)(xr + col + 4);
                    *(f32x4*)(X1 + (size_t)row * DM + col) = a0; *(f32x4*)(X1 + (size_t)row * DM + col + 4) = a1;
                    *(u32x4*)(X1B + (size_t)row * DM + col) = pack8(a0, a1);
                    ss += (a0[0] * a0[0] + a0[1] * a0[1]) + (a0[2] * a0[2] + a0[3] * a0[3]) + (a1[0] * a1[0] + a1[1] * a1[1]) + (a1[2] * a1[2] + a1[3] * a1[3]); }
                ss += __shfl_xor(ss, 16); ss += __shfl_xor(ss, 32);
                if (fq == 0) SS[(size_t)row * 16 + u.pn * 4 + wc] = ss; }
        return true;
    }
};
struct Epi4 {
    const float* SS; bf16_t* ACT;
    __device__ __forceinline__ bool operator()(f32x4 (&acc)[2][2][4][2], const pg8::Unit& u, int wr, int wc, int fr, int fq) const {
        const int rowb = u.pm * 256 + wr * 64 + fr, colb = u.pn * 128 + wc * 32 + 8 * fq;
#pragma unroll
        for (int ai = 0; ai < 2; ++ai)
#pragma unroll
            for (int m = 0; m < 4; ++m) { const int row = rowb + ai * 128 + m * 16;
                const f32x4 p = *(const f32x4*)(SS + (size_t)row * 16 + 4 * fq); float s = (p[0] + p[1]) + (p[2] + p[3]);
                s += __shfl_xor(s, 16); s += __shfl_xor(s, 32);
                const float rstd = 1.0f / sqrtf(s * (1.0f / 1024.0f) + EPS);
                f32x4 o0, o1;
#pragma unroll
                for (int j = 0; j < 4; ++j) { const float g0 = acc[ai][0][m][0][j] * rstd, u0 = acc[ai][1][m][0][j] * rstd, g1 = acc[ai][0][m][1][j] * rstd, u1 = acc[ai][1][m][1][j] * rstd;
                    o0[j] = g0 * sigmoidf_(g0) * u0; o1[j] = g1 * sigmoidf_(g1) * u1; }
                *(u32x4*)(ACT + (size_t)row * DFF + colb) = pack8(o0, o1); }
        return true;
    }
};
struct Epi5 {
    float* X1;
    __device__ __forceinline__ bool operator()(f32x4 (&acc)[2][2][4][2], const pg8::Unit& u, int wr, int wc, int fr, int fq) const {
        const int rowb = u.pm * 256 + wr * 64 + fr, colb = u.pn * 256 + wc * 32 + 8 * fq;
        TILE_FOR( float* p = X1 + (size_t)row * DM + col; const f32x4 a0 = v0 + *(const f32x4*)p, a1 = v1 + *(const f32x4*)(p + 4); *(f32x4*)p = a0; *(f32x4*)(p + 4) = a1; )
        return true;
    }
};

struct P2Ctx {
    const Args* a; LAS unsigned char* lds; int tid, lane, wid;
    const bf16_t *Q, *Kb, *Vb, *XB, *GG, *QC, *MK, *MV, *WRG; bf16_t *AO, *BO, *CO;
};
template <int NB>
__device__ __forceinline__ float softmax_step(f32x16 (&s)[NB], float& m, float& l) {
    float mx = s[0][0];
#pragma unroll
    for (int b = 0; b < NB; ++b)
#pragma unroll
        for (int r = 0; r < 16; ++r) mx = fmaxf(mx, s[b][r]);
    mx = fmaxf(mx, __shfl_xor(mx, 32));
    const float mn = fmaxf(m, mx), alpha = fexp2(m - mn);
    float ps = 0.f;
#pragma unroll
    for (int b = 0; b < NB; ++b)
#pragma unroll
        for (int r = 0; r < 16; ++r) { const float p = fexp2(s[b][r] - mn); s[b][r] = p; ps += p; }
    l = l * alpha + ps; m = mn;
    return alpha;
}
__device__ __forceinline__ bf16x8 pack_p(const f32x16& s, int h) {
    u32x4 w; w.x = pk_bf16(s[8 * h + 0], s[8 * h + 1]); w.y = pk_bf16(s[8 * h + 2], s[8 * h + 3]); w.z = pk_bf16(s[8 * h + 4], s[8 * h + 5]); w.w = pk_bf16(s[8 * h + 6], s[8 * h + 7]);
    return __builtin_bit_cast(bf16x8, w);
}
__device__ __forceinline__ bf16x8 v_frag(const LAS unsigned char* vimg, int ncb, int s, int cb, int lane) {
    const int hi = lane >> 5, g16 = (lane >> 4) & 1, i = lane & 15;
    const LAS unsigned char* p = vimg + ((2 * s) * ncb + cb) * 512 + (4 * hi + (i >> 2)) * 64 + g16 * 32 + (i & 3) * 8;
    const s16x4 lo = vtr(p), hv = vtr(p + ncb * 512);
    return (bf16x8){lo[0], lo[1], lo[2], lo[3], hv[0], hv[1], hv[2], hv[3]};
}
__device__ __forceinline__ void subln_store(f32x16 (&o)[4], const float* subg, bf16_t* dst  , int lane) {
    const int hi = lane >> 5;
    float ss = 0.f;
#pragma unroll
    for (int cb = 0; cb < 4; ++cb)
#pragma unroll
        for (int r = 0; r < 16; ++r) ss += o[cb][r] * o[cb][r];
    ss += __shfl_xor(ss, 32);
    const float rstd = (1.0f - LAMBDA_INIT) / sqrtf(ss * (1.0f / 128.0f) + EPS);
#pragma unroll
    for (int cb = 0; cb < 4; ++cb)
#pragma unroll
        for (int g = 0; g < 4; ++g) { const int dv0 = 32 * cb + 8 * g + 4 * hi; const f32x4 sg = *(const f32x4*)(subg + dv0);
            u32x2 w; w.x = pk_bf16(o[cb][4 * g + 0] * rstd * sg[0], o[cb][4 * g + 1] * rstd * sg[1]); w.y = pk_bf16(o[cb][4 * g + 2] * rstd * sg[2], o[cb][4 * g + 3] * rstd * sg[3]);
            *(u32x2*)(dst + dv0) = w; }
}

__device__ __forceinline__ void attnA_unit(const P2Ctx& C, int b, int h, int qb) {
    LAS unsigned char* lds = C.lds; const int tid = C.tid, lane = C.lane, wid = C.wid;
    const int comp = wid >> 2, qs = wid & 3, r32 = lane & 31, hi = lane >> 5;
    const int q0 = qb * 128, trow0 = b * SEQ;
    const int qpos = q0 + qs * 32 + r32; const size_t qrow = (size_t)(trow0 + qpos);
    const int qcw = (q0 + qs * 32) >> 6, ntw = qcw + 1, NT = 2 * qb + 2;
    const LAS float* lut = (const LAS float*)(lds + LUT_OFF) + h * 256;
    const float lam = *(const LAS float*)(lds + LAM_OFF);
    bf16x8 qf[4];
#pragma unroll
    for (int ds = 0; ds < 4; ++ds) qf[ds] = *(const bf16x8*)(C.Q + qrow * DM + h * 128 + comp * 64 + ds * 16 + hi * 8);
    u32x4 kreg[2], vreg[2];
    const int kkey = tid >> 3, kch = tid & 7;
#define A_ISSUE(kt) do { const size_t tr_ = (size_t)(trow0 + (kt) * 64); \
        kreg[0] = *(const u32x4*)(C.Kb + (tr_ + kkey) * DM + h * 128 + kch * 8); kreg[1] = *(const u32x4*)(C.Kb + (tr_ + kkey) * DM + h * 128 + 64 + kch * 8); \
        _Pragma("unroll") for (int i_ = 0; i_ < 2; ++i_) { const int idx_ = tid + 512 * i_; vreg[i_] = *(const u32x4*)(C.Vb + (tr_ + (idx_ >> 4)) * DM + h * 128 + (idx_ & 15) * 8); } } while (0)
#define A_WRITE(st) do { LAS unsigned char* sb_ = lds + (st) * 32768; \
        *(LAS u32x4*)(sb_ + kkey * 128 + ((kch ^ ((kkey >> 1) & 7)) << 4)) = kreg[0]; *(LAS u32x4*)(sb_ + 8192 + kkey * 128 + ((kch ^ ((kkey >> 1) & 7)) << 4)) = kreg[1]; \
        _Pragma("unroll") for (int i_ = 0; i_ < 2; ++i_) { const int idx_ = tid + 512 * i_, key_ = idx_ >> 4, ch_ = idx_ & 15; \
            *(LAS u32x4*)(sb_ + 16384 + ((key_ >> 3) * 4 + (ch_ >> 2)) * 512 + (key_ & 7) * 64 + (ch_ & 3) * 16) = vreg[i_]; } } while (0)
    f32x16 o[4];
#pragma unroll
    for (int cb = 0; cb < 4; ++cb)
#pragma unroll
        for (int r = 0; r < 16; ++r) o[cb][r] = 0.f;
    float m = -1e30f, l = 0.f;
    A_ISSUE(0); A_WRITE(0); __syncthreads();
    for (int kt = 0; kt < NT; ++kt) {
        if (kt + 1 < NT) A_ISSUE(kt + 1);
        if (kt < ntw) {
            const LAS unsigned char* sb = lds + (kt & 1) * 32768;
            const int relmax = kt * 64 + 63 - (q0 + qs * 32);
            const bool far = (relmax + 192 <= 0);
            f32x16 s[2];
            { const float c0 = far ? lut[0] : 0.f;
#pragma unroll
              for (int kb = 0; kb < 2; ++kb)
#pragma unroll
                  for (int r = 0; r < 16; ++r) s[kb][r] = c0; }
#pragma unroll
            for (int ds = 0; ds < 4; ++ds)
#pragma unroll
                for (int kb = 0; kb < 2; ++kb) { const int key = kb * 32 + r32, ch = 2 * ds + hi;
                    const bf16x8 kf = *(const LAS bf16x8*)(sb + comp * 8192 + key * 128 + ((ch ^ ((key >> 1) & 7)) << 4));
                    s[kb] = MFMA32(kf, qf[ds], s[kb]); }
            if (!far) {
#pragma unroll
                for (int kb = 0; kb < 2; ++kb)
#pragma unroll
                    for (int r = 0; r < 16; ++r) { const int rel = kt * 64 + kb * 32 + crow(r, hi) - qpos; const int idx = rel + 192 > 0 ? rel + 192 : 0; s[kb][r] += lut[idx]; }
            }
            const float alpha = softmax_step<2>(s, m, l);
#pragma unroll
            for (int cb = 0; cb < 4; ++cb)
#pragma unroll
                for (int r = 0; r < 16; ++r) o[cb][r] *= alpha;
            bf16x8 pf[4];
            pf[0] = pack_p(s[0], 0); pf[1] = pack_p(s[0], 1); pf[2] = pack_p(s[1], 0); pf[3] = pack_p(s[1], 1);
#pragma unroll
            for (int cb = 0; cb < 4; ++cb)
#pragma unroll
                for (int ks = 0; ks < 4; ++ks) o[cb] = MFMA32(v_frag(sb + 16384, 4, ks, cb, lane), pf[ks], o[cb]);
        }
        if (kt + 1 < NT) A_WRITE((kt + 1) & 1);
        __syncthreads();
    }
#undef A_ISSUE
#undef A_WRITE
    l += __shfl_xor(l, 32);
    const float inv = 1.0f / l;
    LAS float* X2 = (LAS float*)(lds + 65536);
    if (comp == 1) {
#pragma unroll
        for (int cb = 0; cb < 4; ++cb)
#pragma unroll
            for (int r = 0; r < 16; ++r) X2[((qs * 4 + cb) * 16 + r) * 64 + lane] = o[cb][r] * inv;
    }
    __syncthreads();
    if (comp == 0) {
#pragma unroll
        for (int cb = 0; cb < 4; ++cb)
#pragma unroll
            for (int r = 0; r < 16; ++r) o[cb][r] = o[cb][r] * inv - lam * X2[((qs * 4 + cb) * 16 + r) * 64 + lane];
        subln_store(o, C.a->in[I_SUBG], C.AO + qrow * DM + h * 128, lane);
    }
    __syncthreads();
}

__device__ __forceinline__ void attnB_unit(const P2Ctx& C, int b, int h) {
    LAS unsigned char* lds = C.lds; const int tid = C.tid, lane = C.lane, wid = C.wid;
    const int comp = wid >> 2, q4 = wid & 3, r32 = lane & 31, hi = lane >> 5;
    const LAS float* lut = (const LAS float*)(lds + LUT_OFF) + h * 256;
    const float lam = *(const LAS float*)(lds + LAM_OFF);
    const size_t trow0 = (size_t)(TP + b * DSEQ);
    const float* ck = C.a->in[I_CK]; const float* cv = C.a->in[I_CV];
    { const int c = tid >> 8, row = (tid >> 3) & 31, ch = tid & 7;
      *(LAS u32x4*)(lds + c * 4096 + row * 128 + ((ch ^ ((row >> 1) & 7)) << 4)) = *(const u32x4*)(C.Q + (trow0 + row) * DM + h * 128 + c * 64 + ch * 8); }
    LAS unsigned char* VL = lds + 8192;
    f32x4 vst[4][2];
    const int vkey = (tid >> 4) & 31, vch = tid & 15;
#define B_ISSUEV(it) do { _Pragma("unroll") for (int i_ = 0; i_ < 4; ++i_) { const float* p_ = cv + (((size_t)(b * PAST + (i_ * 16 + (it)) * 32 + vkey)) * 8 + h) * 128 + vch * 8; \
        vst[i_][0] = *(const f32x4*)p_; vst[i_][1] = *(const f32x4*)(p_ + 4); } } while (0)
#define B_WRITEV(st) do { _Pragma("unroll") for (int i_ = 0; i_ < 4; ++i_) \
        *(LAS u32x4*)(VL + ((st) * 4 + i_) * 8192 + ((vkey >> 3) * 4 + (vch >> 2)) * 512 + (vkey & 7) * 64 + (vch & 3) * 16) = pack8(vst[i_][0], vst[i_][1]); } while (0)
    f32x4 kst[4][2];
#define B_ISSUEK(it) do { const float* p_ = ck + ((((size_t)(b * PAST + (q4 * 16 + (it)) * 32 + r32)) * 8 + h) * 2 + comp) * 64 + hi * 8; \
        _Pragma("unroll") for (int ds_ = 0; ds_ < 4; ++ds_) { kst[ds_][0] = *(const f32x4*)(p_ + ds_ * 16); kst[ds_][1] = *(const f32x4*)(p_ + ds_ * 16 + 4); } } while (0)
    f32x16 o[4];
#pragma unroll
    for (int cb = 0; cb < 4; ++cb)
#pragma unroll
        for (int r = 0; r < 16; ++r) o[cb][r] = 0.f;
    float m = -1e30f, l = 0.f;
    B_ISSUEV(0); B_ISSUEK(0); B_WRITEV(0); __syncthreads();
    for (int it = 0; it <= 16; ++it) {
        const bool active = (it < 16) || (q4 == 0);
        bf16x8 kf[4];
        if (it < 16) {
#pragma unroll
            for (int ds = 0; ds < 4; ++ds) kf[ds] = __builtin_bit_cast(bf16x8, pack8(kst[ds][0], kst[ds][1]));
        } else {
#pragma unroll
            for (int ds = 0; ds < 4; ++ds) kf[ds] = *(const bf16x8*)(C.Kb + (trow0 + r32) * DM + h * 128 + comp * 64 + ds * 16 + hi * 8);
        }
        u32x4 vnew = (u32x4){0u, 0u, 0u, 0u};
        if (it + 1 < 16) { B_ISSUEV(it + 1); B_ISSUEK(it + 1); }
        else if (it + 1 == 16) { if (tid < 512) vnew = *(const u32x4*)(C.Vb + (trow0 + vkey) * DM + h * 128 + vch * 8); }
        if (active) {
            const int kpos0 = it < 16 ? (q4 * 16 + it) * 32 : PAST;
            const LAS unsigned char* vimg = VL + ((it & 1) * 4 + (it < 16 ? q4 : 0)) * 8192;
            const int qpos = PAST + r32;
            const bool far = (kpos0 + 31 - PAST + 192 <= 0);
            f32x16 s[1];
            { const float c0 = far ? lut[0] : 0.f;
#pragma unroll
              for (int r = 0; r < 16; ++r) s[0][r] = c0; }
#pragma unroll
            for (int ds = 0; ds < 4; ++ds) { const int ch = 2 * ds + hi;
                const bf16x8 qf = *(const LAS bf16x8*)(lds + comp * 4096 + r32 * 128 + ((ch ^ ((r32 >> 1) & 7)) << 4));
                s[0] = MFMA32(kf[ds], qf, s[0]); }
            if (!far) {
#pragma unroll
                for (int r = 0; r < 16; ++r) { const int rel = kpos0 + crow(r, hi) - qpos; const int idx = rel + 192 > 0 ? rel + 192 : 0; s[0][r] += lut[idx]; }
            }
            const float alpha = softmax_step<1>(s, m, l);
#pragma unroll
            for (int cb = 0; cb < 4; ++cb)
#pragma unroll
                for (int r = 0; r < 16; ++r) o[cb][r] *= alpha;
            const bf16x8 p0 = pack_p(s[0], 0), p1 = pack_p(s[0], 1);
#pragma unroll
            for (int cb = 0; cb < 4; ++cb) { o[cb] = MFMA32(v_frag(vimg, 4, 0, cb, lane), p0, o[cb]); o[cb] = MFMA32(v_frag(vimg, 4, 1, cb, lane), p1, o[cb]); }
        }
        if (it + 1 < 16) { B_WRITEV((it + 1) & 1); }
        else if (it + 1 == 16) { *(LAS u32x4*)(VL + (0 * 4 + 0) * 8192 + ((vkey >> 3) * 4 + (vch >> 2)) * 512 + (vkey & 7) * 64 + (vch & 3) * 16) = vnew; }
        __syncthreads();
    }
#undef B_ISSUEV
#undef B_WRITEV
#undef B_ISSUEK
    l += __shfl_xor(l, 32);
    LAS float* MX = (LAS float*)(lds + 73728);
    if (hi == 0) MX[wid * 32 + r32] = m;
    __syncthreads();
    float M = MX[(comp * 4 + 0) * 32 + r32];
#pragma unroll
    for (int j = 1; j < 4; ++j) M = fmaxf(M, MX[(comp * 4 + j) * 32 + r32]);
    const float f = fexp2(m - M);
    l *= f;
#pragma unroll
    for (int cb = 0; cb < 4; ++cb)
#pragma unroll
        for (int r = 0; r < 16; ++r) o[cb][r] *= f;
    if (hi == 0) MX[256 + wid * 32 + r32] = l;
    __syncthreads();
    float L = 0.f;
#pragma unroll
    for (int j = 0; j < 4; ++j) L += MX[256 + (comp * 4 + j) * 32 + r32];
    const float inv = 1.0f / L;
    LAS float* R = (LAS float*)(lds + 8192);
#define B_PUT(slot) do { _Pragma("unroll") for (int cb = 0; cb < 4; ++cb) _Pragma("unroll") for (int r = 0; r < 16; ++r) R[(slot) * 4096 + (cb * 16 + r) * 64 + lane] = o[cb][r]; } while (0)
#define B_ADD(slot) do { _Pragma("unroll") for (int cb = 0; cb < 4; ++cb) _Pragma("unroll") for (int r = 0; r < 16; ++r) o[cb][r] += R[(slot) * 4096 + (cb * 16 + r) * 64 + lane]; } while (0)
    if (q4 >= 2) B_PUT(comp * 2 + (q4 - 2));
    __syncthreads();
    if (q4 < 2) B_ADD(comp * 2 + q4);
    __syncthreads();
    if (q4 == 1) B_PUT(comp);
    __syncthreads();
    if (q4 == 0) { B_ADD(comp);
#pragma unroll
        for (int cb = 0; cb < 4; ++cb)
#pragma unroll
            for (int r = 0; r < 16; ++r) o[cb][r] *= inv; }
    __syncthreads();
    if (q4 == 0 && comp == 1) B_PUT(0);
    __syncthreads();
    if (wid == 0) {
#pragma unroll
        for (int cb = 0; cb < 4; ++cb)
#pragma unroll
            for (int r = 0; r < 16; ++r) o[cb][r] -= lam * R[(cb * 16 + r) * 64 + lane];
        subln_store(o, C.a->in[I_SUBG], C.AO + (trow0 + r32) * DM + h * 128, lane);
    }
    __syncthreads();
#undef B_PUT
#undef B_ADD
}

template <bool SAMPLE>
__device__ __forceinline__ void attnC_unit(const P2Ctx& C, int b, int h, int qblk) {
    LAS unsigned char* lds = C.lds; const int tid = C.tid, lane = C.lane, wid = C.wid;
    const int dvh = wid >> 2, qs = wid & 3, r32 = lane & 31, hi = lane >> 5;
    const size_t trow0 = SAMPLE ? (size_t)(TP + b * DSEQ) : (size_t)(b * SEQ + qblk * 128);
    const int nq = SAMPLE ? DSEQ : 128;
    LAS unsigned char* QL = lds + 65536;
#pragma unroll
    for (int i = 0; i < 8; ++i) { const int idx = tid + 512 * i, row = idx >> 5, ch = idx & 31;
        u32x4 v = (u32x4){0u, 0u, 0u, 0u};
        if (row < nq) v = *(const u32x4*)(C.QC + (trow0 + row) * DM + h * 256 + ch * 8);
        *(LAS u32x4*)(QL + row * 512 + (((ch & 16) | ((ch ^ row) & 15)) << 4)) = v; }
    u32x4 kreg[2], vreg[2];
#define C_ISSUE(kt) do { _Pragma("unroll") for (int i_ = 0; i_ < 2; ++i_) { const int idx_ = tid + 512 * i_, key_ = idx_ >> 5, ch_ = idx_ & 31; const int mrow_ = (kt) * 32 + key_; \
        if (SAMPLE) { const float* pk_ = C.a->in[I_CMK] + (((size_t)(b * 256 + mrow_)) * 4 + h) * 256 + ch_ * 8; const float* pv_ = C.a->in[I_CMV] + (((size_t)(b * 256 + mrow_)) * 4 + h) * 256 + ch_ * 8; \
            kreg[i_] = pack8(*(const f32x4*)pk_, *(const f32x4*)(pk_ + 4)); vreg[i_] = pack8(*(const f32x4*)pv_, *(const f32x4*)(pv_ + 4)); } \
        else { kreg[i_] = *(const u32x4*)(C.MK + ((size_t)(b * 256 + mrow_)) * DM + h * 256 + ch_ * 8); vreg[i_] = *(const u32x4*)(C.MV + ((size_t)(b * 256 + mrow_)) * DM + h * 256 + ch_ * 8); } } } while (0)
#define C_WRITE(st) do { LAS unsigned char* sb_ = lds + (st) * 32768; _Pragma("unroll") for (int i_ = 0; i_ < 2; ++i_) { const int idx_ = tid + 512 * i_, key_ = idx_ >> 5, ch_ = idx_ & 31; \
        *(LAS u32x4*)(sb_ + key_ * 512 + (((ch_ & 16) | ((ch_ ^ key_) & 15)) << 4)) = kreg[i_]; \
        *(LAS u32x4*)(sb_ + 16384 + ((key_ >> 3) * 8 + (ch_ >> 2)) * 512 + (key_ & 7) * 64 + (ch_ & 3) * 16) = vreg[i_]; } } while (0)
    f32x16 o[4];
#pragma unroll
    for (int cb = 0; cb < 4; ++cb)
#pragma unroll
        for (int r = 0; r < 16; ++r) o[cb][r] = 0.f;
    float m = -1e30f, l = 0.f;
    const bool active = SAMPLE ? (qs == 0) : true;
    C_ISSUE(0); C_WRITE(0); __syncthreads();
    for (int kt = 0; kt < 8; ++kt) {
        if (kt + 1 < 8) C_ISSUE(kt + 1);
        if (active) {
            const LAS unsigned char* sb = lds + (kt & 1) * 32768;
            f32x16 s[1];
#pragma unroll
            for (int r = 0; r < 16; ++r) s[0][r] = 0.f;
            const int qrow = qs * 32 + r32;
#pragma unroll
            for (int ds = 0; ds < 16; ++ds) { const int ch = 2 * ds + hi;
                const bf16x8 kf = *(const LAS bf16x8*)(sb + r32 * 512 + (((ch & 16) | ((ch ^ r32) & 15)) << 4));
                const bf16x8 qf = *(const LAS bf16x8*)(QL + qrow * 512 + (((ch & 16) | ((ch ^ qrow) & 15)) << 4));
                s[0] = MFMA32(kf, qf, s[0]); }
            const float alpha = softmax_step<1>(s, m, l);
#pragma unroll
            for (int cb = 0; cb < 4; ++cb)
#pragma unroll
                for (int r = 0; r < 16; ++r) o[cb][r] *= alpha;
            const bf16x8 p0 = pack_p(s[0], 0), p1 = pack_p(s[0], 1);
#pragma unroll
            for (int cb = 0; cb < 4; ++cb) { o[cb] = MFMA32(v_frag(sb + 16384, 8, 0, dvh * 4 + cb, lane), p0, o[cb]); o[cb] = MFMA32(v_frag(sb + 16384, 8, 1, dvh * 4 + cb, lane), p1, o[cb]); }
        }
        if (kt + 1 < 8) C_WRITE((kt + 1) & 1);
        __syncthreads();
    }
#undef C_ISSUE
#undef C_WRITE
    if (active) {
        l += __shfl_xor(l, 32);
        const float inv = 1.0f / l;
        bf16_t* dst = C.CO + (trow0 + qs * 32 + r32) * DM + h * 256 + dvh * 128;
#pragma unroll
        for (int cb = 0; cb < 4; ++cb)
#pragma unroll
            for (int g = 0; g < 4; ++g) { const int dv0 = 32 * cb + 8 * g + 4 * hi;
                u32x2 w; w.x = pk_bf16(o[cb][4 * g + 0] * inv, o[cb][4 * g + 1] * inv); w.y = pk_bf16(o[cb][4 * g + 2] * inv, o[cb][4 * g + 3] * inv);
                *(u32x2*)(dst + dv0) = w; }
    }
    __syncthreads();
}

__device__ __forceinline__ void lru_unit(const P2Ctx& C, int sg, int n) {
    LAS unsigned char* lds = C.lds; const int tid = C.tid, lane = C.lane, wid = C.wid;
    const Args& a = *C.a;
    const bool smp = sg >= 8; const int b = smp ? sg - 8 : sg; const int S = smp ? DSEQ : SEQ; const size_t t0 = smp ? (size_t)(TP + b * DSEQ) : (size_t)(b * SEQ);
    LAS unsigned char* XC = lds;
    LAS float* AA = (LAS float*)(lds + 16384);
    LAS float* UU = (LAS float*)(lds + 49152);
    LAS float* SEG = (LAS float*)(lds + 81920);
    LAS float* CAR = (LAS float*)(lds + 86016);
    const int r32 = lane & 31, hi = lane >> 5, chb = wid & 3, tkb = wid >> 2;
    const int chl = chb * 32 + r32, chg = n * 128 + chl;
    const float ba = a.in[I_BRGA][chg], bx = a.in[I_BRGX][chg];
    const float sp8 = 8.0f * log1pf(expf(-a.in[I_RGL][chg]));
    const int cg = tid & 15;
    if (tid < 128) CAR[tid] = smp ? a.in[I_SLRU][b * 1024 + n * 128 + tid] : 0.f;
    const int nchunks = (S + 63) / 64;
    for (int ck = 0; ck < nchunks; ++ck) {
#pragma unroll
        for (int i = 0; i < 2; ++i) { const int tok = (tid >> 4) + 32 * i, tt = ck * 64 + tok;
            float xc[8];
            { const float* cbp = a.in[I_CONVB] + n * 128 + cg * 8; const f32x4 c0 = *(const f32x4*)cbp, c1 = *(const f32x4*)(cbp + 4);
              xc[0] = c0[0]; xc[1] = c0[1]; xc[2] = c0[2]; xc[3] = c0[3]; xc[4] = c1[0]; xc[5] = c1[1]; xc[6] = c1[2]; xc[7] = c1[3]; }
#pragma unroll
            for (int j = 0; j < 4; ++j) { const int ts = tt - 3 + j; float x[8]; float cw[8];
                { const float* cwp = a.in[I_CONVW] + j * 1024 + n * 128 + cg * 8; const f32x4 c0 = *(const f32x4*)cwp, c1 = *(const f32x4*)(cwp + 4);
                  cw[0] = c0[0]; cw[1] = c0[1]; cw[2] = c0[2]; cw[3] = c0[3]; cw[4] = c1[0]; cw[5] = c1[1]; cw[6] = c1[2]; cw[7] = c1[3]; }
                if (ts >= 0 && ts < S) { const u32x4 w = *(const u32x4*)(C.XB + (t0 + ts) * DM + n * 128 + cg * 8); unpack8(w, x); }
                else if (ts < 0 && smp) { const float* p = a.in[I_SCONV] + (size_t)(b * 3 + ts + 3) * DM + n * 128 + cg * 8; const f32x4 p0 = *(const f32x4*)p, p1 = *(const f32x4*)(p + 4);
                    x[0] = p0[0]; x[1] = p0[1]; x[2] = p0[2]; x[3] = p0[3]; x[4] = p1[0]; x[5] = p1[1]; x[6] = p1[2]; x[7] = p1[3]; }
                else {
#pragma unroll
                    for (int e = 0; e < 8; ++e) x[e] = 0.f; }
#pragma unroll
                for (int e = 0; e < 8; ++e) xc[e] += cw[e] * x[e]; }
            u32x4 w; w.x = pk_bf16(xc[0], xc[1]); w.y = pk_bf16(xc[2], xc[3]); w.z = pk_bf16(xc[4], xc[5]); w.w = pk_bf16(xc[6], xc[7]);
            *(LAS u32x4*)(XC + tok * 256 + ((cg ^ (tok & 15)) << 4)) = w; }
        __syncthreads();
        f32x16 da, dx;
#pragma unroll
        for (int r = 0; r < 16; ++r) { da[r] = 0.f; dx[r] = 0.f; }
        { const int tokA = tkb * 32 + r32;
          const bf16_t* wpa = C.WRG + ((size_t)n * 128 + chl) * 128 + hi * 8; const bf16_t* wpx = wpa + (size_t)8 * 128 * 128;
#pragma unroll
          for (int ks = 0; ks < 8; ++ks) { const bf16x8 xf = *(const LAS bf16x8*)(XC + tokA * 256 + (((2 * ks + hi) ^ (tokA & 15)) << 4));
              const bf16x8 wa = *(const bf16x8*)(wpa + ks * 16), wx = *(const bf16x8*)(wpx + ks * 16);
              da = MFMA32(xf, wa, da); dx = MFMA32(xf, wx, dx); } }
#pragma unroll
        for (int r = 0; r < 16; ++r) { const int tokl = tkb * 32 + crow(r, hi);
            const float xcv = bf2f(*(const LAS bf16_t*)(XC + tokl * 256 + ((((chl >> 3)) ^ (tokl & 15)) << 4) + (chl & 7) * 2));
            const float rg = sigmoidf_(da[r] + ba), ig = sigmoidf_(dx[r] + bx);
            const float log_a = -sp8 * rg;
            const float x2 = 2.0f * log_a;
            const float om = x2 > -0.25f ? -x2 * (1.0f + x2 * (0.5f + x2 * (0.16666667f + x2 * (0.041666668f + x2 * 0.0083333333f)))) : 1.0f - fexp2(x2 * LOG2E);
            float av = fexp2(log_a * LOG2E), uv = sqrtf(om) * (ig * xcv);
            if (ck * 64 + tokl >= S) { av = 1.0f; uv = 0.f; }
            AA[tokl * 128 + chl] = av; UU[tokl * 128 + chl] = uv; }
        __syncthreads();
        { const int c = tid & 127, seg = tid >> 7;
          float A = 1.f, B = 0.f;
#pragma unroll
          for (int t = 0; t < 16; ++t) { const int tok = seg * 16 + t; const float av = AA[tok * 128 + c], uv = UU[tok * 128 + c]; B = av * B + uv; A *= av; }
          SEG[(seg * 128 + c) * 2] = A; SEG[(seg * 128 + c) * 2 + 1] = B;
          __syncthreads();
          float hin = CAR[c];
          for (int s = 0; s < seg; ++s) hin = SEG[(s * 128 + c) * 2] * hin + SEG[(s * 128 + c) * 2 + 1];
          float hv = hin;
#pragma unroll
          for (int t = 0; t < 16; ++t) { const int tok = seg * 16 + t, tt = ck * 64 + tok; const float av = AA[tok * 128 + c], uv = UU[tok * 128 + c]; hv = av * hv + uv;
              if (tt < S) { const size_t off = (t0 + tt) * DM + n * 128 + c; const float gg = bf2f(C.GG[off]);
                  C.BO[off] = (bf16_t)(pk_bf16(hv * gg, 0.f) & 0xffffu); } }
          __syncthreads();
          if (seg == 3) CAR[c] = hv; }
    }
    __syncthreads();
    if (tid < 128) a.out[(smp ? O_HS : O_HP) + (size_t)b * 1024 + n * 128 + tid] = CAR[tid];
    __syncthreads();
}

constexpr int P2_N_LRU_P = 64, P2_N_B = 128, P2_N_A = 1024, P2_N_CP = 512, P2_N_CS = 64, P2_N_LRU_S = 128;
constexpr int P2_NITEMS = P2_N_LRU_P + P2_N_B + P2_N_A + P2_N_CP + P2_N_CS + P2_N_LRU_S;
__device__ __forceinline__ void p2_mixers(const Args& a, LAS unsigned char* lds, int tid, int lane, int wid) {
    unsigned char* ws0 = a.ws;
    { LAS float* lut = (LAS float*)(lds + LUT_OFF);
      for (int e = tid; e < 8 * 256; e += 512) { const int h = e >> 8, rel = (e & 255) - 192; const int nn = rel < 0 ? -rel : rel;
          int bk = nn < 8 ? nn : (nn >= 91 ? 15 : nn >= 64 ? 14 : nn >= 46 ? 13 : nn >= 32 ? 12 : nn >= 23 ? 11 : nn >= 16 ? 10 : nn >= 12 ? 9 : 8);
          if (rel > 0) bk += 16;
          lut[e] = a.in[I_REL][bk * 8 + h] * LOG2E; }
      if (tid < 64) { float d1 = a.in[I_LQ1][tid] * a.in[I_LK1][tid], d2 = a.in[I_LQ2][tid] * a.in[I_LK2][tid]; d1 = wave_sum(d1); d2 = wave_sum(d2);
          if (tid == 0) *(LAS float*)(lds + LAM_OFF) = expf(d1) - expf(d2) + LAMBDA_INIT; } }
    __syncthreads();
    unsigned* queue = (unsigned*)(ws0 + WS_CTL) + CW_QUEUE;
    volatile LAS unsigned* slot = (volatile LAS unsigned*)(lds + MISC_OFF + 64);
    for (;;) {
        if (tid == 0) *slot = __hip_atomic_fetch_add(queue, 1u, __ATOMIC_RELAXED, __HIP_MEMORY_SCOPE_AGENT);
        __syncthreads();
        int it = (int)*slot;
        __syncthreads();
        if (it >= P2_NITEMS) break;
        int tid_ = tid; asm volatile("" : "+v"(tid_));
        unsigned char* ws = ws0; asm volatile("" : "+s"(ws));
        P2Ctx C; C.a = &a; C.lds = lds; C.tid = tid_; C.lane = tid_ & 63; C.wid = __builtin_amdgcn_readfirstlane(tid_ >> 6);
        C.Q = (const bf16_t*)(ws + WS_Q); C.Kb = (const bf16_t*)(ws + WS_K); C.Vb = (const bf16_t*)(ws + WS_V); C.XB = (const bf16_t*)(ws + WS_XB); C.GG = (const bf16_t*)(ws + WS_GG);
        C.QC = (const bf16_t*)(ws + WS_QC); C.MK = (const bf16_t*)(ws + WS_MK); C.MV = (const bf16_t*)(ws + WS_MV); C.WRG = (const bf16_t*)(ws + WS_WRG);
        C.AO = (bf16_t*)(ws + WS_AO); C.BO = (bf16_t*)(ws + WS_BO); C.CO = (bf16_t*)(ws + WS_CO);
#ifndef UNIT_MASK
#define UNIT_MASK 0xFF
#endif
        if (it < P2_N_LRU_P) { if (UNIT_MASK & 1) lru_unit(C, it >> 3, it & 7); continue; } it -= P2_N_LRU_P;
        if (it < P2_N_B) { if (UNIT_MASK & 2) attnB_unit(C, it >> 3, it & 7); continue; } it -= P2_N_B;
        if (it < P2_N_A) { const int qb = 15 - (it >> 6), bh = it & 63; if (UNIT_MASK & 4) attnA_unit(C, bh >> 3, bh & 7, qb); continue; } it -= P2_N_A;
        if (it < P2_N_CP) { const int qblk = it & 15, bh = it >> 4; if (UNIT_MASK & 8) attnC_unit<false>(C, bh >> 2, bh & 3, qblk); continue; } it -= P2_N_CP;
        if (it < P2_N_CS) { if (UNIT_MASK & 16) attnC_unit<true>(C, it >> 2, it & 3, 0); continue; } it -= P2_N_CS;
        if (UNIT_MASK & 1) lru_unit(C, 8 + (it >> 3), it & 7);
    }
}

__device__ __forceinline__ void p7_final(const Args& a, int gw, int NGW, int lane) {
    const float* X2 = (const float*)(a.ws + WS_X1);
    const f32x4* gr = (const f32x4*)a.in[I_NFIN] + lane;
    for (int mrow = gw; mrow < TT; mrow += NGW) {
        const f32x4* xr = (const f32x4*)(X2 + (size_t)mrow * DM) + lane;
        f32x4 v[4]; float s = 0.f;
#pragma unroll
        for (int j = 0; j < 4; ++j) { v[j] = xr[64 * j]; s += (v[j].x * v[j].x + v[j].y * v[j].y) + (v[j].z * v[j].z + v[j].w * v[j].w); }
        const float rstd = 1.0f / sqrtf(wave_sum(s) * (1.0f / 1024.0f) + EPS);
        f32x4* o = (f32x4*)(a.out + (mrow < TP ? O_YP + (size_t)mrow * DM : O_YS + (size_t)(mrow - TP) * DM)) + lane;
#pragma unroll
        for (int j = 0; j < 4; ++j) { const f32x4 g = gr[64 * j]; o[64 * j] = v[j] * rstd * g; }
    }
}

constexpr int N_PHASES = 8;
__global__ void __launch_bounds__(NWAVES * 64, 2) fwd_kernel(Args args) {
    __shared__ __attribute__((aligned(16))) unsigned char lds_raw[LDS_BYTES];
    LAS unsigned char* lds = (LAS unsigned char*)lds_raw;
    const int tid = threadIdx.x, lane = tid & 63, wave = __builtin_amdgcn_readfirstlane(tid >> 6);
    const int G = gridDim.x, bx = blockIdx.x;
    const int vcu = (G % 8 == 0) ? (bx % 8) * (G / 8) + bx / 8 : bx;
    const int gw = vcu * NWAVES + wave, NGW = G * NWAVES;
    unsigned char* ws = args.ws;
    unsigned* ctl = (unsigned*)(ws + WS_CTL);
    for (int u = tid; u < (LDS_BYTES - EXTRA_OFF) / 4; u += NWAVES * 64) ((LAS unsigned*)(lds + EXTRA_OFF))[u] = 0u;
    __syncthreads();
    XcdBarrier bar; bar.bar = ctl + CW_BAR; bar.x = 0; bar.st = nullptr;
    if (MK_N_LAUNCHES == 1) bar = xcd_barrier_post(ctl + CW_BAR, (volatile LAS unsigned*)(lds + MISC_OFF + 32));
    const int lo = args.ph_lo, hi = args.ph_hi;
#ifndef PH_MASK
#define PH_MASK 0xFF
#endif
#define IN(k) (((PH_MASK >> (k)) & 1) && lo <= (k) && (k) < hi)
#define SEAM(k) do { if (IN(k) && IN((k) + 1)) xcd_barrier(bar); } while (0)

    if (IN(0)) { p0_prologue(args, lds, gw, NGW, wave, lane); }
    SEAM(0);
    if (IN(1)) {
        Sched1 S{(const char*)(ws + WS_XN), (const char*)(ws + WS_WCAT), G, bx};
        Epi1 E{(bf16_t*)(ws + WS_Q), (bf16_t*)(ws + WS_K), (bf16_t*)(ws + WS_V), (bf16_t*)(ws + WS_XB), (bf16_t*)(ws + WS_GG), (bf16_t*)(ws + WS_QC), (bf16_t*)(ws + WS_G),
               (bf16_t*)(ws + WS_MK), (bf16_t*)(ws + WS_MV), args.out, args.in[I_BGATE]};
        pg8::gemm_phase(lds, 1024, S, E);
    }
    SEAM(1);
    if (IN(2)) { p2_mixers(args, lds, tid, lane, wave); }
    SEAM(2);
    if (IN(3)) {
        Sched2 S{(const char*)(ws + WS_AO), (const char*)(ws + WS_BO), (const char*)(ws + WS_CO), (const char*)(ws + WS_WP), G, bx};
        Epi2 E{(const bf16_t*)(ws + WS_G), (bf16_t*)(ws + WS_MG), (float*)(ws + WS_X1)};
        pg8::gemm_phase(lds, 1024, S, E);
    }
    SEAM(3);
    if (IN(4)) {
        SchedT S{(const char*)(ws + WS_MG), (const char*)(ws + WS_WO), 66, 4, 1024, G, bx};
        Epi3 E{args.in[I_XP], args.in[I_XS], (float*)(ws + WS_X1), (bf16_t*)(ws + WS_X1B), (float*)(ws + WS_SS)};
        pg8::gemm_phase(lds, 1024, S, E);
    }
    SEAM(4);
    if (IN(5)) {
        SchedT S{(const char*)(ws + WS_X1B), (const char*)(ws + WS_WFI), 66, 22, 1024, G, bx};
        Epi4 E{(const float*)(ws + WS_SS), (bf16_t*)(ws + WS_ACT)};
        pg8::gemm_phase(lds, 1024, S, E);
    }
    SEAM(5);
    if (IN(6)) {
        SchedT S{(const char*)(ws + WS_ACT), (const char*)(ws + WS_WFO), 66, 4, DFF, G, bx};
        Epi5 E{(float*)(ws + WS_X1)};
        pg8::gemm_phase(lds, DFF, S, E);
    }
    SEAM(6);
    if (IN(7)) { p7_final(args, gw, NGW, lane); }
#undef IN
#undef SEAM
}

extern "C" void kernel_launch(void* const* d_in, const int* in_sizes, int n_in, void* d_out, int out_size, void* d_ws, size_t ws_size, hipStream_t stream) {
    static int grid = 0;
    if (grid == 0) {
        if (n_in != 36 || out_size != (int)O_END || ws_size < WS_END) { fprintf(stderr, "kernel_launch: unexpected problem (n_in %d, out %d, ws %zu); nothing launched\n", n_in, out_size, ws_size); grid = -1; return; }
        int dev = 0, cus = 0;
        if (hipGetDevice(&dev) != hipSuccess || hipDeviceGetAttribute(&cus, hipDeviceAttributeMultiprocessorCount, dev) != hipSuccess) { grid = -1; return; }
        int per_cu = 0;
        if (hipOccupancyMaxActiveBlocksPerMultiprocessor(&per_cu, (const void*)fwd_kernel, NWAVES * 64, 0) != hipSuccess || per_cu < 1)
            fprintf(stderr, "kernel_launch: note: occupancy query reports %d workgroups per CU\n", per_cu);
        (void)hipGetLastError();
        grid = cus;
    }
    if (grid < 0) return;
    (void)hipMemsetAsync((char*)d_ws + WS_CTL, 0, CTL_ZERO_BYTES, stream);
    Args a{};
    for (int i = 0; i < 36; ++i) a.in[i] = (const float*)d_in[i];
    a.out = (float*)d_out; a.ws = (unsigned char*)d_ws;
    if (MK_N_LAUNCHES == 1) { a.ph_lo = 0; a.ph_hi = N_PHASES; a.li = 0; hipLaunchKernelGGL(fwd_kernel, dim3(grid), dim3(NWAVES * 64), 0, stream, a); }
    else for (int li = 0; li < N_PHASES; ++li) { a.ph_lo = li; a.ph_hi = li + 1; a.li = li; hipLaunchKernelGGL(fwd_kernel, dim3(grid), dim3(NWAVES * 64), 0, stream, a); }
}
```

```cpp
#include <hip/hip_runtime.h>
#include <cstdio>
#include <cstdint>

#ifndef MK_N_LAUNCHES
#define MK_N_LAUNCHES 1
#endif

#define LAS __attribute__((address_space(3)))
#define GAS __attribute__((address_space(1)))
typedef unsigned short bf16_t;
typedef short bf16x8 __attribute__((ext_vector_type(8)));
typedef short s16x4 __attribute__((ext_vector_type(4)));
typedef float f32x2 __attribute__((ext_vector_type(2)));
typedef float f32x4 __attribute__((ext_vector_type(4)));
typedef float f32x16 __attribute__((ext_vector_type(16)));
typedef unsigned u32x2 __attribute__((ext_vector_type(2)));
typedef unsigned u32x4 __attribute__((ext_vector_type(4)));
typedef __bf16 bf16x2_t __attribute__((ext_vector_type(2)));

constexpr int DM = 1024, TP = 16384, TS = 512, TT = TP + TS, TMEM = 2048, TALL = TT + TMEM;
constexpr int SEQ = 2048, NBATCH = 8, DSEQ = 32, DBATCH = 16, PAST = 2048;
constexpr int INW = 6144, GATEW = 3072, DFF = 2816;
constexpr float EPS = 1e-6f;
constexpr float LOG2E = 1.4426950408889634f;
constexpr float QSCALE = 0.125f * LOG2E;
constexpr float CSCALE = 0.0625f * LOG2E;
constexpr float LAMBDA_INIT = 0.2f;

constexpr size_t O_YP = 0, O_YS = 16777216, O_KP = 17301504, O_VP = 34078720, O_CP = 50855936, O_HP = 50880512,
                 O_MKP = 50888704, O_MVP = 52985856, O_KS = 55083008, O_VS = 55607296, O_CS = 56131584, O_HS = 56180736, O_END = 56197120;

constexpr size_t MiB = 1u << 20;
constexpr size_t WS_CTL = 0, CTL_ZERO_BYTES = 1 * MiB;
constexpr size_t WS_WCAT = 1 * MiB;
constexpr size_t WS_WP = 23 * MiB;
constexpr size_t WS_WO = 29 * MiB;
constexpr size_t WS_WFI = 31 * MiB;
constexpr size_t WS_WFO = 42 * MiB;
constexpr size_t WS_WRG = 47 * MiB + 512 * 1024;
constexpr size_t WS_XN = 48 * MiB;
constexpr size_t WS_MK = 85 * MiB, WS_MV = 89 * MiB;
constexpr size_t WS_Q = 93 * MiB, WS_K = 126 * MiB, WS_V = 159 * MiB, WS_XB = 192 * MiB, WS_GG = 225 * MiB, WS_QC = 258 * MiB;
constexpr size_t WS_G = 291 * MiB;
constexpr size_t WS_AO = 390 * MiB, WS_BO = 423 * MiB, WS_CO = 456 * MiB;
constexpr size_t WS_MG = 48 * MiB;
constexpr size_t WS_X1B = 291 * MiB;
constexpr size_t WS_X1 = 192 * MiB;
constexpr size_t WS_ACT = 93 * MiB;
constexpr size_t WS_SS = 489 * MiB;
constexpr size_t WS_END = 491 * MiB;
constexpr int CW_BAR = 4096, CW_QUEUE = 16384;

constexpr int RING_BYTES = 131072, EXTRA_OFF = RING_BYTES, MISC_OFF = EXTRA_OFF + 320, LAM_OFF = EXTRA_OFF + 512, LUT_OFF = EXTRA_OFF + 1024;
constexpr int LDS_BYTES = 147456;
constexpr int NWAVES = 8;

__device__ __forceinline__ unsigned pk_bf16(float lo, float hi) { f32x2 v = {lo, hi}; bf16x2_t b = __builtin_convertvector(v, bf16x2_t); return __builtin_bit_cast(unsigned, b); }
__device__ __forceinline__ float bf_lo(unsigned u) { return __uint_as_float(u << 16); }
__device__ __forceinline__ float bf_hi(unsigned u) { return __uint_as_float(u & 0xffff0000u); }
__device__ __forceinline__ float bf2f(bf16_t v) { return __uint_as_float(((unsigned)v) << 16); }
__device__ __forceinline__ float fexp2(float x) { return __builtin_amdgcn_exp2f(x); }
__device__ __forceinline__ float frcp(float x) { return __builtin_amdgcn_rcpf(x); }
__device__ __forceinline__ float sigmoidf_(float x) { return frcp(1.0f + fexp2(-x * LOG2E)); }
__device__ __forceinline__ float gelu_tanh(float x) { const float z = 1.5957691216057308f * (x + 0.044715f * x * x * x); return x * frcp(1.0f + fexp2(-z * LOG2E)); }
__device__ __forceinline__ int crow(int r, int hi) { return (r & 3) + 8 * (r >> 2) + 4 * hi; }
__device__ __forceinline__ u32x4 pack8(f32x4 a, f32x4 b) { u32x4 w; w.x = pk_bf16(a[0], a[1]); w.y = pk_bf16(a[2], a[3]); w.z = pk_bf16(b[0], b[1]); w.w = pk_bf16(b[2], b[3]); return w; }
__device__ __forceinline__ void unpack8(u32x4 w, float* f) { f[0] = bf_lo(w.x); f[1] = bf_hi(w.x); f[2] = bf_lo(w.y); f[3] = bf_hi(w.y); f[4] = bf_lo(w.z); f[5] = bf_hi(w.z); f[6] = bf_lo(w.w); f[7] = bf_hi(w.w); }
__device__ __forceinline__ float wave_sum(float v) {
#pragma unroll
    for (int o = 1; o < 64; o <<= 1) v += __shfl_xor(v, o);
    return v;
}
__device__ __forceinline__ s16x4 vtr(const LAS unsigned char* p) { return __builtin_bit_cast(s16x4, __builtin_amdgcn_ds_read_tr16_b64_v4i16((LAS s16x4*)p)); }
#define MFMA32(a, b, c) __builtin_amdgcn_mfma_f32_32x32x16_bf16((a), (b), (c), 0, 0, 0)

namespace pg8 {
constexpr int BM = 256, BK = 64, HALF = 128, HTB = HALF * BK * 2, STAGE_BYTES = 8 * HTB, NXCD = 8, WGM = 8;
__host__ __device__ __forceinline__ int lds_byte(int r, int c) { const int st = (r >> 4) * 2 + (c >> 5), rr = r & 15, cc = c & 31, ob = rr * 64 + cc * 2; return st * 1024 + (ob ^ (((ob >> 9) & 1) << 5)); }
__host__ __device__ __forceinline__ void stage_rc(int b, int& R, int& C) { const int st = b / 1024, sb = b % 1024, swz = sb ^ (((sb >> 9) & 1) << 5); R = (st >> 1) * 16 + swz / 64; C = (st & 1) * 32 + (swz % 64) / 2; }
__host__ __device__ __forceinline__ int perm32(int rho) { const int n = rho >> 4, i = rho & 15; return 8 * (i >> 2) + 4 * n + (i & 3); }

struct Unit { const char* A; const char* B; int pm, pn, kind; };

__device__ __forceinline__ void tile_order(int L, int nM, int nN, int& pm, int& pn) {
    const int nwg = nM * nN; int wgid = L;
    { const int q = nwg / NXCD, r = nwg % NXCD, xcd = wgid % NXCD, off = wgid / NXCD; wgid = (xcd < r ? xcd * (q + 1) : r * (q + 1) + (xcd - r) * q) + off; }
    const int nig = WGM * nN, gid = wgid / nig, fm = gid * WGM, gsz = (nM - fm) < WGM ? (nM - fm) : WGM;
    pm = fm + ((wgid % nig) % gsz); pn = (wgid % nig) / gsz;
}

template <class Epi, class Sched>
__device__ __forceinline__ void gemm_phase(LAS unsigned char* lds, const int K, const Sched& S, const Epi& E) {
    const int tid = threadIdx.x, wid = __builtin_amdgcn_readfirstlane(tid >> 6), lane = tid & 63, wr = wid >> 2, wc = wid & 3, fr = lane & 15, fq = lane >> 4;
    const int nt = K / BK;
    unsigned voffA[2], voffB[2];
#pragma unroll
    for (int i = 0; i < 2; ++i) { int R, C; stage_rc(tid * 16 + i * 8192, R, C); const int Rb = (R & ~31) + perm32(R & 31);
        voffA[i] = (unsigned)(R * K + C) * 2u; voffB[i] = (unsigned)(Rb * K + C) * 2u; }
    const size_t kstep = (size_t)(BK * 2);
    const size_t hstep = (size_t)HALF * K * 2;
    const unsigned ldsw = (unsigned)wid * 1024u;
    const int aoff = lds_byte(wr * 64 + fr, fq * 8), boff = lds_byte(wc * 32 + fr, fq * 8);
#define PG8_SA(b, h) (((b) * 2 + (h)) * HTB)
#define PG8_SB(b, h) ((4 + (b) * 2 + (h)) * HTB)
#define PG8_STAGE(bufoff, gbase, voff) do { _Pragma("unroll") for (int _i = 0; _i < 2; ++_i) \
        __builtin_amdgcn_global_load_lds((const unsigned*)((const char*)(gbase) + (voff)[_i]), (LAS unsigned*)(lds + (bufoff) + ldsw + _i * 8192), 16, 0, 0); } while (0)
#define PG8_LDA(dst, b, h) do { _Pragma("unroll") for (int m = 0; m < 4; ++m) _Pragma("unroll") for (int k = 0; k < 2; ++k) dst[m][k] = *(const LAS bf16x8*)(lds + PG8_SA(b, h) + aoff + m * 2048 + k * 1024); } while (0)
#define PG8_LDB(dst, b, h) do { _Pragma("unroll") for (int n = 0; n < 2; ++n) _Pragma("unroll") for (int k = 0; k < 2; ++k) dst[n][k] = *(const LAS bf16x8*)(lds + PG8_SB(b, h) + boff + n * 2048 + k * 1024); } while (0)
#define PG8_MMA(ai, bj, At, Bt) do { __builtin_amdgcn_s_setprio(1); _Pragma("unroll") for (int m = 0; m < 4; ++m) _Pragma("unroll") for (int n = 0; n < 2; ++n) _Pragma("unroll") for (int k = 0; k < 2; ++k) \
        acc[ai][bj][m][n] = __builtin_amdgcn_mfma_f32_16x16x32_bf16(Bt[n][k], At[m][k], acc[ai][bj][m][n], 0, 0, 0); __builtin_amdgcn_s_setprio(0); } while (0)
#define PG8_WAIT_V(n) asm volatile("s_waitcnt vmcnt(" #n ")" ::: "memory")
#define PG8_WAIT_L(n) asm volatile("s_waitcnt lgkmcnt(" #n ")" ::: "memory")
#define PG8_BAR __builtin_amdgcn_s_barrier()
#define PG8_SCHED __builtin_amdgcn_sched_barrier(0)
#define PG8_ZERO() do { _Pragma("unroll") for (int a = 0; a < 2; ++a) _Pragma("unroll") for (int b = 0; b < 2; ++b) _Pragma("unroll") for (int m = 0; m < 4; ++m) _Pragma("unroll") for (int n = 0; n < 2; ++n) acc[a][b][m][n] = (f32x4){0.f, 0.f, 0.f, 0.f}; } while (0)
    Unit cur, nxt; int ui = 0;
    if (!S.next(0, cur)) return;
    f32x4 acc[2][2][4][2];
    PG8_ZERO();
    bf16x8 At[4][2], B0[2][2], B1[2][2];
    const char* cA = cur.A; const char* cB = cur.B;
    PG8_STAGE(PG8_SB(0, 0), cB, voffB); PG8_STAGE(PG8_SB(0, 1), cB + hstep, voffB); PG8_STAGE(PG8_SA(0, 0), cA, voffA); PG8_STAGE(PG8_SA(0, 1), cA + hstep, voffA);
    if (wr == 1) PG8_BAR;
    PG8_WAIT_V(2); PG8_BAR;
    PG8_STAGE(PG8_SB(1, 0), cB + kstep, voffB); PG8_STAGE(PG8_SA(1, 0), cA + kstep, voffA); PG8_STAGE(PG8_SB(1, 1), cB + hstep + kstep, voffB);
    PG8_WAIT_V(6); PG8_BAR;
    for (;;) {
        const bool has_next = S.next(ui + 1, nxt);
        const char* nA = has_next ? nxt.A : cA; const char* nB = has_next ? nxt.B : cB;
        for (int t = 0; t < nt; t += 2) {
            const bool last = (t == nt - 2);
            const char* a1 = cA + (size_t)(t + 1) * kstep;
            const char* a2 = last ? nA : cA + (size_t)(t + 2) * kstep; const char* b2 = last ? nB : cB + (size_t)(t + 2) * kstep;
            const char* a3 = a2 + kstep; const char* b3 = b2 + kstep;
            PG8_LDB(B0, 0, 0); PG8_LDB(B1, 0, 1); PG8_SCHED; PG8_LDA(At, 0, 0); PG8_STAGE(PG8_SA(1, 1), a1 + hstep, voffA);
            PG8_WAIT_V(8); PG8_WAIT_L(0); PG8_BAR; PG8_MMA(0, 0, At, B0); PG8_MMA(0, 1, At, B1); PG8_BAR; PG8_SCHED;
            PG8_LDA(At, 0, 1); PG8_STAGE(PG8_SB(0, 0), b2, voffB); PG8_STAGE(PG8_SB(0, 1), b2 + hstep, voffB); PG8_STAGE(PG8_SA(0, 0), a2, voffA);
            PG8_WAIT_V(8); PG8_WAIT_L(0); PG8_BAR; PG8_MMA(1, 0, At, B0); PG8_MMA(1, 1, At, B1); PG8_BAR; PG8_SCHED;
            PG8_LDB(B0, 1, 0); PG8_LDB(B1, 1, 1); PG8_SCHED; PG8_LDA(At, 1, 0); PG8_STAGE(PG8_SA(0, 1), a2 + hstep, voffA);
            PG8_WAIT_V(8); PG8_WAIT_L(0); PG8_BAR; PG8_MMA(0, 0, At, B0); PG8_MMA(0, 1, At, B1); PG8_BAR; PG8_SCHED;
            PG8_LDA(At, 1, 1); PG8_STAGE(PG8_SB(1, 0), b3, voffB); PG8_STAGE(PG8_SB(1, 1), b3 + hstep, voffB); PG8_STAGE(PG8_SA(1, 0), a3, voffA);
            PG8_WAIT_V(8); PG8_WAIT_L(0); PG8_BAR; PG8_MMA(1, 0, At, B0); PG8_MMA(1, 1, At, B1); PG8_BAR; PG8_SCHED;
        }
        if (wr == 0) PG8_BAR;
        const bool zero = E(acc, cur, wr, wc, fr, fq);
        if (!has_next) break;
        if (zero) PG8_ZERO();
        cur = nxt; cA = nA; cB = nB; ++ui;
        if (wr == 1) PG8_BAR;
    }
    PG8_WAIT_V(0);
    PG8_BAR;
#undef PG8_SA
#undef PG8_SB
#undef PG8_STAGE
#undef PG8_LDA
#undef PG8_LDB
#undef PG8_MMA
#undef PG8_WAIT_V
#undef PG8_WAIT_L
#undef PG8_BAR
#undef PG8_SCHED
#undef PG8_ZERO
}
}

#define TILE_FOR(...) \
    _Pragma("unroll") for (int ai = 0; ai < 2; ++ai) _Pragma("unroll") for (int m = 0; m < 4; ++m) { const int row = rowb + ai * 128 + m * 16; \
    _Pragma("unroll") for (int bj = 0; bj < 2; ++bj) { const int col = colb + bj * 128; f32x4& v0 = acc[ai][bj][m][0]; f32x4& v1 = acc[ai][bj][m][1]; __VA_ARGS__ } }

#define XB_TMO      128
#define XB_XCNT(j)  (256  + 64 * (j))
#define XB_XSUB(j)  (1280 + 64 * (j))
#define XB_XGEN(j)  (2304 + 64 * (j))
#define XB_TOP      3328
#define XB_TOPGEN   3392
#define XCD_BAR_WORDS 3456
#define XB_SPIN_CAP (1u << 18)
__device__ __forceinline__ unsigned xb_ld(unsigned* p)              { return __hip_atomic_load(p, __ATOMIC_RELAXED, __HIP_MEMORY_SCOPE_AGENT); }
__device__ __forceinline__ unsigned xb_add(unsigned* p, unsigned v) { return __hip_atomic_fetch_add(p, v, __ATOMIC_RELAXED, __HIP_MEMORY_SCOPE_AGENT); }
__device__ __forceinline__ unsigned xb_xcc_id() { return (unsigned)__builtin_amdgcn_s_getreg((3 << 11) | 20) & 0xFu; }
#define XB_SPIN(cond, bar) do { unsigned _sp = 0; while (cond) { __builtin_amdgcn_s_sleep(1); \
    if ((++_sp & 255u) == 0u) { if (xb_ld(&(bar)[XB_TMO])) break; if (_sp > XB_SPIN_CAP) { atomicAdd(&(bar)[XB_TMO], 1u); break; } } } } while (0)
struct XcdBarrier { unsigned* bar; unsigned x; volatile LAS unsigned* st; };
__device__ __forceinline__ XcdBarrier xcd_barrier_post(unsigned* bar, volatile LAS unsigned* st) {
    XcdBarrier b; b.bar = bar; b.x = xb_xcc_id(); b.st = st;
    if (threadIdx.x == 0) (void)xb_add(&bar[XB_XCNT(b.x)], 1u);
    return b;
}
__device__ __forceinline__ void xcd_barrier_complete(unsigned* bar, unsigned x, unsigned& nloc, unsigned& nx) {
    const unsigned G = gridDim.x * gridDim.y * gridDim.z;
    unsigned sum, cnt, mine, sp = 0u;
    for (;;) {
        sum = 0u; cnt = 0u; mine = 0u;
#pragma unroll
        for (unsigned j = 0; j < 16; ++j) { const unsigned c = xb_ld(&bar[XB_XCNT(j)]); sum += c; cnt += (c > 0u) ? 1u : 0u; mine = (j == x) ? c : mine; }
        if (sum == G) break;
        __builtin_amdgcn_s_sleep(1);
        if ((++sp & 255u) == 0u) { if (xb_ld(&bar[XB_TMO])) break; if (sp > XB_SPIN_CAP) { atomicAdd(&bar[XB_TMO], 1u); break; } }
    }
    nloc = mine > 0u ? mine : 1u; nx = cnt > 0u ? cnt : 1u;
}
__device__ __forceinline__ void xcd_barrier(const XcdBarrier& b) {
    asm volatile("s_waitcnt vmcnt(0)" ::: "memory");
    __syncthreads();
    if (threadIdx.x == 0) {
        unsigned* bar = b.bar;
        __builtin_amdgcn_s_waitcnt(0);
        unsigned nloc = b.st[0], nx = b.st[1];
        if (nloc == 0u) { xcd_barrier_complete(bar, b.x, nloc, nx); b.st[0] = nloc; b.st[1] = nx; }
        const unsigned old = xb_add(&bar[XB_XSUB(b.x)], 1u);
        const unsigned gen = old / nloc;
        if (old + 1u == (gen + 1u) * nloc) {
            __builtin_amdgcn_fence(__ATOMIC_RELEASE, "agent");
            asm volatile("s_waitcnt vmcnt(0)" ::: "memory");
            const unsigned og = xb_add(&bar[XB_TOP], 1u);
            const unsigned tg = og / nx;
            if (og + 1u == (tg + 1u) * nx) xb_add(&bar[XB_TOPGEN], 1u);
            else XB_SPIN(xb_ld(&bar[XB_TOPGEN]) == tg, bar);
            __builtin_amdgcn_fence(__ATOMIC_ACQUIRE, "agent");
            xb_add(&bar[XB_XGEN(b.x)], 1u);
            asm volatile("s_waitcnt vmcnt(0)" ::: "memory");
        } else {
            XB_SPIN(xb_ld(&bar[XB_XGEN(b.x)]) == gen, bar);
            __builtin_amdgcn_fence(__ATOMIC_ACQUIRE, "agent");
            asm volatile("s_waitcnt vmcnt(0)" ::: "memory");
        }
    }
    __syncthreads();
}

struct Args { const float* in[36]; float* out; unsigned char* ws; int ph_lo, ph_hi, li, pad; };
enum { I_XP = 0, I_XS, I_MEM, I_CK, I_CV, I_SCONV, I_SLRU, I_CMK, I_CMV, I_REL, I_NMIX, I_WIN, I_LQ1, I_LK1, I_LQ2, I_LK2, I_SUBG, I_CONVW, I_CONVB,
       I_WRGA, I_BRGA, I_WRGX, I_BRGX, I_RGL, I_NMEM, I_WMEM, I_WPA, I_WPB, I_WPC, I_WGATE, I_BGATE, I_WOUT, I_NFFN, I_WFI, I_WFO, I_NFIN };

__device__ __forceinline__ void transpose_item(const float* W, int K, int N, bf16_t* WT, int kb, int nb, int dst_row0, const float* kscale, LAS float* scr, int lane) {
    const int k0 = 64 * kb, n0 = 32 * nb;
#pragma unroll 8
    for (int i = 0; i < 32; ++i) { const int kk = 2 * i + (lane >> 5); scr[kk * 33 + (lane & 31)] = W[(size_t)(k0 + kk) * N + n0 + (lane & 31)]; }
    asm volatile("s_waitcnt lgkmcnt(0)" ::: "memory");
    const int c = lane & 7;
    float sc[8];
#pragma unroll
    for (int e = 0; e < 8; ++e) sc[e] = kscale ? kscale[k0 + 8 * c + e] : 1.0f;
#pragma unroll
    for (int j = 0; j < 4; ++j) { const int n = (lane >> 3) + 8 * j; const LAS float* s = scr + (8 * c) * 33 + n;
        u32x4 o; o.x = pk_bf16(s[0 * 33] * sc[0], s[1 * 33] * sc[1]); o.y = pk_bf16(s[2 * 33] * sc[2], s[3 * 33] * sc[3]);
        o.z = pk_bf16(s[4 * 33] * sc[4], s[5 * 33] * sc[5]); o.w = pk_bf16(s[6 * 33] * sc[6], s[7 * 33] * sc[7]);
        *(u32x4*)(WT + (size_t)(dst_row0 + n) * K + k0 + 8 * c) = o; }
    asm volatile("s_waitcnt lgkmcnt(0)" ::: "memory");
}
__device__ __forceinline__ void norm_row_bf16(const float* xrow, const float* gain, bf16_t* orow, int lane) {
    const f32x4* xr = (const f32x4*)xrow + lane; const f32x4* gr = (const f32x4*)gain + lane;
    f32x4 v[4]; float s = 0.f;
#pragma unroll
    for (int j = 0; j < 4; ++j) { v[j] = xr[64 * j]; s += (v[j].x * v[j].x + v[j].y * v[j].y) + (v[j].z * v[j].z + v[j].w * v[j].w); }
    const float rstd = 1.0f / sqrtf(wave_sum(s) * (1.0f / 1024.0f) + EPS);
    u32x2* o8 = (u32x2*)orow + lane;
#pragma unroll
    for (int j = 0; j < 4; ++j) { const f32x4 g = gr[64 * j]; u32x2 w; w.x = pk_bf16(v[j].x * rstd * g.x, v[j].y * rstd * g.y); w.y = pk_bf16(v[j].z * rstd * g.z, v[j].w * rstd * g.w); o8[64 * j] = w; }
}
__device__ __forceinline__ void p0_prologue(const Args& a, LAS unsigned char* lds, int gw, int NGW, int wave, int lane) {
    LAS float* scr = (LAS float*)(lds + wave * 16384);
    unsigned char* ws = a.ws;
    constexpr int I0 = 16 * 192, I1 = 16 * 96, I2 = 16 * 64, I3 = 16 * 32, I7 = 16 * 176, I8 = 44 * 32, I9 = 64;
    constexpr int NITEMS = I0 + I1 + I2 + 4 * I3 + I7 + I8 + 2 * I9;
    for (int it = gw; it < NITEMS; it += NGW) {
        int r = it;
        if (r < I0) { transpose_item(a.in[I_WIN], 1024, INW, (bf16_t*)(ws + WS_WCAT), r / 192, r % 192, 32 * (r % 192), nullptr, scr, lane); continue; } r -= I0;
        if (r < I1) { transpose_item(a.in[I_WGATE], 1024, GATEW, (bf16_t*)(ws + WS_WCAT), r / 96, r % 96, 6144 + 32 * (r % 96), nullptr, scr, lane); continue; } r -= I1;
        if (r < I2) { transpose_item(a.in[I_WMEM], 1024, 2048, (bf16_t*)(ws + WS_WCAT), r / 64, r % 64, 9216 + 32 * (r % 64), nullptr, scr, lane); continue; } r -= I2;
        if (r < I3) { transpose_item(a.in[I_WPA], 1024, 1024, (bf16_t*)(ws + WS_WP), r / 32, r % 32, 32 * (r % 32), nullptr, scr, lane); continue; } r -= I3;
        if (r < I3) { transpose_item(a.in[I_WPB], 1024, 1024, (bf16_t*)(ws + WS_WP), r / 32, r % 32, 1024 + 32 * (r % 32), nullptr, scr, lane); continue; } r -= I3;
        if (r < I3) { transpose_item(a.in[I_WPC], 1024, 1024, (bf16_t*)(ws + WS_WP), r / 32, r % 32, 2048 + 32 * (r % 32), nullptr, scr, lane); continue; } r -= I3;
        if (r < I3) { transpose_item(a.in[I_WOUT], 1024, 1024, (bf16_t*)(ws + WS_WO), r / 32, r % 32, 32 * (r % 32), nullptr, scr, lane); continue; } r -= I3;
        if (r < I7) { const int nb = r % 176, n0 = 32 * nb; const int ch0 = n0 < DFF ? n0 : n0 - DFF; const int dst = 256 * (ch0 / 128) + (n0 < DFF ? 0 : 128) + (ch0 % 128);
            transpose_item(a.in[I_WFI], 1024, 2 * DFF, (bf16_t*)(ws + WS_WFI), r / 176, nb, dst, a.in[I_NFFN], scr, lane); continue; } r -= I7;
        if (r < I8) { transpose_item(a.in[I_WFO], DFF, 1024, (bf16_t*)(ws + WS_WFO), r / 32, r % 32, 32 * (r % 32), nullptr, scr, lane); continue; } r -= I8;
        if (r < I9) { const int n = r / 8, s = r % 8;
          transpose_item(a.in[I_WRGA] + (size_t)n * 128 * 128, 128, 128, (bf16_t*)(ws + WS_WRG) + (size_t)n * 128 * 128, s / 4, s % 4, 32 * (s % 4), nullptr, scr, lane); continue; } r -= I9;
        { const int n = r / 8, s = r % 8;
          transpose_item(a.in[I_WRGX] + (size_t)n * 128 * 128, 128, 128, (bf16_t*)(ws + WS_WRG) + (size_t)(8 + n) * 128 * 128, s / 4, s % 4, 32 * (s % 4), nullptr, scr, lane); }
    }
    bf16_t* XN = (bf16_t*)(ws + WS_XN);
    for (int m = gw; m < TALL; m += NGW) {
        if (m < TP) norm_row_bf16(a.in[I_XP] + (size_t)m * DM, a.in[I_NMIX], XN + (size_t)m * DM, lane);
        else if (m < TT) norm_row_bf16(a.in[I_XS] + (size_t)(m - TP) * DM, a.in[I_NMIX], XN + (size_t)m * DM, lane);
        else norm_row_bf16(a.in[I_MEM] + (size_t)(m - TT) * DM, a.in[I_NMEM], XN + (size_t)m * DM, lane);
    }
}

struct Sched1 {
    const char* A; const char* B; int G, c;
    __device__ __forceinline__ bool next(int i, pg8::Unit& u) const {
        const int L = i * G + c;
        if (L < 66 * 36) { int pm, pn; pg8::tile_order(L, 66, 36, pm, pn); u.pm = pm; u.pn = pn; u.kind = pn >> 2;
            u.A = A + (size_t)pm * 256 * 1024 * 2; u.B = B + (size_t)pn * 256 * 1024 * 2; return true; }
        const int L2 = L - 66 * 36;
        if (L2 < 64) { int pm, pn; pg8::tile_order(L2, 8, 8, pm, pn); u.pm = pm; u.pn = pn; u.kind = 9;
            u.A = A + (size_t)(66 + pm) * 256 * 1024 * 2; u.B = B + (size_t)(36 + pn) * 256 * 1024 * 2; return true; }
        return false;
    }
};
struct Epi1 {
    bf16_t *Q, *Kb, *Vb, *XB, *GG, *QC, *G, *MK, *MV; float* out; const float* bgate;
    __device__ __forceinline__ bool operator()(f32x4 (&acc)[2][2][4][2], const pg8::Unit& u, int wr, int wc, int fr, int fq) const {
        const int rowb = u.pm * 256 + wr * 64 + fr, colb = (u.pn & 3) * 256 + wc * 32 + 8 * fq;
        const int kind = u.kind;
        if (kind == 0) { TILE_FOR( *(u32x4*)(Q + (size_t)row * DM + col) = pack8(v0 * QSCALE, v1 * QSCALE); ) }
        else if (kind == 1 || kind == 2) {
            bf16_t* B = kind == 1 ? Kb : Vb; const size_t op = kind == 1 ? O_KP : O_VP, os = kind == 1 ? O_KS : O_VS;
            TILE_FOR( *(u32x4*)(B + (size_t)row * DM + col) = pack8(v0, v1);
                      float* o = out + (row < TP ? op + (size_t)row * DM : os + (size_t)(row - TP) * DM) + col; *(f32x4*)o = v0; *(f32x4*)(o + 4) = v1; ) }
        else if (kind == 3) {
            TILE_FOR( *(u32x4*)(XB + (size_t)row * DM + col) = pack8(v0, v1);
                      if (row < TP) { const int s = row & (SEQ - 1); if (s >= SEQ - 3) { float* o = out + O_CP + (size_t)((row >> 11) * 3 + (s - (SEQ - 3))) * DM + col; *(f32x4*)o = v0; *(f32x4*)(o + 4) = v1; } }
                      else { const int rs = row - TP, s = rs & (DSEQ - 1); if (s >= DSEQ - 3) { float* o = out + O_CS + (size_t)((rs >> 5) * 3 + (s - (DSEQ - 3))) * DM + col; *(f32x4*)o = v0; *(f32x4*)(o + 4) = v1; } } ) }
        else if (kind == 4) {
            TILE_FOR( f32x4 g0, g1;
                      _Pragma("unroll") for (int j = 0; j < 4; ++j) { g0[j] = gelu_tanh(v0[j]); g1[j] = gelu_tanh(v1[j]); }
                      *(u32x4*)(GG + (size_t)row * DM + col) = pack8(g0, g1); ) }
        else if (kind == 5) { TILE_FOR( *(u32x4*)(QC + (size_t)row * DM + col) = pack8(v0 * CSCALE, v1 * CSCALE); ) }
        else if (kind <= 8) {
            const int gofs = (kind - 6) * 1024;
            TILE_FOR( const f32x4 b0 = *(const f32x4*)(bgate + gofs + col); const f32x4 b1 = *(const f32x4*)(bgate + gofs + col + 4); f32x4 g0, g1;
                      _Pragma("unroll") for (int j = 0; j < 4; ++j) { g0[j] = sigmoidf_(v0[j] + b0[j]); g1[j] = sigmoidf_(v1[j] + b1[j]); }
                      *(u32x4*)(G + (size_t)row * GATEW + gofs + col) = pack8(g0, g1); ) }
        else {
            bf16_t* B = u.pn < 4 ? MK : MV; const size_t ob = u.pn < 4 ? O_MKP : O_MVP;
            TILE_FOR( *(u32x4*)(B + (size_t)row * DM + col) = pack8(v0, v1);
                      float* o = out + ob + (size_t)row * DM + col; *(f32x4*)o = v0; *(f32x4*)(o + 4) = v1; ) }
        return true;
    }
};

struct Sched2 {
    const char* A0; const char* A1; const char* A2; const char* B; int G, c;
    __device__ __forceinline__ bool next(int i, pg8::Unit& u) const {
        const int j = i / 3, br = i - 3 * j; const int L = j * G + c;
        if (L >= 64 * 4) return false;
        int pm, pn; pg8::tile_order(L, 64, 4, pm, pn); u.pm = pm; u.pn = pn; u.kind = br;
        u.A = (br == 0 ? A0 : br == 1 ? A1 : A2) + (size_t)pm * 256 * 1024 * 2; u.B = B + (size_t)(br * 1024 + pn * 256) * 1024 * 2; return true;
    }
};
struct Epi2 {
    const bf16_t* G; bf16_t* MG; float* P;
    __device__ __forceinline__ bool operator()(f32x4 (&acc)[2][2][4][2], const pg8::Unit& u, int wr, int wc, int fr, int fq) const {
        const int rowb = u.pm * 256 + wr * 64 + fr, colb = u.pn * 256 + wc * 32 + 8 * fq;
        const int br = u.kind;
        TILE_FOR( const u32x4 gc = *(const u32x4*)(G + (size_t)row * GATEW + br * 1024 + col); float c[8]; unpack8(gc, c);
                  float* pp = P + (size_t)row * DM + col; f32x4 o0, o1;
                  _Pragma("unroll") for (int j = 0; j < 4; ++j) { o0[j] = v0[j] * c[j]; o1[j] = v1[j] * c[4 + j]; }
                  if (br > 0) { o0 += *(const f32x4*)pp; o1 += *(const f32x4*)(pp + 4); }
                  if (br < 2) { *(f32x4*)pp = o0; *(f32x4*)(pp + 4) = o1; }
                  else *(u32x4*)(MG + (size_t)row * DM + col) = pack8(o0, o1); )
        return true;
    }
};

struct SchedT {
    const char* A; const char* B; int nM, nN, K, G, c;
    __device__ __forceinline__ bool next(int i, pg8::Unit& u) const {
        const int L = i * G + c; if (L >= nM * nN) return false;
        int pm, pn; pg8::tile_order(L, nM, nN, pm, pn); u.pm = pm; u.pn = pn; u.kind = 0;
        u.A = A + (size_t)pm * 256 * K * 2; u.B = B + (size_t)pn * 256 * K * 2; return true;
    }
};
struct Epi3 {
    const float* xp; const float* xs; float* X1; bf16_t* X1B; float* SS;
    __device__ __forceinline__ bool operator()(f32x4 (&acc)[2][2][4][2], const pg8::Unit& u, int wr, int wc, int fr, int fq) const {
        const int rowb = u.pm * 256 + wr * 64 + fr, colb = u.pn * 256 + wc * 32 + 8 * fq;
#pragma unroll
        for (int ai = 0; ai < 2; ++ai)
#pragma unroll
            for (int m = 0; m < 4; ++m) { const int row = rowb + ai * 128 + m * 16; float ss = 0.f;
                const float* xr = row < TP ? xp + (size_t)row * DM : xs + (size_t)(row - TP) * DM;
#pragma unroll
                for (int bj = 0; bj < 2; ++bj) { const int col = colb + bj * 128;
                    const f32x4 a0 = acc[ai][bj][m][0] + *(const f32x4*)(xr + col), a1 = acc[ai][bj][m][1] + *(const f32x4*)(xr + col + 4);
                    *(f32x4*)(X1 + (size_t)row * DM + col) = a0; *(f32x4*)(X1 + (size_t)row * DM + col + 4) = a1;
                    *(u32x4*)(X1B + (size_t)row * DM + col) = pack8(a0, a1);
                    ss += (a0[0] * a0[0] + a0[1] * a0[1]) + (a0[2] * a0[2] + a0[3] * a0[3]) + (a1[0] * a1[0] + a1[1] * a1[1]) + (a1[2] * a1[2] + a1[3] * a1[3]); }
                ss += __shfl_xor(ss, 16); ss += __shfl_xor(ss, 32);
                if (fq == 0) SS[(size_t)row * 16 + u.pn * 4 + wc] = ss; }
        return true;
    }
};
struct Epi4 {
    const float* SS; bf16_t* ACT;
    __device__ __forceinline__ bool operator()(f32x4 (&acc)[2][2][4][2], const pg8::Unit& u, int wr, int wc, int fr, int fq) const {
        const int rowb = u.pm * 256 + wr * 64 + fr, colb = u.pn * 128 + wc * 32 + 8 * fq;
#pragma unroll
        for (int ai = 0; ai < 2; ++ai)
#pragma unroll
            for (int m = 0; m < 4; ++m) { const int row = rowb + ai * 128 + m * 16;
                const f32x4 p = *(const f32x4*)(SS + (size_t)row * 16 + 4 * fq); float s = (p[0] + p[1]) + (p[2] + p[3]);
                s += __shfl_xor(s, 16); s += __shfl_xor(s, 32);
                const float rstd = 1.0f / sqrtf(s * (1.0f / 1024.0f) + EPS);
                f32x4 o0, o1;
#pragma unroll
                for (int j = 0; j < 4; ++j) { const float g0 = acc[ai][0][m][0][j] * rstd, u0 = acc[ai][1][m][0][j] * rstd, g1 = acc[ai][0][m][1][j] * rstd, u1 = acc[ai][1][m][1][j] * rstd;
                    o0[j] = g0 * sigmoidf_(g0) * u0; o1[j] = g1 * sigmoidf_(g1) * u1; }
                *(u32x4*)(ACT + (size_t)row * DFF + colb) = pack8(o0, o1); }
        return true;
    }
};
struct Epi5 {
    float* X1;
    __device__ __forceinline__ bool operator()(f32x4 (&acc)[2][2][4][2], const pg8::Unit& u, int wr, int wc, int fr, int fq) const {
        const int rowb = u.pm * 256 + wr * 64 + fr, colb = u.pn * 256 + wc * 32 + 8 * fq;
        TILE_FOR( float* p = X1 + (size_t)row * DM + col; const f32x4 a0 = v0 + *(const f32x4*)p, a1 = v1 + *(const f32x4*)(p + 4); *(f32x4*)p = a0; *(f32x4*)(p + 4) = a1; )
        return true;
    }
};


template <int NSEG, class Fin>
__device__ __forceinline__ void tail_gemm(LAS unsigned char* lds, const bf16_t* A0, const bf16_t* A1, const bf16_t* A2, const bf16_t* Bt, const int Kseg, const bf16_t* G, const Fin& fin, int G_, int bx) {
    const int tid = threadIdx.x, wid = __builtin_amdgcn_readfirstlane(tid >> 6), lane = tid & 63, fr = lane & 15, fq = lane >> 4;
    const int ksl = Kseg / 8, kbase = wid * ksl;
    LAS float* part = (LAS float*)lds;
    for (int tile = bx; tile < 256; tile += G_) {
        const int rt = tile >> 4, ct = tile & 15, r0 = TP + rt * 32, c0 = ct * 64;
        f32x4 tot[2][4];
#pragma unroll
        for (int m = 0; m < 2; ++m)
#pragma unroll
            for (int n = 0; n < 4; ++n) tot[m][n] = (f32x4){0.f, 0.f, 0.f, 0.f};
#pragma unroll
        for (int seg = 0; seg < NSEG; ++seg) {
            const bf16_t* A = seg == 0 ? A0 : seg == 1 ? A1 : A2;
            f32x4 acc[2][4];
#pragma unroll
            for (int m = 0; m < 2; ++m)
#pragma unroll
                for (int n = 0; n < 4; ++n) acc[m][n] = (f32x4){0.f, 0.f, 0.f, 0.f};
            const bf16_t* ap = A + (size_t)(r0 + fr) * Kseg + kbase + 8 * fq;
            const bf16_t* wp = Bt + (size_t)(seg * 1024 + c0 + fr) * Kseg + kbase + 8 * fq;
#pragma unroll 2
            for (int kk = 0; kk < ksl; kk += 32) {
                bf16x8 af[2], wf[4];
#pragma unroll
                for (int m = 0; m < 2; ++m) af[m] = *(const bf16x8*)(ap + (size_t)(16 * m) * Kseg + kk);
#pragma unroll
                for (int n = 0; n < 4; ++n) wf[n] = *(const bf16x8*)(wp + (size_t)(16 * n) * Kseg + kk);
#pragma unroll
                for (int m = 0; m < 2; ++m)
#pragma unroll
                    for (int n = 0; n < 4; ++n) acc[m][n] = __builtin_amdgcn_mfma_f32_16x16x32_bf16(wf[n], af[m], acc[m][n], 0, 0, 0);
            }
            if (G) {
#pragma unroll
                for (int m = 0; m < 2; ++m)
#pragma unroll
                    for (int n = 0; n < 4; ++n) { const u32x2 g = *(const u32x2*)(G + (size_t)(r0 + 16 * m + fr) * GATEW + seg * 1024 + c0 + 16 * n + 4 * fq);
                        tot[m][n][0] += acc[m][n][0] * bf_lo(g.x); tot[m][n][1] += acc[m][n][1] * bf_hi(g.x); tot[m][n][2] += acc[m][n][2] * bf_lo(g.y); tot[m][n][3] += acc[m][n][3] * bf_hi(g.y); }
            } else {
#pragma unroll
                for (int m = 0; m < 2; ++m)
#pragma unroll
                    for (int n = 0; n < 4; ++n) tot[m][n] += acc[m][n];
            }
        }
#pragma unroll
        for (int m = 0; m < 2; ++m)
#pragma unroll
            for (int n = 0; n < 4; ++n) *(LAS f32x4*)(part + wid * 2048 + (16 * m + fr) * 64 + 16 * n + 4 * fq) = tot[m][n];
        __syncthreads();
        { const int row = tid >> 4, c4 = tid & 15;
          f32x4 v = *(const LAS f32x4*)(part + row * 64 + c4 * 4);
#pragma unroll
          for (int w = 1; w < 8; ++w) v += *(const LAS f32x4*)(part + w * 2048 + row * 64 + c4 * 4);
          fin(r0 + row, c0 + c4 * 4, v, ct); }
        __syncthreads();
    }
}
struct Fin3 { bf16_t* MG;
    __device__ __forceinline__ void operator()(int row, int col, f32x4 v, int) const { u32x2 w; w.x = pk_bf16(v[0], v[1]); w.y = pk_bf16(v[2], v[3]); *(u32x2*)(MG + (size_t)row * DM + col) = w; } };
struct Fin4 { const float* xs; float* X1; bf16_t* X1B; float* SS;
    __device__ __forceinline__ void operator()(int row, int col, f32x4 v, int ct) const {
        const f32x4 a = v + *(const f32x4*)(xs + (size_t)(row - TP) * DM + col);
        *(f32x4*)(X1 + (size_t)row * DM + col) = a; u32x2 w; w.x = pk_bf16(a[0], a[1]); w.y = pk_bf16(a[2], a[3]); *(u32x2*)(X1B + (size_t)row * DM + col) = w;
        float ss = (a[0] * a[0] + a[1] * a[1]) + (a[2] * a[2] + a[3] * a[3]);
        ss += __shfl_xor(ss, 1); ss += __shfl_xor(ss, 2); ss += __shfl_xor(ss, 4); ss += __shfl_xor(ss, 8);
        if ((threadIdx.x & 15) == 0) SS[(size_t)row * 16 + ct] = ss; } };
struct Fin6 { float* X1;
    __device__ __forceinline__ void operator()(int row, int col, f32x4 v, int) const { float* p = X1 + (size_t)row * DM + col; *(f32x4*)p = v + *(const f32x4*)p; } };

struct P2Ctx {
    const Args* a; LAS unsigned char* lds; int tid, lane, wid;
    const bf16_t *Q, *Kb, *Vb, *XB, *GG, *QC, *MK, *MV, *WRG; bf16_t *AO, *BO, *CO;
};
template <int NB>
__device__ __forceinline__ float softmax_step(f32x16 (&s)[NB], float& m, float& l) {
    float mx = s[0][0];
#pragma unroll
    for (int b = 0; b < NB; ++b)
#pragma unroll
        for (int r = 0; r < 16; ++r) mx = fmaxf(mx, s[b][r]);
    mx = fmaxf(mx, __shfl_xor(mx, 32));
    const float mn = fmaxf(m, mx), alpha = fexp2(m - mn);
    float ps = 0.f;
#pragma unroll
    for (int b = 0; b < NB; ++b)
#pragma unroll
        for (int r = 0; r < 16; ++r) { const float p = fexp2(s[b][r] - mn); s[b][r] = p; ps += p; }
    l = l * alpha + ps; m = mn;
    return alpha;
}
__device__ __forceinline__ bf16x8 pack_p(const f32x16& s, int h) {
    u32x4 w; w.x = pk_bf16(s[8 * h + 0], s[8 * h + 1]); w.y = pk_bf16(s[8 * h + 2], s[8 * h + 3]); w.z = pk_bf16(s[8 * h + 4], s[8 * h + 5]); w.w = pk_bf16(s[8 * h + 6], s[8 * h + 7]);
    return __builtin_bit_cast(bf16x8, w);
}
__device__ __forceinline__ bf16x8 v_frag(const LAS unsigned char* vimg, int ncb, int s, int cb, int lane) {
    const int hi = lane >> 5, g16 = (lane >> 4) & 1, i = lane & 15;
    const LAS unsigned char* p = vimg + ((2 * s) * ncb + cb) * 512 + (4 * hi + (i >> 2)) * 64 + g16 * 32 + (i & 3) * 8;
    const s16x4 lo = vtr(p), hv = vtr(p + ncb * 512);
    return (bf16x8){lo[0], lo[1], lo[2], lo[3], hv[0], hv[1], hv[2], hv[3]};
}
__device__ __forceinline__ void subln_store(f32x16 (&o)[4], const float* subg, bf16_t* dst  , int lane) {
    const int hi = lane >> 5;
    float ss = 0.f;
#pragma unroll
    for (int cb = 0; cb < 4; ++cb)
#pragma unroll
        for (int r = 0; r < 16; ++r) ss += o[cb][r] * o[cb][r];
    ss += __shfl_xor(ss, 32);
    const float rstd = (1.0f - LAMBDA_INIT) / sqrtf(ss * (1.0f / 128.0f) + EPS);
#pragma unroll
    for (int cb = 0; cb < 4; ++cb)
#pragma unroll
        for (int g = 0; g < 4; ++g) { const int dv0 = 32 * cb + 8 * g + 4 * hi; const f32x4 sg = *(const f32x4*)(subg + dv0);
            u32x2 w; w.x = pk_bf16(o[cb][4 * g + 0] * rstd * sg[0], o[cb][4 * g + 1] * rstd * sg[1]); w.y = pk_bf16(o[cb][4 * g + 2] * rstd * sg[2], o[cb][4 * g + 3] * rstd * sg[3]);
            *(u32x2*)(dst + dv0) = w; }
}

__device__ __forceinline__ void attnA_unit(const P2Ctx& C, int b, int h, int qb) {
    LAS unsigned char* lds = C.lds; const int tid = C.tid, lane = C.lane, wid = C.wid;
    const int comp = wid >> 2, qs = wid & 3, r32 = lane & 31, hi = lane >> 5;
    const int q0 = qb * 128, trow0 = b * SEQ;
    const int qpos = q0 + qs * 32 + r32; const size_t qrow = (size_t)(trow0 + qpos);
    const int qcw = (q0 + qs * 32) >> 6, ntw = qcw + 1, NT = 2 * qb + 2;
    const LAS float* lut = (const LAS float*)(lds + LUT_OFF) + h * 256;
    const float lam = *(const LAS float*)(lds + LAM_OFF);
    bf16x8 qf[4];
#pragma unroll
    for (int ds = 0; ds < 4; ++ds) qf[ds] = *(const bf16x8*)(C.Q + qrow * DM + h * 128 + comp * 64 + ds * 16 + hi * 8);
    u32x4 kreg[2], vreg[2];
    const int kkey = tid >> 3, kch = tid & 7;
#define A_ISSUE(kt) do { const size_t tr_ = (size_t)(trow0 + (kt) * 64); \
        kreg[0] = *(const u32x4*)(C.Kb + (tr_ + kkey) * DM + h * 128 + kch * 8); kreg[1] = *(const u32x4*)(C.Kb + (tr_ + kkey) * DM + h * 128 + 64 + kch * 8); \
        _Pragma("unroll") for (int i_ = 0; i_ < 2; ++i_) { const int idx_ = tid + 512 * i_; vreg[i_] = *(const u32x4*)(C.Vb + (tr_ + (idx_ >> 4)) * DM + h * 128 + (idx_ & 15) * 8); } } while (0)
#define A_WRITE(st) do { LAS unsigned char* sb_ = lds + (st) * 32768; \
        *(LAS u32x4*)(sb_ + kkey * 128 + ((kch ^ ((kkey >> 1) & 7)) << 4)) = kreg[0]; *(LAS u32x4*)(sb_ + 8192 + kkey * 128 + ((kch ^ ((kkey >> 1) & 7)) << 4)) = kreg[1]; \
        _Pragma("unroll") for (int i_ = 0; i_ < 2; ++i_) { const int idx_ = tid + 512 * i_, key_ = idx_ >> 4, ch_ = idx_ & 15; \
            *(LAS u32x4*)(sb_ + 16384 + ((key_ >> 3) * 4 + (ch_ >> 2)) * 512 + (key_ & 7) * 64 + (ch_ & 3) * 16) = vreg[i_]; } } while (0)
    f32x16 o[4];
#pragma unroll
    for (int cb = 0; cb < 4; ++cb)
#pragma unroll
        for (int r = 0; r < 16; ++r) o[cb][r] = 0.f;
    float m = -1e30f, l = 0.f;
    A_ISSUE(0); A_WRITE(0); __syncthreads();
    for (int kt = 0; kt < NT; ++kt) {
        if (kt + 1 < NT) A_ISSUE(kt + 1);
        if (kt < ntw) {
            const LAS unsigned char* sb = lds + (kt & 1) * 32768;
            const int relmax = kt * 64 + 63 - (q0 + qs * 32);
            const bool far = (relmax + 192 <= 0);
            f32x16 s[2];
            { const float c0 = far ? lut[0] : 0.f;
#pragma unroll
              for (int kb = 0; kb < 2; ++kb)
#pragma unroll
                  for (int r = 0; r < 16; ++r) s[kb][r] = c0; }
#pragma unroll
            for (int ds = 0; ds < 4; ++ds)
#pragma unroll
                for (int kb = 0; kb < 2; ++kb) { const int key = kb * 32 + r32, ch = 2 * ds + hi;
                    const bf16x8 kf = *(const LAS bf16x8*)(sb + comp * 8192 + key * 128 + ((ch ^ ((key >> 1) & 7)) << 4));
                    s[kb] = MFMA32(kf, qf[ds], s[kb]); }
            if (!far) {
#pragma unroll
                for (int kb = 0; kb < 2; ++kb)
#pragma unroll
                    for (int r = 0; r < 16; ++r) { const int rel = kt * 64 + kb * 32 + crow(r, hi) - qpos; const int idx = rel + 192 > 0 ? rel + 192 : 0; s[kb][r] += lut[idx]; }
            }
            const float alpha = softmax_step<2>(s, m, l);
#pragma unroll
            for (int cb = 0; cb < 4; ++cb)
#pragma unroll
                for (int r = 0; r < 16; ++r) o[cb][r] *= alpha;
            bf16x8 pf[4];
            pf[0] = pack_p(s[0], 0); pf[1] = pack_p(s[0], 1); pf[2] = pack_p(s[1], 0); pf[3] = pack_p(s[1], 1);
#pragma unroll
            for (int cb = 0; cb < 4; ++cb)
#pragma unroll
                for (int ks = 0; ks < 4; ++ks) o[cb] = MFMA32(v_frag(sb + 16384, 4, ks, cb, lane), pf[ks], o[cb]);
        }
        if (kt + 1 < NT) A_WRITE((kt + 1) & 1);
        __syncthreads();
    }
#undef A_ISSUE
#undef A_WRITE
    l += __shfl_xor(l, 32);
    const float inv = 1.0f / l;
    LAS float* X2 = (LAS float*)(lds + 65536);
    if (comp == 1) {
#pragma unroll
        for (int cb = 0; cb < 4; ++cb)
#pragma unroll
            for (int r = 0; r < 16; ++r) X2[((qs * 4 + cb) * 16 + r) * 64 + lane] = o[cb][r] * inv;
    }
    __syncthreads();
    if (comp == 0) {
#pragma unroll
        for (int cb = 0; cb < 4; ++cb)
#pragma unroll
            for (int r = 0; r < 16; ++r) o[cb][r] = o[cb][r] * inv - lam * X2[((qs * 4 + cb) * 16 + r) * 64 + lane];
        subln_store(o, C.a->in[I_SUBG], C.AO + qrow * DM + h * 128, lane);
    }
    __syncthreads();
}

__device__ __forceinline__ void attnB_unit(const P2Ctx& C, int b, int h) {
    LAS unsigned char* lds = C.lds; const int tid = C.tid, lane = C.lane, wid = C.wid;
    const int comp = wid >> 2, q4 = wid & 3, r32 = lane & 31, hi = lane >> 5;
    const LAS float* lut = (const LAS float*)(lds + LUT_OFF) + h * 256;
    const float lam = *(const LAS float*)(lds + LAM_OFF);
    const size_t trow0 = (size_t)(TP + b * DSEQ);
    const float* ck = C.a->in[I_CK]; const float* cv = C.a->in[I_CV];
    { const int c = tid >> 8, row = (tid >> 3) & 31, ch = tid & 7;
      *(LAS u32x4*)(lds + c * 4096 + row * 128 + ((ch ^ ((row >> 1) & 7)) << 4)) = *(const u32x4*)(C.Q + (trow0 + row) * DM + h * 128 + c * 64 + ch * 8); }
    LAS unsigned char* VL = lds + 8192;
    f32x4 vst[4][2];
    const int vkey = (tid >> 4) & 31, vch = tid & 15;
#define B_ISSUEV(it) do { _Pragma("unroll") for (int i_ = 0; i_ < 4; ++i_) { const float* p_ = cv + (((size_t)(b * PAST + (i_ * 16 + (it)) * 32 + vkey)) * 8 + h) * 128 + vch * 8; \
        vst[i_][0] = *(const f32x4*)p_; vst[i_][1] = *(const f32x4*)(p_ + 4); } } while (0)
#define B_WRITEV(st) do { _Pragma("unroll") for (int i_ = 0; i_ < 4; ++i_) \
        *(LAS u32x4*)(VL + ((st) * 4 + i_) * 8192 + ((vkey >> 3) * 4 + (vch >> 2)) * 512 + (vkey & 7) * 64 + (vch & 3) * 16) = pack8(vst[i_][0], vst[i_][1]); } while (0)
    f32x4 kst[4][2];
#define B_ISSUEK(it) do { const float* p_ = ck + ((((size_t)(b * PAST + (q4 * 16 + (it)) * 32 + r32)) * 8 + h) * 2 + comp) * 64 + hi * 8; \
        _Pragma("unroll") for (int ds_ = 0; ds_ < 4; ++ds_) { kst[ds_][0] = *(const f32x4*)(p_ + ds_ * 16); kst[ds_][1] = *(const f32x4*)(p_ + ds_ * 16 + 4); } } while (0)
    f32x16 o[4];
#pragma unroll
    for (int cb = 0; cb < 4; ++cb)
#pragma unroll
        for (int r = 0; r < 16; ++r) o[cb][r] = 0.f;
    float m = -1e30f, l = 0.f;
    B_ISSUEV(0); B_ISSUEK(0); B_WRITEV(0); __syncthreads();
    for (int it = 0; it <= 16; ++it) {
        const bool active = (it < 16) || (q4 == 0);
        bf16x8 kf[4];
        if (it < 16) {
#pragma unroll
            for (int ds = 0; ds < 4; ++ds) kf[ds] = __builtin_bit_cast(bf16x8, pack8(kst[ds][0], kst[ds][1]));
        } else {
#pragma unroll
            for (int ds = 0; ds < 4; ++ds) kf[ds] = *(const bf16x8*)(C.Kb + (trow0 + r32) * DM + h * 128 + comp * 64 + ds * 16 + hi * 8);
        }
        u32x4 vnew = (u32x4){0u, 0u, 0u, 0u};
        if (it + 1 < 16) { B_ISSUEV(it + 1); B_ISSUEK(it + 1); }
        else if (it + 1 == 16) { if (tid < 512) vnew = *(const u32x4*)(C.Vb + (trow0 + vkey) * DM + h * 128 + vch * 8); }
        if (active) {
            const int kpos0 = it < 16 ? (q4 * 16 + it) * 32 : PAST;
            const LAS unsigned char* vimg = VL + ((it & 1) * 4 + (it < 16 ? q4 : 0)) * 8192;
            const int qpos = PAST + r32;
            const bool far = (kpos0 + 31 - PAST + 192 <= 0);
            f32x16 s[1];
            { const float c0 = far ? lut[0] : 0.f;
#pragma unroll
              for (int r = 0; r < 16; ++r) s[0][r] = c0; }
#pragma unroll
            for (int ds = 0; ds < 4; ++ds) { const int ch = 2 * ds + hi;
                const bf16x8 qf = *(const LAS bf16x8*)(lds + comp * 4096 + r32 * 128 + ((ch ^ ((r32 >> 1) & 7)) << 4));
                s[0] = MFMA32(kf[ds], qf, s[0]); }
            if (!far) {
#pragma unroll
                for (int r = 0; r < 16; ++r) { const int rel = kpos0 + crow(r, hi) - qpos; const int idx = rel + 192 > 0 ? rel + 192 : 0; s[0][r] += lut[idx]; }
            }
            const float alpha = softmax_step<1>(s, m, l);
#pragma unroll
            for (int cb = 0; cb < 4; ++cb)
#pragma unroll
                for (int r = 0; r < 16; ++r) o[cb][r] *= alpha;
            const bf16x8 p0 = pack_p(s[0], 0), p1 = pack_p(s[0], 1);
#pragma unroll
            for (int cb = 0; cb < 4; ++cb) { o[cb] = MFMA32(v_frag(vimg, 4, 0, cb, lane), p0, o[cb]); o[cb] = MFMA32(v_frag(vimg, 4, 1, cb, lane), p1, o[cb]); }
        }
        if (it + 1 < 16) { B_WRITEV((it + 1) & 1); }
        else if (it + 1 == 16) { *(LAS u32x4*)(VL + (0 * 4 + 0) * 8192 + ((vkey >> 3) * 4 + (vch >> 2)) * 512 + (vkey & 7) * 64 + (vch & 3) * 16) = vnew; }
        __syncthreads();
    }
#undef B_ISSUEV
#undef B_WRITEV
#undef B_ISSUEK
    l += __shfl_xor(l, 32);
    LAS float* MX = (LAS float*)(lds + 73728);
    if (hi == 0) MX[wid * 32 + r32] = m;
    __syncthreads();
    float M = MX[(comp * 4 + 0) * 32 + r32];
#pragma unroll
    for (int j = 1; j < 4; ++j) M = fmaxf(M, MX[(comp * 4 + j) * 32 + r32]);
    const float f = fexp2(m - M);
    l *= f;
#pragma unroll
    for (int cb = 0; cb < 4; ++cb)
#pragma unroll
        for (int r = 0; r < 16; ++r) o[cb][r] *= f;
    if (hi == 0) MX[256 + wid * 32 + r32] = l;
    __syncthreads();
    float L = 0.f;
#pragma unroll
    for (int j = 0; j < 4; ++j) L += MX[256 + (comp * 4 + j) * 32 + r32];
    const float inv = 1.0f / L;
    LAS float* R = (LAS float*)(lds + 8192);
#define B_PUT(slot) do { _Pragma("unroll") for (int cb = 0; cb < 4; ++cb) _Pragma("unroll") for (int r = 0; r < 16; ++r) R[(slot) * 4096 + (cb * 16 + r) * 64 + lane] = o[cb][r]; } while (0)
#define B_ADD(slot) do { _Pragma("unroll") for (int cb = 0; cb < 4; ++cb) _Pragma("unroll") for (int r = 0; r < 16; ++r) o[cb][r] += R[(slot) * 4096 + (cb * 16 + r) * 64 + lane]; } while (0)
    if (q4 >= 2) B_PUT(comp * 2 + (q4 - 2));
    __syncthreads();
    if (q4 < 2) B_ADD(comp * 2 + q4);
    __syncthreads();
    if (q4 == 1) B_PUT(comp);
    __syncthreads();
    if (q4 == 0) { B_ADD(comp);
#pragma unroll
        for (int cb = 0; cb < 4; ++cb)
#pragma unroll
            for (int r = 0; r < 16; ++r) o[cb][r] *= inv; }
    __syncthreads();
    if (q4 == 0 && comp == 1) B_PUT(0);
    __syncthreads();
    if (wid == 0) {
#pragma unroll
        for (int cb = 0; cb < 4; ++cb)
#pragma unroll
            for (int r = 0; r < 16; ++r) o[cb][r] -= lam * R[(cb * 16 + r) * 64 + lane];
        subln_store(o, C.a->in[I_SUBG], C.AO + (trow0 + r32) * DM + h * 128, lane);
    }
    __syncthreads();
#undef B_PUT
#undef B_ADD
}

template <bool SAMPLE>
__device__ __forceinline__ void attnC_unit(const P2Ctx& C, int b, int h, int qblk) {
    LAS unsigned char* lds = C.lds; const int tid = C.tid, lane = C.lane, wid = C.wid;
    const int dvh = wid >> 2, qs = wid & 3, r32 = lane & 31, hi = lane >> 5;
    const size_t trow0 = SAMPLE ? (size_t)(TP + b * DSEQ) : (size_t)(b * SEQ + qblk * 128);
    const int nq = SAMPLE ? DSEQ : 128;
    LAS unsigned char* QL = lds + 65536;
#pragma unroll
    for (int i = 0; i < 8; ++i) { const int idx = tid + 512 * i, row = idx >> 5, ch = idx & 31;
        u32x4 v = (u32x4){0u, 0u, 0u, 0u};
        if (row < nq) v = *(const u32x4*)(C.QC + (trow0 + row) * DM + h * 256 + ch * 8);
        *(LAS u32x4*)(QL + row * 512 + (((ch & 16) | ((ch ^ row) & 15)) << 4)) = v; }
    u32x4 kreg[2], vreg[2];
#define C_ISSUE(kt) do { _Pragma("unroll") for (int i_ = 0; i_ < 2; ++i_) { const int idx_ = tid + 512 * i_, key_ = idx_ >> 5, ch_ = idx_ & 31; const int mrow_ = (kt) * 32 + key_; \
        if (SAMPLE) { const float* pk_ = C.a->in[I_CMK] + (((size_t)(b * 256 + mrow_)) * 4 + h) * 256 + ch_ * 8; const float* pv_ = C.a->in[I_CMV] + (((size_t)(b * 256 + mrow_)) * 4 + h) * 256 + ch_ * 8; \
            kreg[i_] = pack8(*(const f32x4*)pk_, *(const f32x4*)(pk_ + 4)); vreg[i_] = pack8(*(const f32x4*)pv_, *(const f32x4*)(pv_ + 4)); } \
        else { kreg[i_] = *(const u32x4*)(C.MK + ((size_t)(b * 256 + mrow_)) * DM + h * 256 + ch_ * 8); vreg[i_] = *(const u32x4*)(C.MV + ((size_t)(b * 256 + mrow_)) * DM + h * 256 + ch_ * 8); } } } while (0)
#define C_WRITE(st) do { LAS unsigned char* sb_ = lds + (st) * 32768; _Pragma("unroll") for (int i_ = 0; i_ < 2; ++i_) { const int idx_ = tid + 512 * i_, key_ = idx_ >> 5, ch_ = idx_ & 31; \
        *(LAS u32x4*)(sb_ + key_ * 512 + (((ch_ & 16) | ((ch_ ^ key_) & 15)) << 4)) = kreg[i_]; \
        *(LAS u32x4*)(sb_ + 16384 + ((key_ >> 3) * 8 + (ch_ >> 2)) * 512 + (key_ & 7) * 64 + (ch_ & 3) * 16) = vreg[i_]; } } while (0)
    f32x16 o[4];
#pragma unroll
    for (int cb = 0; cb < 4; ++cb)
#pragma unroll
        for (int r = 0; r < 16; ++r) o[cb][r] = 0.f;
    float m = -1e30f, l = 0.f;
    const bool active = SAMPLE ? (qs == 0) : true;
    C_ISSUE(0); C_WRITE(0); __syncthreads();
    for (int kt = 0; kt < 8; ++kt) {
        if (kt + 1 < 8) C_ISSUE(kt + 1);
        if (active) {
            const LAS unsigned char* sb = lds + (kt & 1) * 32768;
            f32x16 s[1];
#pragma unroll
            for (int r = 0; r < 16; ++r) s[0][r] = 0.f;
            const int qrow = qs * 32 + r32;
#pragma unroll
            for (int ds = 0; ds < 16; ++ds) { const int ch = 2 * ds + hi;
                const bf16x8 kf = *(const LAS bf16x8*)(sb + r32 * 512 + (((ch & 16) | ((ch ^ r32) & 15)) << 4));
                const bf16x8 qf = *(const LAS bf16x8*)(QL + qrow * 512 + (((ch & 16) | ((ch ^ qrow) & 15)) << 4));
                s[0] = MFMA32(kf, qf, s[0]); }
            const float alpha = softmax_step<1>(s, m, l);
#pragma unroll
            for (int cb = 0; cb < 4; ++cb)
#pragma unroll
                for (int r = 0; r < 16; ++r) o[cb][r] *= alpha;
            const bf16x8 p0 = pack_p(s[0], 0), p1 = pack_p(s[0], 1);
#pragma unroll
            for (int cb = 0; cb < 4; ++cb) { o[cb] = MFMA32(v_frag(sb + 16384, 8, 0, dvh * 4 + cb, lane), p0, o[cb]); o[cb] = MFMA32(v_frag(sb + 16384, 8, 1, dvh * 4 + cb, lane), p1, o[cb]); }
        }
        if (kt + 1 < 8) C_WRITE((kt + 1) & 1);
        __syncthreads();
    }
#undef C_ISSUE
#undef C_WRITE
    if (active) {
        l += __shfl_xor(l, 32);
        const float inv = 1.0f / l;
        bf16_t* dst = C.CO + (trow0 + qs * 32 + r32) * DM + h * 256 + dvh * 128;
#pragma unroll
        for (int cb = 0; cb < 4; ++cb)
#pragma unroll
            for (int g = 0; g < 4; ++g) { const int dv0 = 32 * cb + 8 * g + 4 * hi;
                u32x2 w; w.x = pk_bf16(o[cb][4 * g + 0] * inv, o[cb][4 * g + 1] * inv); w.y = pk_bf16(o[cb][4 * g + 2] * inv, o[cb][4 * g + 3] * inv);
                *(u32x2*)(dst + dv0) = w; }
    }
    __syncthreads();
}

__device__ __forceinline__ void lru_unit(const P2Ctx& C, int sg, int n) {
    LAS unsigned char* lds = C.lds; const int tid = C.tid, lane = C.lane, wid = C.wid;
    const Args& a = *C.a;
    const bool smp = sg >= 8; const int b = smp ? sg - 8 : sg; const int S = smp ? DSEQ : SEQ; const size_t t0 = smp ? (size_t)(TP + b * DSEQ) : (size_t)(b * SEQ);
    LAS unsigned char* XC = lds;
    LAS float* AA = (LAS float*)(lds + 16384);
    LAS float* UU = (LAS float*)(lds + 49152);
    LAS float* SEG = (LAS float*)(lds + 81920);
    LAS float* CAR = (LAS float*)(lds + 86016);
    const int r32 = lane & 31, hi = lane >> 5, chb = wid & 3, tkb = wid >> 2;
    const int chl = chb * 32 + r32, chg = n * 128 + chl;
    const float ba = a.in[I_BRGA][chg], bx = a.in[I_BRGX][chg];
    const float sp8 = 8.0f * log1pf(expf(-a.in[I_RGL][chg]));
    const int cg = tid & 15;
    if (tid < 128) CAR[tid] = smp ? a.in[I_SLRU][b * 1024 + n * 128 + tid] : 0.f;
    const int nchunks = (S + 63) / 64;
    for (int ck = 0; ck < nchunks; ++ck) {
#pragma unroll
        for (int i = 0; i < 2; ++i) { const int tok = (tid >> 4) + 32 * i, tt = ck * 64 + tok;
            float xc[8];
            { const float* cbp = a.in[I_CONVB] + n * 128 + cg * 8; const f32x4 c0 = *(const f32x4*)cbp, c1 = *(const f32x4*)(cbp + 4);
              xc[0] = c0[0]; xc[1] = c0[1]; xc[2] = c0[2]; xc[3] = c0[3]; xc[4] = c1[0]; xc[5] = c1[1]; xc[6] = c1[2]; xc[7] = c1[3]; }
#pragma unroll
            for (int j = 0; j < 4; ++j) { const int ts = tt - 3 + j; float x[8]; float cw[8];
                { const float* cwp = a.in[I_CONVW] + j * 1024 + n * 128 + cg * 8; const f32x4 c0 = *(const f32x4*)cwp, c1 = *(const f32x4*)(cwp + 4);
                  cw[0] = c0[0]; cw[1] = c0[1]; cw[2] = c0[2]; cw[3] = c0[3]; cw[4] = c1[0]; cw[5] = c1[1]; cw[6] = c1[2]; cw[7] = c1[3]; }
                if (ts >= 0 && ts < S) { const u32x4 w = *(const u32x4*)(C.XB + (t0 + ts) * DM + n * 128 + cg * 8); unpack8(w, x); }
                else if (ts < 0 && smp) { const float* p = a.in[I_SCONV] + (size_t)(b * 3 + ts + 3) * DM + n * 128 + cg * 8; const f32x4 p0 = *(const f32x4*)p, p1 = *(const f32x4*)(p + 4);
                    x[0] = p0[0]; x[1] = p0[1]; x[2] = p0[2]; x[3] = p0[3]; x[4] = p1[0]; x[5] = p1[1]; x[6] = p1[2]; x[7] = p1[3]; }
                else {
#pragma unroll
                    for (int e = 0; e < 8; ++e) x[e] = 0.f; }
#pragma unroll
                for (int e = 0; e < 8; ++e) xc[e] += cw[e] * x[e]; }
            u32x4 w; w.x = pk_bf16(xc[0], xc[1]); w.y = pk_bf16(xc[2], xc[3]); w.z = pk_bf16(xc[4], xc[5]); w.w = pk_bf16(xc[6], xc[7]);
            *(LAS u32x4*)(XC + tok * 256 + ((cg ^ (tok & 15)) << 4)) = w; }
        __syncthreads();
        f32x16 da, dx;
#pragma unroll
        for (int r = 0; r < 16; ++r) { da[r] = 0.f; dx[r] = 0.f; }
        { const int tokA = tkb * 32 + r32;
          const bf16_t* wpa = C.WRG + ((size_t)n * 128 + chl) * 128 + hi * 8; const bf16_t* wpx = wpa + (size_t)8 * 128 * 128;
#pragma unroll
          for (int ks = 0; ks < 8; ++ks) { const bf16x8 xf = *(const LAS bf16x8*)(XC + tokA * 256 + (((2 * ks + hi) ^ (tokA & 15)) << 4));
              const bf16x8 wa = *(const bf16x8*)(wpa + ks * 16), wx = *(const bf16x8*)(wpx + ks * 16);
              da = MFMA32(xf, wa, da); dx = MFMA32(xf, wx, dx); } }
#pragma unroll
        for (int r = 0; r < 16; ++r) { const int tokl = tkb * 32 + crow(r, hi);
            const float xcv = bf2f(*(const LAS bf16_t*)(XC + tokl * 256 + ((((chl >> 3)) ^ (tokl & 15)) << 4) + (chl & 7) * 2));
            const float rg = sigmoidf_(da[r] + ba), ig = sigmoidf_(dx[r] + bx);
            const float log_a = -sp8 * rg;
            const float x2 = 2.0f * log_a;
            const float om = x2 > -0.25f ? -x2 * (1.0f + x2 * (0.5f + x2 * (0.16666667f + x2 * (0.041666668f + x2 * 0.0083333333f)))) : 1.0f - fexp2(x2 * LOG2E);
            float av = fexp2(log_a * LOG2E), uv = sqrtf(om) * (ig * xcv);
            if (ck * 64 + tokl >= S) { av = 1.0f; uv = 0.f; }
            AA[tokl * 128 + chl] = av; UU[tokl * 128 + chl] = uv; }
        __syncthreads();
        { const int c = tid & 127, seg = tid >> 7;
          float A = 1.f, B = 0.f;
#pragma unroll
          for (int t = 0; t < 16; ++t) { const int tok = seg * 16 + t; const float av = AA[tok * 128 + c], uv = UU[tok * 128 + c]; B = av * B + uv; A *= av; }
          SEG[(seg * 128 + c) * 2] = A; SEG[(seg * 128 + c) * 2 + 1] = B;
          __syncthreads();
          float hin = CAR[c];
          for (int s = 0; s < seg; ++s) hin = SEG[(s * 128 + c) * 2] * hin + SEG[(s * 128 + c) * 2 + 1];
          float hv = hin;
#pragma unroll
          for (int t = 0; t < 16; ++t) { const int tok = seg * 16 + t, tt = ck * 64 + tok; const float av = AA[tok * 128 + c], uv = UU[tok * 128 + c]; hv = av * hv + uv;
              if (tt < S) { const size_t off = (t0 + tt) * DM + n * 128 + c; const float gg = bf2f(C.GG[off]);
                  C.BO[off] = (bf16_t)(pk_bf16(hv * gg, 0.f) & 0xffffu); } }
          __syncthreads();
          if (seg == 3) CAR[c] = hv; }
    }
    __syncthreads();
    if (tid < 128) a.out[(smp ? O_HS : O_HP) + (size_t)b * 1024 + n * 128 + tid] = CAR[tid];
    __syncthreads();
}

constexpr int P2_N_LRU_P = 64, P2_N_B = 128, P2_N_A = 1024, P2_N_CP = 512, P2_N_CS = 64, P2_N_LRU_S = 128;
constexpr int P2_NITEMS = P2_N_LRU_P + P2_N_B + P2_N_A + P2_N_CP + P2_N_CS + P2_N_LRU_S;
__device__ __forceinline__ void p2_mixers(const Args& a, LAS unsigned char* lds, int tid, int lane, int wid) {
    unsigned char* ws0 = a.ws;
    { LAS float* lut = (LAS float*)(lds + LUT_OFF);
      for (int e = tid; e < 8 * 256; e += 512) { const int h = e >> 8, rel = (e & 255) - 192; const int nn = rel < 0 ? -rel : rel;
          int bk = nn < 8 ? nn : (nn >= 91 ? 15 : nn >= 64 ? 14 : nn >= 46 ? 13 : nn >= 32 ? 12 : nn >= 23 ? 11 : nn >= 16 ? 10 : nn >= 12 ? 9 : 8);
          if (rel > 0) bk += 16;
          lut[e] = a.in[I_REL][bk * 8 + h] * LOG2E; }
      if (tid < 64) { float d1 = a.in[I_LQ1][tid] * a.in[I_LK1][tid], d2 = a.in[I_LQ2][tid] * a.in[I_LK2][tid]; d1 = wave_sum(d1); d2 = wave_sum(d2);
          if (tid == 0) *(LAS float*)(lds + LAM_OFF) = expf(d1) - expf(d2) + LAMBDA_INIT; } }
    __syncthreads();
    unsigned* queue = (unsigned*)(ws0 + WS_CTL) + CW_QUEUE;
    volatile LAS unsigned* slot = (volatile LAS unsigned*)(lds + MISC_OFF + 64);
    for (;;) {
        if (tid == 0) *slot = __hip_atomic_fetch_add(queue, 1u, __ATOMIC_RELAXED, __HIP_MEMORY_SCOPE_AGENT);
        __syncthreads();
        int it = (int)*slot;
        __syncthreads();
        if (it >= P2_NITEMS) break;
        int tid_ = tid; asm volatile("" : "+v"(tid_));
        unsigned char* ws = ws0; asm volatile("" : "+s"(ws));
        P2Ctx C; C.a = &a; C.lds = lds; C.tid = tid_; C.lane = tid_ & 63; C.wid = __builtin_amdgcn_readfirstlane(tid_ >> 6);
        C.Q = (const bf16_t*)(ws + WS_Q); C.Kb = (const bf16_t*)(ws + WS_K); C.Vb = (const bf16_t*)(ws + WS_V); C.XB = (const bf16_t*)(ws + WS_XB); C.GG = (const bf16_t*)(ws + WS_GG);
        C.QC = (const bf16_t*)(ws + WS_QC); C.MK = (const bf16_t*)(ws + WS_MK); C.MV = (const bf16_t*)(ws + WS_MV); C.WRG = (const bf16_t*)(ws + WS_WRG);
        C.AO = (bf16_t*)(ws + WS_AO); C.BO = (bf16_t*)(ws + WS_BO); C.CO = (bf16_t*)(ws + WS_CO);
#ifndef UNIT_MASK
#define UNIT_MASK 0xFF
#endif
        if (it < P2_N_LRU_P) { if (UNIT_MASK & 1) lru_unit(C, it >> 3, it & 7); continue; } it -= P2_N_LRU_P;
        if (it < P2_N_B) { if (UNIT_MASK & 2) attnB_unit(C, it >> 3, it & 7); continue; } it -= P2_N_B;
        if (it < P2_N_A) { const int qb = 15 - (it >> 6), bh = it & 63; if (UNIT_MASK & 4) attnA_unit(C, bh >> 3, bh & 7, qb); continue; } it -= P2_N_A;
        if (it < P2_N_CP) { const int qblk = it & 15, bh = it >> 4; if (UNIT_MASK & 8) attnC_unit<false>(C, bh >> 2, bh & 3, qblk); continue; } it -= P2_N_CP;
        if (it < P2_N_CS) { if (UNIT_MASK & 16) attnC_unit<true>(C, it >> 2, it & 3, 0); continue; } it -= P2_N_CS;
        if (UNIT_MASK & 1) lru_unit(C, 8 + (it >> 3), it & 7);
    }
}

__device__ __forceinline__ void p7_final(const Args& a, int gw, int NGW, int lane) {
    const float* X2 = (const float*)(a.ws + WS_X1);
    const f32x4* gr = (const f32x4*)a.in[I_NFIN] + lane;
    for (int mrow = gw; mrow < TT; mrow += NGW) {
        const f32x4* xr = (const f32x4*)(X2 + (size_t)mrow * DM) + lane;
        f32x4 v[4]; float s = 0.f;
#pragma unroll
        for (int j = 0; j < 4; ++j) { v[j] = xr[64 * j]; s += (v[j].x * v[j].x + v[j].y * v[j].y) + (v[j].z * v[j].z + v[j].w * v[j].w); }
        const float rstd = 1.0f / sqrtf(wave_sum(s) * (1.0f / 1024.0f) + EPS);
        f32x4* o = (f32x4*)(a.out + (mrow < TP ? O_YP + (size_t)mrow * DM : O_YS + (size_t)(mrow - TP) * DM)) + lane;
#pragma unroll
        for (int j = 0; j < 4; ++j) { const f32x4 g = gr[64 * j]; o[64 * j] = v[j] * rstd * g; }
    }
}

constexpr int N_PHASES = 8;
__global__ void __launch_bounds__(NWAVES * 64, 2) fwd_kernel(Args args) {
    __shared__ __attribute__((aligned(16))) unsigned char lds_raw[LDS_BYTES];
    LAS unsigned char* lds = (LAS unsigned char*)lds_raw;
    const int tid = threadIdx.x, lane = tid & 63, wave = __builtin_amdgcn_readfirstlane(tid >> 6);
    const int G = gridDim.x, bx = blockIdx.x;
    const int vcu = (G % 8 == 0) ? (bx % 8) * (G / 8) + bx / 8 : bx;
    const int gw = vcu * NWAVES + wave, NGW = G * NWAVES;
    unsigned char* ws = args.ws;
    unsigned* ctl = (unsigned*)(ws + WS_CTL);
    for (int u = tid; u < (LDS_BYTES - EXTRA_OFF) / 4; u += NWAVES * 64) ((LAS unsigned*)(lds + EXTRA_OFF))[u] = 0u;
    __syncthreads();
    XcdBarrier bar; bar.bar = ctl + CW_BAR; bar.x = 0; bar.st = nullptr;
    if (MK_N_LAUNCHES == 1) bar = xcd_barrier_post(ctl + CW_BAR, (volatile LAS unsigned*)(lds + MISC_OFF + 32));
    const int lo = args.ph_lo, hi = args.ph_hi;
#ifndef PH_MASK
#define PH_MASK 0xFF
#endif
#define IN(k) (((PH_MASK >> (k)) & 1) && lo <= (k) && (k) < hi)
#define SEAM(k) do { if (IN(k) && IN((k) + 1)) xcd_barrier(bar); } while (0)

    if (IN(0)) { p0_prologue(args, lds, gw, NGW, wave, lane); }
    SEAM(0);
    if (IN(1)) {
        Sched1 S{(const char*)(ws + WS_XN), (const char*)(ws + WS_WCAT), G, bx};
        Epi1 E{(bf16_t*)(ws + WS_Q), (bf16_t*)(ws + WS_K), (bf16_t*)(ws + WS_V), (bf16_t*)(ws + WS_XB), (bf16_t*)(ws + WS_GG), (bf16_t*)(ws + WS_QC), (bf16_t*)(ws + WS_G),
               (bf16_t*)(ws + WS_MK), (bf16_t*)(ws + WS_MV), args.out, args.in[I_BGATE]};
        pg8::gemm_phase(lds, 1024, S, E);
    }
    SEAM(1);
    if (IN(2)) { p2_mixers(args, lds, tid, lane, wave); }
    SEAM(2);
    if (IN(3)) {
        Sched2 S{(const char*)(ws + WS_AO), (const char*)(ws + WS_BO), (const char*)(ws + WS_CO), (const char*)(ws + WS_WP), G, bx};
        Epi2 E{(const bf16_t*)(ws + WS_G), (bf16_t*)(ws + WS_MG), (float*)(ws + WS_X1)};
        pg8::gemm_phase(lds, 1024, S, E);
        Fin3 F{(bf16_t*)(ws + WS_MG)};
        tail_gemm<3>(lds, (const bf16_t*)(ws + WS_AO), (const bf16_t*)(ws + WS_BO), (const bf16_t*)(ws + WS_CO), (const bf16_t*)(ws + WS_WP), 1024, (const bf16_t*)(ws + WS_G), F, G, bx);
    }
    SEAM(3);
    if (IN(4)) {
        SchedT S{(const char*)(ws + WS_MG), (const char*)(ws + WS_WO), 64, 4, 1024, G, bx};
        Epi3 E{args.in[I_XP], args.in[I_XS], (float*)(ws + WS_X1), (bf16_t*)(ws + WS_X1B), (float*)(ws + WS_SS)};
        pg8::gemm_phase(lds, 1024, S, E);
        Fin4 F{args.in[I_XS], (float*)(ws + WS_X1), (bf16_t*)(ws + WS_X1B), (float*)(ws + WS_SS)};
        tail_gemm<1>(lds, (const bf16_t*)(ws + WS_MG), nullptr, nullptr, (const bf16_t*)(ws + WS_WO), 1024, nullptr, F, G, bx);
    }
    SEAM(4);
    if (IN(5)) {
        SchedT S{(const char*)(ws + WS_X1B), (const char*)(ws + WS_WFI), 66, 22, 1024, G, bx};
        Epi4 E{(const float*)(ws + WS_SS), (bf16_t*)(ws + WS_ACT)};
        pg8::gemm_phase(lds, 1024, S, E);
    }
    SEAM(5);
    if (IN(6)) {
        SchedT S{(const char*)(ws + WS_ACT), (const char*)(ws + WS_WFO), 64, 4, DFF, G, bx};
        Epi5 E{(float*)(ws + WS_X1)};
        pg8::gemm_phase(lds, DFF, S, E);
        Fin6 F{(float*)(ws + WS_X1)};
        tail_gemm<1>(lds, (const bf16_t*)(ws + WS_ACT), nullptr, nullptr, (const bf16_t*)(ws + WS_WFO), DFF, nullptr, F, G, bx);
    }
    SEAM(6);
    if (IN(7)) { p7_final(args, gw, NGW, lane); }
#undef IN
#undef SEAM
}

extern "C" void kernel_launch(void* const* d_in, const int* in_sizes, int n_in, void* d_out, int out_size, void* d_ws, size_t ws_size, hipStream_t stream) {
    static int grid = 0;
    if (grid == 0) {
        if (n_in != 36 || out_size != (int)O_END || ws_size < WS_END) { fprintf(stderr, "kernel_launch: unexpected problem (n_in %d, out %d, ws %zu); nothing launched\n", n_in, out_size, ws_size); grid = -1; return; }
        int dev = 0, cus = 0;
        if (hipGetDevice(&dev) != hipSuccess || hipDeviceGetAttribute(&cus, hipDeviceAttributeMultiprocessorCount, dev) != hipSuccess) { grid = -1; return; }
        int per_cu = 0;
        if (hipOccupancyMaxActiveBlocksPerMultiprocessor(&per_cu, (const void*)fwd_kernel, NWAVES * 64, 0) != hipSuccess || per_cu < 1)
            fprintf(stderr, "kernel_launch: note: occupancy query reports %d workgroups per CU\n", per_cu);
        (void)hipGetLastError();
        grid = cus;
    }
    if (grid < 0) return;
    (void)hipMemsetAsync((char*)d_ws + WS_CTL, 0, CTL_ZERO_BYTES, stream);
    Args a{};
    for (int i = 0; i < 36; ++i) a.in[i] = (const float*)d_in[i];
    a.out = (float*)d_out; a.ws = (unsigned char*)d_ws;
    if (MK_N_LAUNCHES == 1) { a.ph_lo = 0; a.ph_hi = N_PHASES; a.li = 0; hipLaunchKernelGGL(fwd_kernel, dim3(grid), dim3(NWAVES * 64), 0, stream, a); }
    else for (int li = 0; li < N_PHASES; ++li) { a.ph_lo = li; a.ph_hi = li + 1; a.li = li; hipLaunchKernelGGL(fwd_kernel, dim3(grid), dim3(NWAVES * 64), 0, stream, a); }
}
```

```cpp
#include <hip/hip_runtime.h>
#include <cstdio>
#include <cstdint>

#ifndef MK_N_LAUNCHES
#define MK_N_LAUNCHES 1
#endif

#define LAS __attribute__((address_space(3)))
#define GAS __attribute__((address_space(1)))
typedef unsigned short bf16_t;
typedef short bf16x8 __attribute__((ext_vector_type(8)));
typedef short s16x4 __attribute__((ext_vector_type(4)));
typedef float f32x2 __attribute__((ext_vector_type(2)));
typedef float f32x4 __attribute__((ext_vector_type(4)));
typedef float f32x16 __attribute__((ext_vector_type(16)));
typedef unsigned u32x2 __attribute__((ext_vector_type(2)));
typedef unsigned u32x4 __attribute__((ext_vector_type(4)));
typedef __bf16 bf16x2_t __attribute__((ext_vector_type(2)));

constexpr int DM = 1024, TP = 16384, TS = 512, TT = TP + TS, TMEM = 2048, TALL = TT + TMEM;
constexpr int SEQ = 2048, NBATCH = 8, DSEQ = 32, DBATCH = 16, PAST = 2048;
constexpr int INW = 6144, GATEW = 3072, DFF = 2816;
constexpr float EPS = 1e-6f;
constexpr float LOG2E = 1.4426950408889634f;
constexpr float QSCALE = 0.125f * LOG2E;
constexpr float CSCALE = 0.0625f * LOG2E;
constexpr float LAMBDA_INIT = 0.2f;

constexpr size_t O_YP = 0, O_YS = 16777216, O_KP = 17301504, O_VP = 34078720, O_CP = 50855936, O_HP = 50880512,
                 O_MKP = 50888704, O_MVP = 52985856, O_KS = 55083008, O_VS = 55607296, O_CS = 56131584, O_HS = 56180736, O_END = 56197120;

constexpr size_t MiB = 1u << 20;
constexpr size_t WS_CTL = 0, CTL_ZERO_BYTES = 1 * MiB;
constexpr size_t WS_WCAT = 1 * MiB;
constexpr size_t WS_WP = 23 * MiB;
constexpr size_t WS_WO = 29 * MiB;
constexpr size_t WS_WFI = 31 * MiB;
constexpr size_t WS_WFO = 42 * MiB;
constexpr size_t WS_WRG = 47 * MiB + 512 * 1024;
constexpr size_t WS_XN = 48 * MiB;
constexpr size_t WS_MK = 85 * MiB, WS_MV = 89 * MiB;
constexpr size_t WS_Q = 93 * MiB, WS_K = 126 * MiB, WS_V = 159 * MiB, WS_XB = 192 * MiB, WS_GG = 225 * MiB, WS_QC = 258 * MiB;
constexpr size_t WS_G = 291 * MiB;
constexpr size_t WS_AO = 390 * MiB, WS_BO = 423 * MiB, WS_CO = 456 * MiB;
constexpr size_t WS_MG = 48 * MiB;
constexpr size_t WS_X1B = 291 * MiB;
constexpr size_t WS_X1 = 192 * MiB;
constexpr size_t WS_ACT = 93 * MiB;
constexpr size_t WS_SS = 489 * MiB;
constexpr size_t WS_END = 491 * MiB;
constexpr int CW_BAR = 4096, CW_QUEUE = 16384;

constexpr int RING_BYTES = 131072, EXTRA_OFF = RING_BYTES, MISC_OFF = EXTRA_OFF + 320, LAM_OFF = EXTRA_OFF + 512, LUT_OFF = EXTRA_OFF + 1024;
constexpr int LDS_BYTES = 147456;
constexpr int NWAVES = 8;

__device__ __forceinline__ unsigned pk_bf16(float lo, float hi) { f32x2 v = {lo, hi}; bf16x2_t b = __builtin_convertvector(v, bf16x2_t); return __builtin_bit_cast(unsigned, b); }
__device__ __forceinline__ float bf_lo(unsigned u) { return __uint_as_float(u << 16); }
__device__ __forceinline__ float bf_hi(unsigned u) { return __uint_as_float(u & 0xffff0000u); }
__device__ __forceinline__ float bf2f(bf16_t v) { return __uint_as_float(((unsigned)v) << 16); }
__device__ __forceinline__ float fexp2(float x) { return __builtin_amdgcn_exp2f(x); }
__device__ __forceinline__ float frcp(float x) { return __builtin_amdgcn_rcpf(x); }
__device__ __forceinline__ float sigmoidf_(float x) { return frcp(1.0f + fexp2(-x * LOG2E)); }
__device__ __forceinline__ float gelu_tanh(float x) { const float z = 1.5957691216057308f * (x + 0.044715f * x * x * x); return x * frcp(1.0f + fexp2(-z * LOG2E)); }
__device__ __forceinline__ int crow(int r, int hi) { return (r & 3) + 8 * (r >> 2) + 4 * hi; }
__device__ __forceinline__ u32x4 pack8(f32x4 a, f32x4 b) { u32x4 w; w.x = pk_bf16(a[0], a[1]); w.y = pk_bf16(a[2], a[3]); w.z = pk_bf16(b[0], b[1]); w.w = pk_bf16(b[2], b[3]); return w; }
__device__ __forceinline__ void unpack8(u32x4 w, float* f) { f[0] = bf_lo(w.x); f[1] = bf_hi(w.x); f[2] = bf_lo(w.y); f[3] = bf_hi(w.y); f[4] = bf_lo(w.z); f[5] = bf_hi(w.z); f[6] = bf_lo(w.w); f[7] = bf_hi(w.w); }
__device__ __forceinline__ float wave_sum(float v) {
#pragma unroll
    for (int o = 1; o < 64; o <<= 1) v += __shfl_xor(v, o);
    return v;
}
__device__ __forceinline__ s16x4 vtr(const LAS unsigned char* p) { return __builtin_bit_cast(s16x4, __builtin_amdgcn_ds_read_tr16_b64_v4i16((LAS s16x4*)p)); }
#define MFMA32(a, b, c) __builtin_amdgcn_mfma_f32_32x32x16_bf16((a), (b), (c), 0, 0, 0)

namespace pg8 {
constexpr int BM = 256, BK = 64, HALF = 128, HTB = HALF * BK * 2, STAGE_BYTES = 8 * HTB, NXCD = 8, WGM = 8;
__host__ __device__ __forceinline__ int lds_byte(int r, int c) { const int st = (r >> 4) * 2 + (c >> 5), rr = r & 15, cc = c & 31, ob = rr * 64 + cc * 2; return st * 1024 + (ob ^ (((ob >> 9) & 1) << 5)); }
__host__ __device__ __forceinline__ void stage_rc(int b, int& R, int& C) { const int st = b / 1024, sb = b % 1024, swz = sb ^ (((sb >> 9) & 1) << 5); R = (st >> 1) * 16 + swz / 64; C = (st & 1) * 32 + (swz % 64) / 2; }
__host__ __device__ __forceinline__ int perm32(int rho) { const int n = rho >> 4, i = rho & 15; return 8 * (i >> 2) + 4 * n + (i & 3); }

struct Unit { const char* A; const char* B; int pm, pn, kind; };

__device__ __forceinline__ void tile_order(int L, int nM, int nN, int& pm, int& pn) {
    const int nwg = nM * nN; int wgid = L;
    { const int q = nwg / NXCD, r = nwg % NXCD, xcd = wgid % NXCD, off = wgid / NXCD; wgid = (xcd < r ? xcd * (q + 1) : r * (q + 1) + (xcd - r) * q) + off; }
    const int nig = WGM * nN, gid = wgid / nig, fm = gid * WGM, gsz = (nM - fm) < WGM ? (nM - fm) : WGM;
    pm = fm + ((wgid % nig) % gsz); pn = (wgid % nig) / gsz;
}

template <class Epi, class Sched>
__device__ __forceinline__ void gemm_phase(LAS unsigned char* lds, const int K, const Sched& S, const Epi& E) {
    const int tid = threadIdx.x, wid = __builtin_amdgcn_readfirstlane(tid >> 6), lane = tid & 63, wr = wid >> 2, wc = wid & 3, fr = lane & 15, fq = lane >> 4;
    const int nt = K / BK;
    unsigned voffA[2], voffB[2];
#pragma unroll
    for (int i = 0; i < 2; ++i) { int R, C; stage_rc(tid * 16 + i * 8192, R, C); const int Rb = (R & ~31) + perm32(R & 31);
        voffA[i] = (unsigned)(R * K + C) * 2u; voffB[i] = (unsigned)(Rb * K + C) * 2u; }
    const size_t kstep = (size_t)(BK * 2);
    const size_t hstep = (size_t)HALF * K * 2;
    const unsigned ldsw = (unsigned)wid * 1024u;
    const int aoff = lds_byte(wr * 64 + fr, fq * 8), boff = lds_byte(wc * 32 + fr, fq * 8);
#define PG8_SA(b, h) (((b) * 2 + (h)) * HTB)
#define PG8_SB(b, h) ((4 + (b) * 2 + (h)) * HTB)
#define PG8_STAGE(bufoff, gbase, voff) do { _Pragma("unroll") for (int _i = 0; _i < 2; ++_i) \
        __builtin_amdgcn_global_load_lds((const unsigned*)((const char*)(gbase) + (voff)[_i]), (LAS unsigned*)(lds + (bufoff) + ldsw + _i * 8192), 16, 0, 0); } while (0)
#define PG8_LDA(dst, b, h) do { _Pragma("unroll") for (int m = 0; m < 4; ++m) _Pragma("unroll") for (int k = 0; k < 2; ++k) dst[m][k] = *(const LAS bf16x8*)(lds + PG8_SA(b, h) + aoff + m * 2048 + k * 1024); } while (0)
#define PG8_LDB(dst, b, h) do { _Pragma("unroll") for (int n = 0; n < 2; ++n) _Pragma("unroll") for (int k = 0; k < 2; ++k) dst[n][k] = *(const LAS bf16x8*)(lds + PG8_SB(b, h) + boff + n * 2048 + k * 1024); } while (0)
#define PG8_MMA(ai, bj, At, Bt) do { __builtin_amdgcn_s_setprio(1); _Pragma("unroll") for (int m = 0; m < 4; ++m) _Pragma("unroll") for (int n = 0; n < 2; ++n) _Pragma("unroll") for (int k = 0; k < 2; ++k) \
        acc[ai][bj][m][n] = __builtin_amdgcn_mfma_f32_16x16x32_bf16(Bt[n][k], At[m][k], acc[ai][bj][m][n], 0, 0, 0); __builtin_amdgcn_s_setprio(0); } while (0)
#define PG8_WAIT_V(n) asm volatile("s_waitcnt vmcnt(" #n ")" ::: "memory")
#define PG8_WAIT_L(n) asm volatile("s_waitcnt lgkmcnt(" #n ")" ::: "memory")
#define PG8_BAR __builtin_amdgcn_s_barrier()
#define PG8_SCHED __builtin_amdgcn_sched_barrier(0)
#define PG8_ZERO() do { _Pragma("unroll") for (int a = 0; a < 2; ++a) _Pragma("unroll") for (int b = 0; b < 2; ++b) _Pragma("unroll") for (int m = 0; m < 4; ++m) _Pragma("unroll") for (int n = 0; n < 2; ++n) acc[a][b][m][n] = (f32x4){0.f, 0.f, 0.f, 0.f}; } while (0)
    Unit cur, nxt; int ui = 0;
    if (!S.next(0, cur)) return;
    f32x4 acc[2][2][4][2];
    PG8_ZERO();
    bf16x8 At[4][2], B0[2][2], B1[2][2];
    const char* cA = cur.A; const char* cB = cur.B;
    PG8_STAGE(PG8_SB(0, 0), cB, voffB); PG8_STAGE(PG8_SB(0, 1), cB + hstep, voffB); PG8_STAGE(PG8_SA(0, 0), cA, voffA); PG8_STAGE(PG8_SA(0, 1), cA + hstep, voffA);
    if (wr == 1) PG8_BAR;
    PG8_WAIT_V(2); PG8_BAR;
    PG8_STAGE(PG8_SB(1, 0), cB + kstep, voffB); PG8_STAGE(PG8_SA(1, 0), cA + kstep, voffA); PG8_STAGE(PG8_SB(1, 1), cB + hstep + kstep, voffB);
    PG8_WAIT_V(6); PG8_BAR;
    for (;;) {
        const bool has_next = S.next(ui + 1, nxt);
        const char* nA = has_next ? nxt.A : cA; const char* nB = has_next ? nxt.B : cB;
        for (int t = 0; t < nt; t += 2) {
            const bool last = (t == nt - 2);
            const char* a1 = cA + (size_t)(t + 1) * kstep;
            const char* a2 = last ? nA : cA + (size_t)(t + 2) * kstep; const char* b2 = last ? nB : cB + (size_t)(t + 2) * kstep;
            const char* a3 = a2 + kstep; const char* b3 = b2 + kstep;
            PG8_LDB(B0, 0, 0); PG8_LDB(B1, 0, 1); PG8_SCHED; PG8_LDA(At, 0, 0); PG8_STAGE(PG8_SA(1, 1), a1 + hstep, voffA);
            PG8_WAIT_V(8); PG8_WAIT_L(0); PG8_BAR; PG8_MMA(0, 0, At, B0); PG8_MMA(0, 1, At, B1); PG8_BAR; PG8_SCHED;
            PG8_LDA(At, 0, 1); PG8_STAGE(PG8_SB(0, 0), b2, voffB); PG8_STAGE(PG8_SB(0, 1), b2 + hstep, voffB); PG8_STAGE(PG8_SA(0, 0), a2, voffA);
            PG8_WAIT_V(8); PG8_WAIT_L(0); PG8_BAR; PG8_MMA(1, 0, At, B0); PG8_MMA(1, 1, At, B1); PG8_BAR; PG8_SCHED;
            PG8_LDB(B0, 1, 0); PG8_LDB(B1, 1, 1); PG8_SCHED; PG8_LDA(At, 1, 0); PG8_STAGE(PG8_SA(0, 1), a2 + hstep, voffA);
            PG8_WAIT_V(8); PG8_WAIT_L(0); PG8_BAR; PG8_MMA(0, 0, At, B0); PG8_MMA(0, 1, At, B1); PG8_BAR; PG8_SCHED;
            PG8_LDA(At, 1, 1); PG8_STAGE(PG8_SB(1, 0), b3, voffB); PG8_STAGE(PG8_SB(1, 1), b3 + hstep, voffB); PG8_STAGE(PG8_SA(1, 0), a3, voffA);
            PG8_WAIT_V(8); PG8_WAIT_L(0); PG8_BAR; PG8_MMA(1, 0, At, B0); PG8_MMA(1, 1, At, B1); PG8_BAR; PG8_SCHED;
        }
        if (wr == 0) PG8_BAR;
        const bool zero = E(acc, cur, wr, wc, fr, fq);
        if (!has_next) break;
        if (zero) PG8_ZERO();
        cur = nxt; cA = nA; cB = nB; ++ui;
        if (wr == 1) PG8_BAR;
    }
    PG8_WAIT_V(0);
    PG8_BAR;
#undef PG8_SA
#undef PG8_SB
#undef PG8_STAGE
#undef PG8_LDA
#undef PG8_LDB
#undef PG8_MMA
#undef PG8_WAIT_V
#undef PG8_WAIT_L
#undef PG8_BAR
#undef PG8_SCHED
#undef PG8_ZERO
}
}

#define TILE_FOR(...) \
    _Pragma("unroll") for (int ai = 0; ai < 2; ++ai) _Pragma("unroll") for (int m = 0; m < 4; ++m) { const int row = rowb + ai * 128 + m * 16; \
    _Pragma("unroll") for (int bj = 0; bj < 2; ++bj) { const int col = colb + bj * 128; f32x4& v0 = acc[ai][bj][m][0]; f32x4& v1 = acc[ai][bj][m][1]; __VA_ARGS__ } }

#define XB_TMO      128
#define XB_XCNT(j)  (256  + 64 * (j))
#define XB_XSUB(j)  (1280 + 64 * (j))
#define XB_XGEN(j)  (2304 + 64 * (j))
#define XB_TOP      3328
#define XB_TOPGEN   3392
#define XCD_BAR_WORDS 3456
#define XB_SPIN_CAP (1u << 18)
__device__ __forceinline__ unsigned xb_ld(unsigned* p)              { return __hip_atomic_load(p, __ATOMIC_RELAXED, __HIP_MEMORY_SCOPE_AGENT); }
__device__ __forceinline__ unsigned xb_add(unsigned* p, unsigned v) { return __hip_atomic_fetch_add(p, v, __ATOMIC_RELAXED, __HIP_MEMORY_SCOPE_AGENT); }
__device__ __forceinline__ unsigned xb_xcc_id() { return (unsigned)__builtin_amdgcn_s_getreg((3 << 11) | 20) & 0xFu; }
#define XB_SPIN(cond, bar) do { unsigned _sp = 0; while (cond) { __builtin_amdgcn_s_sleep(1); \
    if ((++_sp & 255u) == 0u) { if (xb_ld(&(bar)[XB_TMO])) break; if (_sp > XB_SPIN_CAP) { atomicAdd(&(bar)[XB_TMO], 1u); break; } } } } while (0)
struct XcdBarrier { unsigned* bar; unsigned x; volatile LAS unsigned* st; };
__device__ __forceinline__ XcdBarrier xcd_barrier_post(unsigned* bar, volatile LAS unsigned* st) {
    XcdBarrier b; b.bar = bar; b.x = xb_xcc_id(); b.st = st;
    if (threadIdx.x == 0) (void)xb_add(&bar[XB_XCNT(b.x)], 1u);
    return b;
}
__device__ __forceinline__ void xcd_barrier_complete(unsigned* bar, unsigned x, unsigned& nloc, unsigned& nx) {
    const unsigned G = gridDim.x * gridDim.y * gridDim.z;
    unsigned sum, cnt, mine, sp = 0u;
    for (;;) {
        sum = 0u; cnt = 0u; mine = 0u;
#pragma unroll
        for (unsigned j = 0; j < 16; ++j) { const unsigned c = xb_ld(&bar[XB_XCNT(j)]); sum += c; cnt += (c > 0u) ? 1u : 0u; mine = (j == x) ? c : mine; }
        if (sum == G) break;
        __builtin_amdgcn_s_sleep(1);
        if ((++sp & 255u) == 0u) { if (xb_ld(&bar[XB_TMO])) break; if (sp > XB_SPIN_CAP) { atomicAdd(&bar[XB_TMO], 1u); break; } }
    }
    nloc = mine > 0u ? mine : 1u; nx = cnt > 0u ? cnt : 1u;
}
__device__ __forceinline__ void xcd_barrier(const XcdBarrier& b) {
    asm volatile("s_waitcnt vmcnt(0)" ::: "memory");
    __syncthreads();
    if (threadIdx.x == 0) {
        unsigned* bar = b.bar;
        __builtin_amdgcn_s_waitcnt(0);
        unsigned nloc = b.st[0], nx = b.st[1];
        if (nloc == 0u) { xcd_barrier_complete(bar, b.x, nloc, nx); b.st[0] = nloc; b.st[1] = nx; }
        const unsigned old = xb_add(&bar[XB_XSUB(b.x)], 1u);
        const unsigned gen = old / nloc;
        if (old + 1u == (gen + 1u) * nloc) {
            __builtin_amdgcn_fence(__ATOMIC_RELEASE, "agent");
            asm volatile("s_waitcnt vmcnt(0)" ::: "memory");
            const unsigned og = xb_add(&bar[XB_TOP], 1u);
            const unsigned tg = og / nx;
            if (og + 1u == (tg + 1u) * nx) xb_add(&bar[XB_TOPGEN], 1u);
            else XB_SPIN(xb_ld(&bar[XB_TOPGEN]) == tg, bar);
            __builtin_amdgcn_fence(__ATOMIC_ACQUIRE, "agent");
            xb_add(&bar[XB_XGEN(b.x)], 1u);
            asm volatile("s_waitcnt vmcnt(0)" ::: "memory");
        } else {
            XB_SPIN(xb_ld(&bar[XB_XGEN(b.x)]) == gen, bar);
            __builtin_amdgcn_fence(__ATOMIC_ACQUIRE, "agent");
            asm volatile("s_waitcnt vmcnt(0)" ::: "memory");
        }
    }
    __syncthreads();
}

struct Args { const float* in[36]; float* out; unsigned char* ws; int ph_lo, ph_hi, li, pad; };
enum { I_XP = 0, I_XS, I_MEM, I_CK, I_CV, I_SCONV, I_SLRU, I_CMK, I_CMV, I_REL, I_NMIX, I_WIN, I_LQ1, I_LK1, I_LQ2, I_LK2, I_SUBG, I_CONVW, I_CONVB,
       I_WRGA, I_BRGA, I_WRGX, I_BRGX, I_RGL, I_NMEM, I_WMEM, I_WPA, I_WPB, I_WPC, I_WGATE, I_BGATE, I_WOUT, I_NFFN, I_WFI, I_WFO, I_NFIN };

__device__ __forceinline__ void transpose_item(const float* W, int K, int N, bf16_t* WT, int kb, int nb, int dst_row0, const float* kscale, LAS float* scr, int lane) {
    const int k0 = 64 * kb, n0 = 32 * nb;
#pragma unroll 8
    for (int i = 0; i < 32; ++i) { const int kk = 2 * i + (lane >> 5); scr[kk * 33 + (lane & 31)] = W[(size_t)(k0 + kk) * N + n0 + (lane & 31)]; }
    asm volatile("s_waitcnt lgkmcnt(0)" ::: "memory");
    const int c = lane & 7;
    float sc[8];
#pragma unroll
    for (int e = 0; e < 8; ++e) sc[e] = kscale ? kscale[k0 + 8 * c + e] : 1.0f;
#pragma unroll
    for (int j = 0; j < 4; ++j) { const int n = (lane >> 3) + 8 * j; const LAS float* s = scr + (8 * c) * 33 + n;
        u32x4 o; o.x = pk_bf16(s[0 * 33] * sc[0], s[1 * 33] * sc[1]); o.y = pk_bf16(s[2 * 33] * sc[2], s[3 * 33] * sc[3]);
        o.z = pk_bf16(s[4 * 33] * sc[4], s[5 * 33] * sc[5]); o.w = pk_bf16(s[6 * 33] * sc[6], s[7 * 33] * sc[7]);
        *(u32x4*)(WT + (size_t)(dst_row0 + n) * K + k0 + 8 * c) = o; }
    asm volatile("s_waitcnt lgkmcnt(0)" ::: "memory");
}
__device__ __forceinline__ void norm_row_bf16(const float* xrow, const float* gain, bf16_t* orow, int lane) {
    const f32x4* xr = (const f32x4*)xrow + lane; const f32x4* gr = (const f32x4*)gain + lane;
    f32x4 v[4]; float s = 0.f;
#pragma unroll
    for (int j = 0; j < 4; ++j) { v[j] = xr[64 * j]; s += (v[j].x * v[j].x + v[j].y * v[j].y) + (v[j].z * v[j].z + v[j].w * v[j].w); }
    const float rstd = 1.0f / sqrtf(wave_sum(s) * (1.0f / 1024.0f) + EPS);
    u32x2* o8 = (u32x2*)orow + lane;
#pragma unroll
    for (int j = 0; j < 4; ++j) { const f32x4 g = gr[64 * j]; u32x2 w; w.x = pk_bf16(v[j].x * rstd * g.x, v[j].y * rstd * g.y); w.y = pk_bf16(v[j].z * rstd * g.z, v[j].w * rstd * g.w); o8[64 * j] = w; }
}
__device__ __forceinline__ void p0_prologue(const Args& a, LAS unsigned char* lds, int gw, int NGW, int wave, int lane) {
    LAS float* scr = (LAS float*)(lds + wave * 16384);
    unsigned char* ws = a.ws;
    constexpr int I0 = 16 * 192, I1 = 16 * 96, I2 = 16 * 64, I3 = 16 * 32, I7 = 16 * 176, I8 = 44 * 32, I9 = 64;
    constexpr int NITEMS = I0 + I1 + I2 + 4 * I3 + I7 + I8 + 2 * I9;
    for (int it = gw; it < NITEMS; it += NGW) {
        int r = it;
        if (r < I0) { transpose_item(a.in[I_WIN], 1024, INW, (bf16_t*)(ws + WS_WCAT), r / 192, r % 192, 32 * (r % 192), nullptr, scr, lane); continue; } r -= I0;
        if (r < I1) { transpose_item(a.in[I_WGATE], 1024, GATEW, (bf16_t*)(ws + WS_WCAT), r / 96, r % 96, 6144 + 32 * (r % 96), nullptr, scr, lane); continue; } r -= I1;
        if (r < I2) { transpose_item(a.in[I_WMEM], 1024, 2048, (bf16_t*)(ws + WS_WCAT), r / 64, r % 64, 9216 + 32 * (r % 64), nullptr, scr, lane); continue; } r -= I2;
        if (r < I3) { transpose_item(a.in[I_WPA], 1024, 1024, (bf16_t*)(ws + WS_WP), r / 32, r % 32, 32 * (r % 32), nullptr, scr, lane); continue; } r -= I3;
        if (r < I3) { transpose_item(a.in[I_WPB], 1024, 1024, (bf16_t*)(ws + WS_WP), r / 32, r % 32, 1024 + 32 * (r % 32), nullptr, scr, lane); continue; } r -= I3;
        if (r < I3) { transpose_item(a.in[I_WPC], 1024, 1024, (bf16_t*)(ws + WS_WP), r / 32, r % 32, 2048 + 32 * (r % 32), nullptr, scr, lane); continue; } r -= I3;
        if (r < I3) { transpose_item(a.in[I_WOUT], 1024, 1024, (bf16_t*)(ws + WS_WO), r / 32, r % 32, 32 * (r % 32), nullptr, scr, lane); continue; } r -= I3;
        if (r < I7) { const int nb = r % 176, n0 = 32 * nb; const int ch0 = n0 < DFF ? n0 : n0 - DFF; const int dst = 256 * (ch0 / 128) + (n0 < DFF ? 0 : 128) + (ch0 % 128);
            transpose_item(a.in[I_WFI], 1024, 2 * DFF, (bf16_t*)(ws + WS_WFI), r / 176, nb, dst, a.in[I_NFFN], scr, lane); continue; } r -= I7;
        if (r < I8) { transpose_item(a.in[I_WFO], DFF, 1024, (bf16_t*)(ws + WS_WFO), r / 32, r % 32, 32 * (r % 32), nullptr, scr, lane); continue; } r -= I8;
        if (r < I9) { const int n = r / 8, s = r % 8;
          transpose_item(a.in[I_WRGA] + (size_t)n * 128 * 128, 128, 128, (bf16_t*)(ws + WS_WRG) + (size_t)n * 128 * 128, s / 4, s % 4, 32 * (s % 4), nullptr, scr, lane); continue; } r -= I9;
        { const int n = r / 8, s = r % 8;
          transpose_item(a.in[I_WRGX] + (size_t)n * 128 * 128, 128, 128, (bf16_t*)(ws + WS_WRG) + (size_t)(8 + n) * 128 * 128, s / 4, s % 4, 32 * (s % 4), nullptr, scr, lane); }
    }
    bf16_t* XN = (bf16_t*)(ws + WS_XN);
    for (int m = gw; m < TALL; m += NGW) {
        if (m < TP) norm_row_bf16(a.in[I_XP] + (size_t)m * DM, a.in[I_NMIX], XN + (size_t)m * DM, lane);
        else if (m < TT) norm_row_bf16(a.in[I_XS] + (size_t)(m - TP) * DM, a.in[I_NMIX], XN + (size_t)m * DM, lane);
        else norm_row_bf16(a.in[I_MEM] + (size_t)(m - TT) * DM, a.in[I_NMEM], XN + (size_t)m * DM, lane);
    }
}

struct Sched1 {
    const char* A; const char* B; int G, c;
    __device__ __forceinline__ bool next(int i, pg8::Unit& u) const {
        const int L = i * G + c;
        if (L < 66 * 36) { int pm, pn; pg8::tile_order(L, 66, 36, pm, pn); u.pm = pm; u.pn = pn; u.kind = pn >> 2;
            u.A = A + (size_t)pm * 256 * 1024 * 2; u.B = B + (size_t)pn * 256 * 1024 * 2; return true; }
        const int L2 = L - 66 * 36;
        if (L2 < 64) { int pm, pn; pg8::tile_order(L2, 8, 8, pm, pn); u.pm = pm; u.pn = pn; u.kind = 9;
            u.A = A + (size_t)(66 + pm) * 256 * 1024 * 2; u.B = B + (size_t)(36 + pn) * 256 * 1024 * 2; return true; }
        return false;
    }
};
struct Epi1 {
    bf16_t *Q, *Kb, *Vb, *XB, *GG, *QC, *G, *MK, *MV; float* out; const float* bgate;
    __device__ __forceinline__ bool operator()(f32x4 (&acc)[2][2][4][2], const pg8::Unit& u, int wr, int wc, int fr, int fq) const {
        const int rowb = u.pm * 256 + wr * 64 + fr, colb = (u.pn & 3) * 256 + wc * 32 + 8 * fq;
        const int kind = u.kind;
        if (kind == 0) { TILE_FOR( *(u32x4*)(Q + (size_t)row * DM + col) = pack8(v0 * QSCALE, v1 * QSCALE); ) }
        else if (kind == 1 || kind == 2) {
            bf16_t* B = kind == 1 ? Kb : Vb; const size_t op = kind == 1 ? O_KP : O_VP, os = kind == 1 ? O_KS : O_VS;
            TILE_FOR( *(u32x4*)(B + (size_t)row * DM + col) = pack8(v0, v1);
                      float* o = out + (row < TP ? op + (size_t)row * DM : os + (size_t)(row - TP) * DM) + col; *(f32x4*)o = v0; *(f32x4*)(o + 4) = v1; ) }
        else if (kind == 3) {
            TILE_FOR( *(u32x4*)(XB + (size_t)row * DM + col) = pack8(v0, v1);
                      if (row < TP) { const int s = row & (SEQ - 1); if (s >= SEQ - 3) { float* o = out + O_CP + (size_t)((row >> 11) * 3 + (s - (SEQ - 3))) * DM + col; *(f32x4*)o = v0; *(f32x4*)(o + 4) = v1; } }
                      else { const int rs = row - TP, s = rs & (DSEQ - 1); if (s >= DSEQ - 3) { float* o = out + O_CS + (size_t)((rs >> 5) * 3 + (s - (DSEQ - 3))) * DM + col; *(f32x4*)o = v0; *(f32x4*)(o + 4) = v1; } } ) }
        else if (kind == 4) {
            TILE_FOR( f32x4 g0, g1;
                      _Pragma("unroll") for (int j = 0; j < 4; ++j) { g0[j] = gelu_tanh(v0[j]); g1[j] = gelu_tanh(v1[j]); }
                      *(u32x4*)(GG + (size_t)row * DM + col) = pack8(g0, g1); ) }
        else if (kind == 5) { TILE_FOR( *(u32x4*)(QC + (size_t)row * DM + col) = pack8(v0 * CSCALE, v1 * CSCALE); ) }
        else if (kind <= 8) {
            const int gofs = (kind - 6) * 1024;
            TILE_FOR( const f32x4 b0 = *(const f32x4*)(bgate + gofs + col); const f32x4 b1 = *(const f32x4*)(bgate + gofs + col + 4); f32x4 g0, g1;
                      _Pragma("unroll") for (int j = 0; j < 4; ++j) { g0[j] = sigmoidf_(v0[j] + b0[j]); g1[j] = sigmoidf_(v1[j] + b1[j]); }
                      *(u32x4*)(G + (size_t)row * GATEW + gofs + col) = pack8(g0, g1); ) }
        else {
            bf16_t* B = u.pn < 4 ? MK : MV; const size_t ob = u.pn < 4 ? O_MKP : O_MVP;
            TILE_FOR( *(u32x4*)(B + (size_t)row * DM + col) = pack8(v0, v1);
                      float* o = out + ob + (size_t)row * DM + col; *(f32x4*)o = v0; *(f32x4*)(o + 4) = v1; ) }
        return true;
    }
};

struct Sched2 {
    const char* A0; const char* A1; const char* A2; const char* B; int G, c;
    __device__ __forceinline__ bool next(int i, pg8::Unit& u) const {
        const int j = i / 3, br = i - 3 * j; const int L = j * G + c;
        if (L >= 64 * 4) return false;
        int pm, pn; pg8::tile_order(L, 64, 4, pm, pn); u.pm = pm; u.pn = pn; u.kind = br;
        u.A = (br == 0 ? A0 : br == 1 ? A1 : A2) + (size_t)pm * 256 * 1024 * 2; u.B = B + (size_t)(br * 1024 + pn * 256) * 1024 * 2; return true;
    }
};
struct Epi2 {
    const bf16_t* G; bf16_t* MG; float* P;
    __device__ __forceinline__ bool operator()(f32x4 (&acc)[2][2][4][2], const pg8::Unit& u, int wr, int wc, int fr, int fq) const {
        const int rowb = u.pm * 256 + wr * 64 + fr, colb = u.pn * 256 + wc * 32 + 8 * fq;
        const int br = u.kind;
        TILE_FOR( const u32x4 gc = *(const u32x4*)(G + (size_t)row * GATEW + br * 1024 + col); float c[8]; unpack8(gc, c);
                  float* pp = P + (size_t)row * DM + col; f32x4 o0, o1;
                  _Pragma("unroll") for (int j = 0; j < 4; ++j) { o0[j] = v0[j] * c[j]; o1[j] = v1[j] * c[4 + j]; }
                  if (br > 0) { o0 += *(const f32x4*)pp; o1 += *(const f32x4*)(pp + 4); }
                  if (br < 2) { *(f32x4*)pp = o0; *(f32x4*)(pp + 4) = o1; }
                  else *(u32x4*)(MG + (size_t)row * DM + col) = pack8(o0, o1); )
        return true;
    }
};

struct SchedT {
    const char* A; const char* B; int nM, nN, K, G, c;
    __device__ __forceinline__ bool next(int i, pg8::Unit& u) const {
        const int L = i * G + c; if (L >= nM * nN) return false;
        int pm, pn; pg8::tile_order(L, nM, nN, pm, pn); u.pm = pm; u.pn = pn; u.kind = 0;
        u.A = A + (size_t)pm * 256 * K * 2; u.B = B + (size_t)pn * 256 * K * 2; return true;
    }
};
struct Epi3 {
    const float* xp; const float* xs; float* X1; bf16_t* X1B; float* SS;
    __device__ __forceinline__ bool operator()(f32x4 (&acc)[2][2][4][2], const pg8::Unit& u, int wr, int wc, int fr, int fq) const {
        const int rowb = u.pm * 256 + wr * 64 + fr, colb = u.pn * 256 + wc * 32 + 8 * fq;
#pragma unroll
        for (int ai = 0; ai < 2; ++ai)
#pragma unroll
            for (int m = 0; m < 4; ++m) { const int row = rowb + ai * 128 + m * 16; float ss = 0.f;
                const float* xr = row < TP ? xp + (size_t)row * DM : xs + (size_t)(row - TP) * DM;
#pragma unroll
                for (int bj = 0; bj < 2; ++bj) { const int col = colb + bj * 128;
                    const f32x4 a0 = acc[ai][bj][m][0] + *(const f32x4*)(xr + col), a1 = acc[ai][bj][m][1] + *(const f32x4*)(xr + col + 4);
                    *(f32x4*)(X1 + (size_t)row * DM + col) = a0; *(f32x4*)(X1 + (size_t)row * DM + col + 4) = a1;
                    *(u32x4*)(X1B + (size_t)row * DM + col) = pack8(a0, a1);
                    ss += (a0[0] * a0[0] + a0[1] * a0[1]) + (a0[2] * a0[2] + a0[3] * a0[3]) + (a1[0] * a1[0] + a1[1] * a1[1]) + (a1[2] * a1[2] + a1[3] * a1[3]); }
                ss += __shfl_xor(ss, 16); ss += __shfl_xor(ss, 32);
                if (fq == 0) SS[(size_t)row * 16 + u.pn * 4 + wc] = ss; }
        return true;
    }
};
struct Epi4 {
    const float* SS; bf16_t* ACT;
    __device__ __forceinline__ bool operator()(f32x4 (&acc)[2][2][4][2], const pg8::Unit& u, int wr, int wc, int fr, int fq) const {
        const int rowb = u.pm * 256 + wr * 64 + fr, colb = u.pn * 128 + wc * 32 + 8 * fq;
#pragma unroll
        for (int ai = 0; ai < 2; ++ai)
#pragma unroll
            for (int m = 0; m < 4; ++m) { const int row = rowb + ai * 128 + m * 16;
                const f32x4 p = *(const f32x4*)(SS + (size_t)row * 16 + 4 * fq); float s = (p[0] + p[1]) + (p[2] + p[3]);
                s += __shfl_xor(s, 16); s += __shfl_xor(s, 32);
                const float rstd = 1.0f / sqrtf(s * (1.0f / 1024.0f) + EPS);
                f32x4 o0, o1;
#pragma unroll
                for (int j = 0; j < 4; ++j) { const float g0 = acc[ai][0][m][0][j] * rstd, u0 = acc[ai][1][m][0][j] * rstd, g1 = acc[ai][0][m][1][j] * rstd, u1 = acc[ai][1][m][1][j] * rstd;
                    o0[j] = g0 * sigmoidf_(g0) * u0; o1[j] = g1 * sigmoidf_(g1) * u1; }
                *(u32x4*)(ACT + (size_t)row * DFF + colb) = pack8(o0, o1); }
        return true;
    }
};
struct Epi5 {
    float* X1;
    __device__ __forceinline__ bool operator()(f32x4 (&acc)[2][2][4][2], const pg8::Unit& u, int wr, int wc, int fr, int fq) const {
        const int rowb = u.pm * 256 + wr * 64 + fr, colb = u.pn * 256 + wc * 32 + 8 * fq;
        TILE_FOR( float* p = X1 + (size_t)row * DM + col; const f32x4 a0 = v0 + *(const f32x4*)p, a1 = v1 + *(const f32x4*)(p + 4); *(f32x4*)p = a0; *(f32x4*)(p + 4) = a1; )
        return true;
    }
};


template <int NSEG, class Fin>
__device__ __forceinline__ void tail_gemm(LAS unsigned char* lds, const bf16_t* A0, const bf16_t* A1, const bf16_t* A2, const bf16_t* Bt, const int Kseg, const bf16_t* G, const Fin& fin, int G_, int bx) {
    const int tid = threadIdx.x, wid = __builtin_amdgcn_readfirstlane(tid >> 6), lane = tid & 63, fr = lane & 15, fq = lane >> 4;
    const int ksl = Kseg / 8, kbase = wid * ksl;
    LAS float* part = (LAS float*)lds;
    for (int tile = bx; tile < 256; tile += G_) {
        const int rt = tile >> 4, ct = tile & 15, r0 = TP + rt * 32, c0 = ct * 64;
        f32x4 tot[2][4];
#pragma unroll
        for (int m = 0; m < 2; ++m)
#pragma unroll
            for (int n = 0; n < 4; ++n) tot[m][n] = (f32x4){0.f, 0.f, 0.f, 0.f};
#pragma unroll
        for (int seg = 0; seg < NSEG; ++seg) {
            const bf16_t* A = seg == 0 ? A0 : seg == 1 ? A1 : A2;
            f32x4 acc[2][4];
#pragma unroll
            for (int m = 0; m < 2; ++m)
#pragma unroll
                for (int n = 0; n < 4; ++n) acc[m][n] = (f32x4){0.f, 0.f, 0.f, 0.f};
            const bf16_t* ap = A + (size_t)(r0 + fr) * Kseg + kbase + 8 * fq;
            const bf16_t* wp = Bt + (size_t)(seg * 1024 + c0 + fr) * Kseg + kbase + 8 * fq;
#pragma unroll 2
            for (int kk = 0; kk < ksl; kk += 32) {
                bf16x8 af[2], wf[4];
#pragma unroll
                for (int m = 0; m < 2; ++m) af[m] = *(const bf16x8*)(ap + (size_t)(16 * m) * Kseg + kk);
#pragma unroll
                for (int n = 0; n < 4; ++n) wf[n] = *(const bf16x8*)(wp + (size_t)(16 * n) * Kseg + kk);
#pragma unroll
                for (int m = 0; m < 2; ++m)
#pragma unroll
                    for (int n = 0; n < 4; ++n) acc[m][n] = __builtin_amdgcn_mfma_f32_16x16x32_bf16(wf[n], af[m], acc[m][n], 0, 0, 0);
            }
            if (G) {
#pragma unroll
                for (int m = 0; m < 2; ++m)
#pragma unroll
                    for (int n = 0; n < 4; ++n) { const u32x2 g = *(const u32x2*)(G + (size_t)(r0 + 16 * m + fr) * GATEW + seg * 1024 + c0 + 16 * n + 4 * fq);
                        tot[m][n][0] += acc[m][n][0] * bf_lo(g.x); tot[m][n][1] += acc[m][n][1] * bf_hi(g.x); tot[m][n][2] += acc[m][n][2] * bf_lo(g.y); tot[m][n][3] += acc[m][n][3] * bf_hi(g.y); }
            } else {
#pragma unroll
                for (int m = 0; m < 2; ++m)
#pragma unroll
                    for (int n = 0; n < 4; ++n) tot[m][n] += acc[m][n];
            }
        }
#pragma unroll
        for (int m = 0; m < 2; ++m)
#pragma unroll
            for (int n = 0; n < 4; ++n) *(LAS f32x4*)(part + wid * 2048 + (16 * m + fr) * 64 + 16 * n + 4 * fq) = tot[m][n];
        __syncthreads();
        { const int row = tid >> 4, c4 = tid & 15;
          f32x4 v = *(const LAS f32x4*)(part + row * 64 + c4 * 4);
#pragma unroll
          for (int w = 1; w < 8; ++w) v += *(const LAS f32x4*)(part + w * 2048 + row * 64 + c4 * 4);
          fin(r0 + row, c0 + c4 * 4, v, ct); }
        __syncthreads();
    }
}
struct Fin3 { bf16_t* MG;
    __device__ __forceinline__ void operator()(int row, int col, f32x4 v, int) const { u32x2 w; w.x = pk_bf16(v[0], v[1]); w.y = pk_bf16(v[2], v[3]); *(u32x2*)(MG + (size_t)row * DM + col) = w; } };
struct Fin4 { const float* xs; float* X1; bf16_t* X1B; float* SS;
    __device__ __forceinline__ void operator()(int row, int col, f32x4 v, int ct) const {
        const f32x4 a = v + *(const f32x4*)(xs + (size_t)(row - TP) * DM + col);
        *(f32x4*)(X1 + (size_t)row * DM + col) = a; u32x2 w; w.x = pk_bf16(a[0], a[1]); w.y = pk_bf16(a[2], a[3]); *(u32x2*)(X1B + (size_t)row * DM + col) = w;
        float ss = (a[0] * a[0] + a[1] * a[1]) + (a[2] * a[2] + a[3] * a[3]);
        ss += __shfl_xor(ss, 1); ss += __shfl_xor(ss, 2); ss += __shfl_xor(ss, 4); ss += __shfl_xor(ss, 8);
        if ((threadIdx.x & 15) == 0) SS[(size_t)row * 16 + ct] = ss; } };
struct Fin6 { float* X1;
    __device__ __forceinline__ void operator()(int row, int col, f32x4 v, int) const { float* p = X1 + (size_t)row * DM + col; *(f32x4*)p = v + *(const f32x4*)p; } };

struct P2Ctx {
    const Args* a; LAS unsigned char* lds; int tid, lane, wid;
    const bf16_t *Q, *Kb, *Vb, *XB, *GG, *QC, *MK, *MV, *WRG; bf16_t *AO, *BO, *CO;
};
template <int NB>
__device__ __forceinline__ float softmax_step(f32x16 (&s)[NB], float& m, float& l) {
    float mx = s[0][0];
#pragma unroll
    for (int b = 0; b < NB; ++b)
#pragma unroll
        for (int r = 0; r < 16; ++r) mx = fmaxf(mx, s[b][r]);
    mx = fmaxf(mx, __shfl_xor(mx, 32));
    const float mn = fmaxf(m, mx), alpha = fexp2(m - mn);
    float ps = 0.f;
#pragma unroll
    for (int b = 0; b < NB; ++b)
#pragma unroll
        for (int r = 0; r < 16; ++r) { const float p = fexp2(s[b][r] - mn); s[b][r] = p; ps += p; }
    l = l * alpha + ps; m = mn;
    return alpha;
}
__device__ __forceinline__ bf16x8 pack_p(const f32x16& s, int h) {
    u32x4 w; w.x = pk_bf16(s[8 * h + 0], s[8 * h + 1]); w.y = pk_bf16(s[8 * h + 2], s[8 * h + 3]); w.z = pk_bf16(s[8 * h + 4], s[8 * h + 5]); w.w = pk_bf16(s[8 * h + 6], s[8 * h + 7]);
    return __builtin_bit_cast(bf16x8, w);
}
__device__ __forceinline__ bf16x8 v_frag(const LAS unsigned char* vimg, int ncb, int s, int cb, int lane) {
    const int hi = lane >> 5, g16 = (lane >> 4) & 1, i = lane & 15;
    const LAS unsigned char* p = vimg + ((2 * s) * ncb + cb) * 512 + (4 * hi + (i >> 2)) * 64 + g16 * 32 + (i & 3) * 8;
    const s16x4 lo = vtr(p), hv = vtr(p + ncb * 512);
    return (bf16x8){lo[0], lo[1], lo[2], lo[3], hv[0], hv[1], hv[2], hv[3]};
}
__device__ __forceinline__ void subln_store(f32x16 (&o)[4], const float* subg, bf16_t* dst  , int lane) {
    const int hi = lane >> 5;
    float ss = 0.f;
#pragma unroll
    for (int cb = 0; cb < 4; ++cb)
#pragma unroll
        for (int r = 0; r < 16; ++r) ss += o[cb][r] * o[cb][r];
    ss += __shfl_xor(ss, 32);
    const float rstd = (1.0f - LAMBDA_INIT) / sqrtf(ss * (1.0f / 128.0f) + EPS);
#pragma unroll
    for (int cb = 0; cb < 4; ++cb)
#pragma unroll
        for (int g = 0; g < 4; ++g) { const int dv0 = 32 * cb + 8 * g + 4 * hi; const f32x4 sg = *(const f32x4*)(subg + dv0);
            u32x2 w; w.x = pk_bf16(o[cb][4 * g + 0] * rstd * sg[0], o[cb][4 * g + 1] * rstd * sg[1]); w.y = pk_bf16(o[cb][4 * g + 2] * rstd * sg[2], o[cb][4 * g + 3] * rstd * sg[3]);
            *(u32x2*)(dst + dv0) = w; }
}

__device__ __forceinline__ void attnA_unit(const P2Ctx& C, int b, int h, int qb) {
    LAS unsigned char* lds = C.lds; const int tid = C.tid, lane = C.lane, wid = C.wid;
    const int comp = wid >> 2, qs = wid & 3, r32 = lane & 31, hi = lane >> 5;
    const int q0 = qb * 128, trow0 = b * SEQ;
    const int qpos = q0 + qs * 32 + r32; const size_t qrow = (size_t)(trow0 + qpos);
    const int qcw = (q0 + qs * 32) >> 6, ntw = qcw + 1, NT = 2 * qb + 2;
    const LAS float* lut = (const LAS float*)(lds + LUT_OFF) + h * 256;
    const float lam = *(const LAS float*)(lds + LAM_OFF);
    bf16x8 qf[4];
#pragma unroll
    for (int ds = 0; ds < 4; ++ds) qf[ds] = *(const bf16x8*)(C.Q + qrow * DM + h * 128 + comp * 64 + ds * 16 + hi * 8);
    u32x4 kreg[2], vreg[2];
    const int kkey = tid >> 3, kch = tid & 7;
#define A_ISSUE(kt) do { const size_t tr_ = (size_t)(trow0 + (kt) * 64); \
        kreg[0] = *(const u32x4*)(C.Kb + (tr_ + kkey) * DM + h * 128 + kch * 8); kreg[1] = *(const u32x4*)(C.Kb + (tr_ + kkey) * DM + h * 128 + 64 + kch * 8); \
        _Pragma("unroll") for (int i_ = 0; i_ < 2; ++i_) { const int idx_ = tid + 512 * i_; vreg[i_] = *(const u32x4*)(C.Vb + (tr_ + (idx_ >> 4)) * DM + h * 128 + (idx_ & 15) * 8); } } while (0)
#define A_WRITE(st) do { LAS unsigned char* sb_ = lds + (st) * 32768; \
        *(LAS u32x4*)(sb_ + kkey * 128 + ((kch ^ ((kkey >> 1) & 7)) << 4)) = kreg[0]; *(LAS u32x4*)(sb_ + 8192 + kkey * 128 + ((kch ^ ((kkey >> 1) & 7)) << 4)) = kreg[1]; \
        _Pragma("unroll") for (int i_ = 0; i_ < 2; ++i_) { const int idx_ = tid + 512 * i_, key_ = idx_ >> 4, ch_ = idx_ & 15; \
            *(LAS u32x4*)(sb_ + 16384 + ((key_ >> 3) * 4 + (ch_ >> 2)) * 512 + (key_ & 7) * 64 + (ch_ & 3) * 16) = vreg[i_]; } } while (0)
    f32x16 o[4];
#pragma unroll
    for (int cb = 0; cb < 4; ++cb)
#pragma unroll
        for (int r = 0; r < 16; ++r) o[cb][r] = 0.f;
    float m = -1e30f, l = 0.f;
    A_ISSUE(0); A_WRITE(0); __syncthreads();
    for (int kt = 0; kt < NT; ++kt) {
        if (kt + 1 < NT) A_ISSUE(kt + 1);
        if (kt < ntw) {
            const LAS unsigned char* sb = lds + (kt & 1) * 32768;
            const int relmax = kt * 64 + 63 - (q0 + qs * 32);
            const bool far = (relmax + 192 <= 0);
            f32x16 s[2];
            { const float c0 = far ? lut[0] : 0.f;
#pragma unroll
              for (int kb = 0; kb < 2; ++kb)
#pragma unroll
                  for (int r = 0; r < 16; ++r) s[kb][r] = c0; }
#pragma unroll
            for (int ds = 0; ds < 4; ++ds)
#pragma unroll
                for (int kb = 0; kb < 2; ++kb) { const int key = kb * 32 + r32, ch = 2 * ds + hi;
                    const bf16x8 kf = *(const LAS bf16x8*)(sb + comp * 8192 + key * 128 + ((ch ^ ((key >> 1) & 7)) << 4));
                    s[kb] = MFMA32(kf, qf[ds], s[kb]); }
            if (!far) {
#pragma unroll
                for (int kb = 0; kb < 2; ++kb)
#pragma unroll
                    for (int r = 0; r < 16; ++r) { const int rel = kt * 64 + kb * 32 + crow(r, hi) - qpos; const int idx = rel + 192 > 0 ? rel + 192 : 0; s[kb][r] += lut[idx]; }
            }
            const float alpha = softmax_step<2>(s, m, l);
#pragma unroll
            for (int cb = 0; cb < 4; ++cb)
#pragma unroll
                for (int r = 0; r < 16; ++r) o[cb][r] *= alpha;
            bf16x8 pf[4];
            pf[0] = pack_p(s[0], 0); pf[1] = pack_p(s[0], 1); pf[2] = pack_p(s[1], 0); pf[3] = pack_p(s[1], 1);
#pragma unroll
            for (int cb = 0; cb < 4; ++cb)
#pragma unroll
                for (int ks = 0; ks < 4; ++ks) o[cb] = MFMA32(v_frag(sb + 16384, 4, ks, cb, lane), pf[ks], o[cb]);
        }
        if (kt + 1 < NT) A_WRITE((kt + 1) & 1);
        __syncthreads();
    }
#undef A_ISSUE
#undef A_WRITE
    l += __shfl_xor(l, 32);
    const float inv = 1.0f / l;
    LAS float* X2 = (LAS float*)(lds + 65536);
    if (comp == 1) {
#pragma unroll
        for (int cb = 0; cb < 4; ++cb)
#pragma unroll
            for (int r = 0; r < 16; ++r) X2[((qs * 4 + cb) * 16 + r) * 64 + lane] = o[cb][r] * inv;
    }
    __syncthreads();
    if (comp == 0) {
#pragma unroll
        for (int cb = 0; cb < 4; ++cb)
#pragma unroll
            for (int r = 0; r < 16; ++r) o[cb][r] = o[cb][r] * inv - lam * X2[((qs * 4 + cb) * 16 + r) * 64 + lane];
        subln_store(o, C.a->in[I_SUBG], C.AO + qrow * DM + h * 128, lane);
    }
    __syncthreads();
}

__device__ __forceinline__ void attnB_unit(const P2Ctx& C, int b, int h) {
    LAS unsigned char* lds = C.lds; const int tid = C.tid, lane = C.lane, wid = C.wid;
    const int comp = wid >> 2, q4 = wid & 3, r32 = lane & 31, hi = lane >> 5;
    const LAS float* lut = (const LAS float*)(lds + LUT_OFF) + h * 256;
    const float lam = *(const LAS float*)(lds + LAM_OFF);
    const size_t trow0 = (size_t)(TP + b * DSEQ);
    const float* ck = C.a->in[I_CK]; const float* cv = C.a->in[I_CV];
    { const int c = tid >> 8, row = (tid >> 3) & 31, ch = tid & 7;
      *(LAS u32x4*)(lds + c * 4096 + row * 128 + ((ch ^ ((row >> 1) & 7)) << 4)) = *(const u32x4*)(C.Q + (trow0 + row) * DM + h * 128 + c * 64 + ch * 8); }
    LAS unsigned char* VL = lds + 8192;
    f32x4 vst[4][2];
    const int vkey = (tid >> 4) & 31, vch = tid & 15;
#define B_ISSUEV(it) do { _Pragma("unroll") for (int i_ = 0; i_ < 4; ++i_) { const float* p_ = cv + (((size_t)(b * PAST + (i_ * 16 + (it)) * 32 + vkey)) * 8 + h) * 128 + vch * 8; \
        vst[i_][0] = *(const f32x4*)p_; vst[i_][1] = *(const f32x4*)(p_ + 4); } } while (0)
#define B_WRITEV(st) do { _Pragma("unroll") for (int i_ = 0; i_ < 4; ++i_) \
        *(LAS u32x4*)(VL + ((st) * 4 + i_) * 8192 + ((vkey >> 3) * 4 + (vch >> 2)) * 512 + (vkey & 7) * 64 + (vch & 3) * 16) = pack8(vst[i_][0], vst[i_][1]); } while (0)
    f32x4 kst[4][2];
#define B_ISSUEK(it) do { const float* p_ = ck + ((((size_t)(b * PAST + (q4 * 16 + (it)) * 32 + r32)) * 8 + h) * 2 + comp) * 64 + hi * 8; \
        _Pragma("unroll") for (int ds_ = 0; ds_ < 4; ++ds_) { kst[ds_][0] = *(const f32x4*)(p_ + ds_ * 16); kst[ds_][1] = *(const f32x4*)(p_ + ds_ * 16 + 4); } } while (0)
    f32x16 o[4];
#pragma unroll
    for (int cb = 0; cb < 4; ++cb)
#pragma unroll
        for (int r = 0; r < 16; ++r) o[cb][r] = 0.f;
    float m = -1e30f, l = 0.f;
    B_ISSUEV(0); B_ISSUEK(0); B_WRITEV(0); __syncthreads();
    for (int it = 0; it <= 16; ++it) {
        const bool active = (it < 16) || (q4 == 0);
        bf16x8 kf[4];
        if (it < 16) {
#pragma unroll
            for (int ds = 0; ds < 4; ++ds) kf[ds] = __builtin_bit_cast(bf16x8, pack8(kst[ds][0], kst[ds][1]));
        } else {
#pragma unroll
            for (int ds = 0; ds < 4; ++ds) kf[ds] = *(const bf16x8*)(C.Kb + (trow0 + r32) * DM + h * 128 + comp * 64 + ds * 16 + hi * 8);
        }
        u32x4 vnew = (u32x4){0u, 0u, 0u, 0u};
        if (it + 1 < 16) { B_ISSUEV(it + 1); B_ISSUEK(it + 1); }
        else if (it + 1 == 16) { if (tid < 512) vnew = *(const u32x4*)(C.Vb + (trow0 + vkey) * DM + h * 128 + vch * 8); }
        if (active) {
            const int kpos0 = it < 16 ? (q4 * 16 + it) * 32 : PAST;
            const LAS unsigned char* vimg = VL + ((it & 1) * 4 + (it < 16 ? q4 : 0)) * 8192;
            const int qpos = PAST + r32;
            const bool far = (kpos0 + 31 - PAST + 192 <= 0);
            f32x16 s[1];
            { const float c0 = far ? lut[0] : 0.f;
#pragma unroll
              for (int r = 0; r < 16; ++r) s[0][r] = c0; }
#pragma unroll
            for (int ds = 0; ds < 4; ++ds) { const int ch = 2 * ds + hi;
                const bf16x8 qf = *(const LAS bf16x8*)(lds + comp * 4096 + r32 * 128 + ((ch ^ ((r32 >> 1) & 7)) << 4));
                s[0] = MFMA32(kf[ds], qf, s[0]); }
            if (!far) {
#pragma unroll
                for (int r = 0; r < 16; ++r) { const int rel = kpos0 + crow(r, hi) - qpos; const int idx = rel + 192 > 0 ? rel + 192 : 0; s[0][r] += lut[idx]; }
            }
            const float alpha = softmax_step<1>(s, m, l);
#pragma unroll
            for (int cb = 0; cb < 4; ++cb)
#pragma unroll
                for (int r = 0; r < 16; ++r) o[cb][r] *= alpha;
            const bf16x8 p0 = pack_p(s[0], 0), p1 = pack_p(s[0], 1);
#pragma unroll
            for (int cb = 0; cb < 4; ++cb) { o[cb] = MFMA32(v_frag(vimg, 4, 0, cb, lane), p0, o[cb]); o[cb] = MFMA32(v_frag(vimg, 4, 1, cb, lane), p1, o[cb]); }
        }
        if (it + 1 < 16) { B_WRITEV((it + 1) & 1); }
        else if (it + 1 == 16) { *(LAS u32x4*)(VL + (0 * 4 + 0) * 8192 + ((vkey >> 3) * 4 + (vch >> 2)) * 512 + (vkey & 7) * 64 + (vch & 3) * 16) = vnew; }
        __syncthreads();
    }
#undef B_ISSUEV
#undef B_WRITEV
#undef B_ISSUEK
    l += __shfl_xor(l, 32);
    LAS float* MX = (LAS float*)(lds + 73728);
    if (hi == 0) MX[wid * 32 + r32] = m;
    __syncthreads();
    float M = MX[(comp * 4 + 0) * 32 + r32];
#pragma unroll
    for (int j = 1; j < 4; ++j) M = fmaxf(M, MX[(comp * 4 + j) * 32 + r32]);
    const float f = fexp2(m - M);
    l *= f;
#pragma unroll
    for (int cb = 0; cb < 4; ++cb)
#pragma unroll
        for (int r = 0; r < 16; ++r) o[cb][r] *= f;
    if (hi == 0) MX[256 + wid * 32 + r32] = l;
    __syncthreads();
    float L = 0.f;
#pragma unroll
    for (int j = 0; j < 4; ++j) L += MX[256 + (comp * 4 + j) * 32 + r32];
    const float inv = 1.0f / L;
    LAS float* R = (LAS float*)(lds + 8192);
#define B_PUT(slot) do { _Pragma("unroll") for (int cb = 0; cb < 4; ++cb) _Pragma("unroll") for (int r = 0; r < 16; ++r) R[(slot) * 4096 + (cb * 16 + r) * 64 + lane] = o[cb][r]; } while (0)
#define B_ADD(slot) do { _Pragma("unroll") for (int cb = 0; cb < 4; ++cb) _Pragma("unroll") for (int r = 0; r < 16; ++r) o[cb][r] += R[(slot) * 4096 + (cb * 16 + r) * 64 + lane]; } while (0)
    if (q4 >= 2) B_PUT(comp * 2 + (q4 - 2));
    __syncthreads();
    if (q4 < 2) B_ADD(comp * 2 + q4);
    __syncthreads();
    if (q4 == 1) B_PUT(comp);
    __syncthreads();
    if (q4 == 0) { B_ADD(comp);
#pragma unroll
        for (int cb = 0; cb < 4; ++cb)
#pragma unroll
            for (int r = 0; r < 16; ++r) o[cb][r] *= inv; }
    __syncthreads();
    if (q4 == 0 && comp == 1) B_PUT(0);
    __syncthreads();
    if (wid == 0) {
#pragma unroll
        for (int cb = 0; cb < 4; ++cb)
#pragma unroll
            for (int r = 0; r < 16; ++r) o[cb][r] -= lam * R[(cb * 16 + r) * 64 + lane];
        subln_store(o, C.a->in[I_SUBG], C.AO + (trow0 + r32) * DM + h * 128, lane);
    }
    __syncthreads();
#undef B_PUT
#undef B_ADD
}

template <bool SAMPLE>
__device__ __forceinline__ void attnC_unit(const P2Ctx& C, int b, int h, int qblk) {
    LAS unsigned char* lds = C.lds; const int tid = C.tid, lane = C.lane, wid = C.wid;
    const int dvh = wid >> 2, qs = wid & 3, r32 = lane & 31, hi = lane >> 5;
    const size_t trow0 = SAMPLE ? (size_t)(TP + b * DSEQ) : (size_t)(b * SEQ + qblk * 128);
    const int nq = SAMPLE ? DSEQ : 128;
    LAS unsigned char* QL = lds + 65536;
#pragma unroll
    for (int i = 0; i < 8; ++i) { const int idx = tid + 512 * i, row = idx >> 5, ch = idx & 31;
        u32x4 v = (u32x4){0u, 0u, 0u, 0u};
        if (row < nq) v = *(const u32x4*)(C.QC + (trow0 + row) * DM + h * 256 + ch * 8);
        *(LAS u32x4*)(QL + row * 512 + (((ch & 16) | ((ch ^ row) & 15)) << 4)) = v; }
    u32x4 kreg[2], vreg[2];
#define C_ISSUE(kt) do { _Pragma("unroll") for (int i_ = 0; i_ < 2; ++i_) { const int idx_ = tid + 512 * i_, key_ = idx_ >> 5, ch_ = idx_ & 31; const int mrow_ = (kt) * 32 + key_; \
        if (SAMPLE) { const float* pk_ = C.a->in[I_CMK] + (((size_t)(b * 256 + mrow_)) * 4 + h) * 256 + ch_ * 8; const float* pv_ = C.a->in[I_CMV] + (((size_t)(b * 256 + mrow_)) * 4 + h) * 256 + ch_ * 8; \
            kreg[i_] = pack8(*(const f32x4*)pk_, *(const f32x4*)(pk_ + 4)); vreg[i_] = pack8(*(const f32x4*)pv_, *(const f32x4*)(pv_ + 4)); } \
        else { kreg[i_] = *(const u32x4*)(C.MK + ((size_t)(b * 256 + mrow_)) * DM + h * 256 + ch_ * 8); vreg[i_] = *(const u32x4*)(C.MV + ((size_t)(b * 256 + mrow_)) * DM + h * 256 + ch_ * 8); } } } while (0)
#define C_WRITE(st) do { LAS unsigned char* sb_ = lds + (st) * 32768; _Pragma("unroll") for (int i_ = 0; i_ < 2; ++i_) { const int idx_ = tid + 512 * i_, key_ = idx_ >> 5, ch_ = idx_ & 31; \
        *(LAS u32x4*)(sb_ + key_ * 512 + (((ch_ & 16) | ((ch_ ^ key_) & 15)) << 4)) = kreg[i_]; \
        *(LAS u32x4*)(sb_ + 16384 + ((key_ >> 3) * 8 + (ch_ >> 2)) * 512 + (key_ & 7) * 64 + (ch_ & 3) * 16) = vreg[i_]; } } while (0)
    f32x16 o[4];
#pragma unroll
    for (int cb = 0; cb < 4; ++cb)
#pragma unroll
        for (int r = 0; r < 16; ++r) o[cb][r] = 0.f;
    float m = -1e30f, l = 0.f;
    const bool active = SAMPLE ? (qs == 0) : true;
    C_ISSUE(0); C_WRITE(0); __syncthreads();
    for (int kt = 0; kt < 8; ++kt) {
        if (kt + 1 < 8) C_ISSUE(kt + 1);
        if (active) {
            const LAS unsigned char* sb = lds + (kt & 1) * 32768;
            f32x16 s[1];
#pragma unroll
            for (int r = 0; r < 16; ++r) s[0][r] = 0.f;
            const int qrow = qs * 32 + r32;
#pragma unroll
            for (int ds = 0; ds < 16; ++ds) { const int ch = 2 * ds + hi;
                const bf16x8 kf = *(const LAS bf16x8*)(sb + r32 * 512 + (((ch & 16) | ((ch ^ r32) & 15)) << 4));
                const bf16x8 qf = *(const LAS bf16x8*)(QL + qrow * 512 + (((ch & 16) | ((ch ^ qrow) & 15)) << 4));
                s[0] = MFMA32(kf, qf, s[0]); }
            const float alpha = softmax_step<1>(s, m, l);
#pragma unroll
            for (int cb = 0; cb < 4; ++cb)
#pragma unroll
                for (int r = 0; r < 16; ++r) o[cb][r] *= alpha;
            const bf16x8 p0 = pack_p(s[0], 0), p1 = pack_p(s[0], 1);
#pragma unroll
            for (int cb = 0; cb < 4; ++cb) { o[cb] = MFMA32(v_frag(sb + 16384, 8, 0, dvh * 4 + cb, lane), p0, o[cb]); o[cb] = MFMA32(v_frag(sb + 16384, 8, 1, dvh * 4 + cb, lane), p1, o[cb]); }
        }
        if (kt + 1 < 8) C_WRITE((kt + 1) & 1);
        __syncthreads();
    }
#undef C_ISSUE
#undef C_WRITE
    if (active) {
        l += __shfl_xor(l, 32);
        const float inv = 1.0f / l;
        bf16_t* dst = C.CO + (trow0 + qs * 32 + r32) * DM + h * 256 + dvh * 128;
#pragma unroll
        for (int cb = 0; cb < 4; ++cb)
#pragma unroll
            for (int g = 0; g < 4; ++g) { const int dv0 = 32 * cb + 8 * g + 4 * hi;
                u32x2 w; w.x = pk_bf16(o[cb][4 * g + 0] * inv, o[cb][4 * g + 1] * inv); w.y = pk_bf16(o[cb][4 * g + 2] * inv, o[cb][4 * g + 3] * inv);
                *(u32x2*)(dst + dv0) = w; }
    }
    __syncthreads();
}

__device__ __forceinline__ void lru_unit(const P2Ctx& C, int sg, int n) {
    LAS unsigned char* lds = C.lds; const int tid = C.tid, lane = C.lane, wid = C.wid;
    const Args& a = *C.a;
    const bool smp = sg >= 8; const int b = smp ? sg - 8 : sg; const int S = smp ? DSEQ : SEQ; const size_t t0 = smp ? (size_t)(TP + b * DSEQ) : (size_t)(b * SEQ);
    LAS unsigned char* XC = lds;
    LAS float* AA = (LAS float*)(lds + 16384);
    LAS float* UU = (LAS float*)(lds + 49152);
    LAS float* SEG = (LAS float*)(lds + 81920);
    LAS float* CAR = (LAS float*)(lds + 86016);
    const int r32 = lane & 31, hi = lane >> 5, chb = wid & 3, tkb = wid >> 2;
    const int chl = chb * 32 + r32, chg = n * 128 + chl;
    const float ba = a.in[I_BRGA][chg], bx = a.in[I_BRGX][chg];
    const float sp8 = 8.0f * log1pf(expf(-a.in[I_RGL][chg]));
    const int cg = tid & 15;
    if (tid < 128) CAR[tid] = smp ? a.in[I_SLRU][b * 1024 + n * 128 + tid] : 0.f;
    const int nchunks = (S + 63) / 64;
    for (int ck = 0; ck < nchunks; ++ck) {
#pragma unroll
        for (int i = 0; i < 2; ++i) { const int tok = (tid >> 4) + 32 * i, tt = ck * 64 + tok;
            float xc[8];
            { const float* cbp = a.in[I_CONVB] + n * 128 + cg * 8; const f32x4 c0 = *(const f32x4*)cbp, c1 = *(const f32x4*)(cbp + 4);
              xc[0] = c0[0]; xc[1] = c0[1]; xc[2] = c0[2]; xc[3] = c0[3]; xc[4] = c1[0]; xc[5] = c1[1]; xc[6] = c1[2]; xc[7] = c1[3]; }
#pragma unroll
            for (int j = 0; j < 4; ++j) { const int ts = tt - 3 + j; float x[8]; float cw[8];
                { const float* cwp = a.in[I_CONVW] + j * 1024 + n * 128 + cg * 8; const f32x4 c0 = *(const f32x4*)cwp, c1 = *(const f32x4*)(cwp + 4);
                  cw[0] = c0[0]; cw[1] = c0[1]; cw[2] = c0[2]; cw[3] = c0[3]; cw[4] = c1[0]; cw[5] = c1[1]; cw[6] = c1[2]; cw[7] = c1[3]; }
                if (ts >= 0 && ts < S) { const u32x4 w = *(const u32x4*)(C.XB + (t0 + ts) * DM + n * 128 + cg * 8); unpack8(w, x); }
                else if (ts < 0 && smp) { const float* p = a.in[I_SCONV] + (size_t)(b * 3 + ts + 3) * DM + n * 128 + cg * 8; const f32x4 p0 = *(const f32x4*)p, p1 = *(const f32x4*)(p + 4);
                    x[0] = p0[0]; x[1] = p0[1]; x[2] = p0[2]; x[3] = p0[3]; x[4] = p1[0]; x[5] = p1[1]; x[6] = p1[2]; x[7] = p1[3]; }
                else {
#pragma unroll
                    for (int e = 0; e < 8; ++e) x[e] = 0.f; }
#pragma unroll
                for (int e = 0; e < 8; ++e) xc[e] += cw[e] * x[e]; }
            u32x4 w; w.x = pk_bf16(xc[0], xc[1]); w.y = pk_bf16(xc[2], xc[3]); w.z = pk_bf16(xc[4], xc[5]); w.w = pk_bf16(xc[6], xc[7]);
            *(LAS u32x4*)(XC + tok * 256 + ((cg ^ (tok & 15)) << 4)) = w; }
        __syncthreads();
        f32x16 da, dx;
#pragma unroll
        for (int r = 0; r < 16; ++r) { da[r] = 0.f; dx[r] = 0.f; }
        { const int tokA = tkb * 32 + r32;
          const bf16_t* wpa = C.WRG + ((size_t)n * 128 + chl) * 128 + hi * 8; const bf16_t* wpx = wpa + (size_t)8 * 128 * 128;
#pragma unroll
          for (int ks = 0; ks < 8; ++ks) { const bf16x8 xf = *(const LAS bf16x8*)(XC + tokA * 256 + (((2 * ks + hi) ^ (tokA & 15)) << 4));
              const bf16x8 wa = *(const bf16x8*)(wpa + ks * 16), wx = *(const bf16x8*)(wpx + ks * 16);
              da = MFMA32(xf, wa, da); dx = MFMA32(xf, wx, dx); } }
#pragma unroll
        for (int r = 0; r < 16; ++r) { const int tokl = tkb * 32 + crow(r, hi);
            const float xcv = bf2f(*(const LAS bf16_t*)(XC + tokl * 256 + ((((chl >> 3)) ^ (tokl & 15)) << 4) + (chl & 7) * 2));
            const float rg = sigmoidf_(da[r] + ba), ig = sigmoidf_(dx[r] + bx);
            const float log_a = -sp8 * rg;
            const float x2 = 2.0f * log_a;
            const float om = x2 > -0.25f ? -x2 * (1.0f + x2 * (0.5f + x2 * (0.16666667f + x2 * (0.041666668f + x2 * 0.0083333333f)))) : 1.0f - fexp2(x2 * LOG2E);
            float av = fexp2(log_a * LOG2E), uv = sqrtf(om) * (ig * xcv);
            if (ck * 64 + tokl >= S) { av = 1.0f; uv = 0.f; }
            AA[tokl * 128 + chl] = av; UU[tokl * 128 + chl] = uv; }
        __syncthreads();
        { const int c = tid & 127, seg = tid >> 7;
          float A = 1.f, B = 0.f;
#pragma unroll
          for (int t = 0; t < 16; ++t) { const int tok = seg * 16 + t; const float av = AA[tok * 128 + c], uv = UU[tok * 128 + c]; B = av * B + uv; A *= av; }
          SEG[(seg * 128 + c) * 2] = A; SEG[(seg * 128 + c) * 2 + 1] = B;
          __syncthreads();
          float hin = CAR[c];
          for (int s = 0; s < seg; ++s) hin = SEG[(s * 128 + c) * 2] * hin + SEG[(s * 128 + c) * 2 + 1];
          float hv = hin;
#pragma unroll
          for (int t = 0; t < 16; ++t) { const int tok = seg * 16 + t, tt = ck * 64 + tok; const float av = AA[tok * 128 + c], uv = UU[tok * 128 + c]; hv = av * hv + uv;
              if (tt < S) { const size_t off = (t0 + tt) * DM + n * 128 + c; const float gg = bf2f(C.GG[off]);
                  C.BO[off] = (bf16_t)(pk_bf16(hv * gg, 0.f) & 0xffffu); } }
          __syncthreads();
          if (seg == 3) CAR[c] = hv; }
    }
    __syncthreads();
    if (tid < 128) a.out[(smp ? O_HS : O_HP) + (size_t)b * 1024 + n * 128 + tid] = CAR[tid];
    __syncthreads();
}


__device__ __forceinline__ void lru_unit_p(const P2Ctx& C, int b, int n, int chq) {
    LAS unsigned char* lds = C.lds; const int tid = C.tid, lane = C.lane, wid = C.wid;
    const Args& a = *C.a;
    const size_t t0 = (size_t)(b * SEQ);
    LAS unsigned char* XC = lds;
    LAS float* AA = (LAS float*)(lds + 65536);
    LAS float* UU = (LAS float*)(lds + 98304);
    LAS float* SEG = (LAS float*)(lds + EXTRA_OFF + 9216);
    LAS float* CAR = (LAS float*)(lds + EXTRA_OFF + 13312);
    const int r32 = lane & 31, hi = lane >> 5;
    const int chl = chq * 32 + r32, chg = n * 128 + chl;
    const bf16_t* wpa = C.WRG + ((size_t)n * 128 + chl) * 128 + hi * 8; const bf16_t* wpx = wpa + (size_t)8 * 128 * 128;
    const float ba = a.in[I_BRGA][chg], bx = a.in[I_BRGX][chg];
    const float sp8 = 8.0f * log1pf(expf(-a.in[I_RGL][chg]));
    const int cg = tid & 15, run = tid >> 4;
    if (tid < 32) CAR[tid] = 0.f;
    for (int ck = 0; ck < 8; ++ck) {
        { float cw[4][8], cb8[8];
          { const float* cbp = a.in[I_CONVB] + n * 128 + cg * 8; const f32x4 c0 = *(const f32x4*)cbp, c1 = *(const f32x4*)(cbp + 4);
            cb8[0] = c0[0]; cb8[1] = c0[1]; cb8[2] = c0[2]; cb8[3] = c0[3]; cb8[4] = c1[0]; cb8[5] = c1[1]; cb8[6] = c1[2]; cb8[7] = c1[3]; }
#pragma unroll
          for (int j = 0; j < 4; ++j) { const float* cwp = a.in[I_CONVW] + j * 1024 + n * 128 + cg * 8; const f32x4 c0 = *(const f32x4*)cwp, c1 = *(const f32x4*)(cwp + 4);
              cw[j][0] = c0[0]; cw[j][1] = c0[1]; cw[j][2] = c0[2]; cw[j][3] = c0[3]; cw[j][4] = c1[0]; cw[j][5] = c1[1]; cw[j][6] = c1[2]; cw[j][7] = c1[3]; }
#pragma unroll 1
          for (int sr = 0; sr < 2; ++sr) { const int tk0 = run * 8 + sr * 4, tt0 = ck * 256 + tk0;
              u32x4 rows[7];
#pragma unroll
              for (int i = 0; i < 7; ++i) { const int ts = tt0 - 3 + i; rows[i] = ts >= 0 ? *(const u32x4*)(C.XB + (t0 + ts) * DM + n * 128 + cg * 8) : (u32x4){0u, 0u, 0u, 0u}; }
              float xc[4][8];
#pragma unroll
              for (int t = 0; t < 4; ++t)
#pragma unroll
                  for (int e = 0; e < 8; ++e) xc[t][e] = cb8[e];
#pragma unroll
              for (int i = 0; i < 7; ++i) { float x[8]; unpack8(rows[i], x);
#pragma unroll
                  for (int j = 0; j < 4; ++j) { const int t = i - j;
                      if (t >= 0 && t < 4) {
#pragma unroll
                          for (int e = 0; e < 8; ++e) xc[t][e] += cw[j][e] * x[e]; } } }
#pragma unroll
              for (int t = 0; t < 4; ++t) { const int tok = tk0 + t; u32x4 w; w.x = pk_bf16(xc[t][0], xc[t][1]); w.y = pk_bf16(xc[t][2], xc[t][3]); w.z = pk_bf16(xc[t][4], xc[t][5]); w.w = pk_bf16(xc[t][6], xc[t][7]);
                  *(LAS u32x4*)(XC + tok * 256 + ((cg ^ (tok & 15)) << 4)) = w; } } }
        __syncthreads();
        f32x16 da, dx;
#pragma unroll
        for (int r = 0; r < 16; ++r) { da[r] = 0.f; dx[r] = 0.f; }
        { const int tokA = wid * 32 + r32;
#pragma unroll
          for (int ks = 0; ks < 8; ++ks) { const bf16x8 xf = *(const LAS bf16x8*)(XC + tokA * 256 + (((2 * ks + hi) ^ (tokA & 15)) << 4));
              const bf16x8 wa = *(const bf16x8*)(wpa + ks * 16), wx = *(const bf16x8*)(wpx + ks * 16);
              da = MFMA32(xf, wa, da); dx = MFMA32(xf, wx, dx); } }
#pragma unroll
        for (int r = 0; r < 16; ++r) { const int tokl = wid * 32 + crow(r, hi);
            const float xcv = bf2f(*(const LAS bf16_t*)(XC + tokl * 256 + (((chl >> 3) ^ (tokl & 15)) << 4) + (chl & 7) * 2));
            const float rg = sigmoidf_(da[r] + ba), ig = sigmoidf_(dx[r] + bx);
            const float log_a = -sp8 * rg;
            const float x2 = 2.0f * log_a;
            const float om = x2 > -0.25f ? -x2 * (1.0f + x2 * (0.5f + x2 * (0.16666667f + x2 * (0.041666668f + x2 * 0.0083333333f)))) : 1.0f - fexp2(x2 * LOG2E);
            AA[tokl * 32 + r32] = fexp2(log_a * LOG2E); UU[tokl * 32 + r32] = sqrtf(om) * (ig * xcv); }
        __syncthreads();
        { const int c = tid & 31, seg = tid >> 5;
          float A = 1.f, B = 0.f;
#pragma unroll
          for (int t = 0; t < 16; ++t) { const int tok = seg * 16 + t; const float av = AA[tok * 32 + c], uv = UU[tok * 32 + c]; B = av * B + uv; A *= av; }
          SEG[(seg * 32 + c) * 2] = A; SEG[(seg * 32 + c) * 2 + 1] = B;
          __syncthreads();
          float hin = CAR[c];
          for (int s = 0; s < seg; ++s) hin = SEG[(s * 32 + c) * 2] * hin + SEG[(s * 32 + c) * 2 + 1];
          float hv = hin;
          const size_t off0 = (t0 + ck * 256 + seg * 16) * DM + n * 128 + chq * 32 + c;
          bf16_t gg[16];
#pragma unroll
          for (int t = 0; t < 16; ++t) gg[t] = C.GG[off0 + (size_t)t * DM];
#pragma unroll
          for (int t = 0; t < 16; ++t) { const int tok = seg * 16 + t; const float av = AA[tok * 32 + c], uv = UU[tok * 32 + c]; hv = av * hv + uv;
              C.BO[off0 + (size_t)t * DM] = (bf16_t)(pk_bf16(hv * bf2f(gg[t]), 0.f) & 0xffffu); }
          __syncthreads();
          if (seg == 15) CAR[c] = hv; }
    }
    __syncthreads();
    if (tid < 32) a.out[O_HP + (size_t)b * 1024 + n * 128 + chq * 32 + tid] = CAR[tid];
    __syncthreads();
}

constexpr int P2_N_LRU_P = 256, P2_N_B = 128, P2_N_A = 1024, P2_N_CP = 512, P2_N_CS = 64, P2_N_LRU_S = 128;
constexpr int P2_NITEMS = P2_N_LRU_P + P2_N_B + P2_N_A + P2_N_CP + P2_N_CS + P2_N_LRU_S;
__device__ __forceinline__ void p2_mixers(const Args& a, LAS unsigned char* lds, int tid, int lane, int wid, int rep) {
    unsigned char* ws0 = a.ws;
    { LAS float* lut = (LAS float*)(lds + LUT_OFF);
      for (int e = tid; e < 8 * 256; e += 512) { const int h = e >> 8, rel = (e & 255) - 192; const int nn = rel < 0 ? -rel : rel;
          int bk = nn < 8 ? nn : (nn >= 91 ? 15 : nn >= 64 ? 14 : nn >= 46 ? 13 : nn >= 32 ? 12 : nn >= 23 ? 11 : nn >= 16 ? 10 : nn >= 12 ? 9 : 8);
          if (rel > 0) bk += 16;
          lut[e] = a.in[I_REL][bk * 8 + h] * LOG2E; }
      if (tid < 64) { float d1 = a.in[I_LQ1][tid] * a.in[I_LK1][tid], d2 = a.in[I_LQ2][tid] * a.in[I_LK2][tid]; d1 = wave_sum(d1); d2 = wave_sum(d2);
          if (tid == 0) *(LAS float*)(lds + LAM_OFF) = expf(d1) - expf(d2) + LAMBDA_INIT; } }
    __syncthreads();
    unsigned* queue = (unsigned*)(ws0 + WS_CTL) + CW_QUEUE + 64 * rep;
    volatile LAS unsigned* slot = (volatile LAS unsigned*)(lds + MISC_OFF + 64);
    for (;;) {
        if (tid == 0) *slot = __hip_atomic_fetch_add(queue, 1u, __ATOMIC_RELAXED, __HIP_MEMORY_SCOPE_AGENT);
        __syncthreads();
        int it = (int)*slot;
        __syncthreads();
        if (it >= P2_NITEMS) break;
        int tid_ = tid; asm volatile("" : "+v"(tid_));
        unsigned char* ws = ws0; asm volatile("" : "+s"(ws));
        P2Ctx C; C.a = &a; C.lds = lds; C.tid = tid_; C.lane = tid_ & 63; C.wid = __builtin_amdgcn_readfirstlane(tid_ >> 6);
        C.Q = (const bf16_t*)(ws + WS_Q); C.Kb = (const bf16_t*)(ws + WS_K); C.Vb = (const bf16_t*)(ws + WS_V); C.XB = (const bf16_t*)(ws + WS_XB); C.GG = (const bf16_t*)(ws + WS_GG);
        C.QC = (const bf16_t*)(ws + WS_QC); C.MK = (const bf16_t*)(ws + WS_MK); C.MV = (const bf16_t*)(ws + WS_MV); C.WRG = (const bf16_t*)(ws + WS_WRG);
        C.AO = (bf16_t*)(ws + WS_AO); C.BO = (bf16_t*)(ws + WS_BO); C.CO = (bf16_t*)(ws + WS_CO);
#ifndef UNIT_MASK
#define UNIT_MASK 0xFF
#endif
        if (it < P2_N_LRU_P) { if (UNIT_MASK & 1) lru_unit_p(C, it >> 5, (it >> 2) & 7, it & 3); continue; } it -= P2_N_LRU_P;
        if (it < P2_N_B) { if (UNIT_MASK & 2) attnB_unit(C, it >> 3, it & 7); continue; } it -= P2_N_B;
        if (it < P2_N_A) { const int qb = 15 - (it >> 6), bh = it & 63; if (UNIT_MASK & 4) attnA_unit(C, bh >> 3, bh & 7, qb); continue; } it -= P2_N_A;
        if (it < P2_N_CP) { const int qblk = it & 15, bh = it >> 4; if (UNIT_MASK & 8) attnC_unit<false>(C, bh >> 2, bh & 3, qblk); continue; } it -= P2_N_CP;
        if (it < P2_N_CS) { if (UNIT_MASK & 16) attnC_unit<true>(C, it >> 2, it & 3, 0); continue; } it -= P2_N_CS;
        if (UNIT_MASK & 1) lru_unit(C, 8 + (it >> 3), it & 7);
    }
}

__device__ __forceinline__ void p7_final(const Args& a, int gw, int NGW, int lane) {
    const float* X2 = (const float*)(a.ws + WS_X1);
    const f32x4* gr = (const f32x4*)a.in[I_NFIN] + lane;
    for (int mrow = gw; mrow < TT; mrow += NGW) {
        const f32x4* xr = (const f32x4*)(X2 + (size_t)mrow * DM) + lane;
        f32x4 v[4]; float s = 0.f;
#pragma unroll
        for (int j = 0; j < 4; ++j) { v[j] = xr[64 * j]; s += (v[j].x * v[j].x + v[j].y * v[j].y) + (v[j].z * v[j].z + v[j].w * v[j].w); }
        const float rstd = 1.0f / sqrtf(wave_sum(s) * (1.0f / 1024.0f) + EPS);
        f32x4* o = (f32x4*)(a.out + (mrow < TP ? O_YP + (size_t)mrow * DM : O_YS + (size_t)(mrow - TP) * DM)) + lane;
#pragma unroll
        for (int j = 0; j < 4; ++j) { const f32x4 g = gr[64 * j]; o[64 * j] = v[j] * rstd * g; }
    }
}

constexpr int N_PHASES = 8;
__global__ void __launch_bounds__(NWAVES * 64, 2) fwd_kernel(Args args) {
    __shared__ __attribute__((aligned(16))) unsigned char lds_raw[LDS_BYTES];
    LAS unsigned char* lds = (LAS unsigned char*)lds_raw;
    const int tid = threadIdx.x, lane = tid & 63, wave = __builtin_amdgcn_readfirstlane(tid >> 6);
    const int G = gridDim.x, bx = blockIdx.x;
    const int vcu = (G % 8 == 0) ? (bx % 8) * (G / 8) + bx / 8 : bx;
    const int gw = vcu * NWAVES + wave, NGW = G * NWAVES;
    unsigned char* ws = args.ws;
    unsigned* ctl = (unsigned*)(ws + WS_CTL);
    for (int u = tid; u < (LDS_BYTES - EXTRA_OFF) / 4; u += NWAVES * 64) ((LAS unsigned*)(lds + EXTRA_OFF))[u] = 0u;
    __syncthreads();
    XcdBarrier bar; bar.bar = ctl + CW_BAR; bar.x = 0; bar.st = nullptr;
    if (MK_N_LAUNCHES == 1) bar = xcd_barrier_post(ctl + CW_BAR, (volatile LAS unsigned*)(lds + MISC_OFF + 32));
    const int lo = args.ph_lo, hi = args.ph_hi;
#ifndef PH_MASK
#define PH_MASK 0xFF
#endif
#define IN(k) (((PH_MASK >> (k)) & 1) && lo <= (k) && (k) < hi)
#define SEAM(k) do { if (IN(k) && IN((k) + 1)) xcd_barrier(bar); } while (0)

#ifndef DUP_MASK
#define DUP_MASK 0
#endif
#define PHASE(k, ...) do { if (IN(k)) { { const int rep_ = 0; (void)rep_; __VA_ARGS__ } if ((DUP_MASK >> (k)) & 1) { xcd_barrier(bar); { const int rep_ = 1; (void)rep_; __VA_ARGS__ } } } SEAM(k); } while (0)

    PHASE(0, p0_prologue(args, lds, gw, NGW, wave, lane); );
    PHASE(1,
        Sched1 S{(const char*)(ws + WS_XN), (const char*)(ws + WS_WCAT), G, bx};
        Epi1 E{(bf16_t*)(ws + WS_Q), (bf16_t*)(ws + WS_K), (bf16_t*)(ws + WS_V), (bf16_t*)(ws + WS_XB), (bf16_t*)(ws + WS_GG), (bf16_t*)(ws + WS_QC), (bf16_t*)(ws + WS_G),
               (bf16_t*)(ws + WS_MK), (bf16_t*)(ws + WS_MV), args.out, args.in[I_BGATE]};
        pg8::gemm_phase(lds, 1024, S, E); );
    PHASE(2, p2_mixers(args, lds, tid, lane, wave, rep_); );
    PHASE(3,
        Sched2 S{(const char*)(ws + WS_AO), (const char*)(ws + WS_BO), (const char*)(ws + WS_CO), (const char*)(ws + WS_WP), G, bx};
        Epi2 E{(const bf16_t*)(ws + WS_G), (bf16_t*)(ws + WS_MG), (float*)(ws + WS_X1)};
        pg8::gemm_phase(lds, 1024, S, E);
        Fin3 F{(bf16_t*)(ws + WS_MG)};
        tail_gemm<3>(lds, (const bf16_t*)(ws + WS_AO), (const bf16_t*)(ws + WS_BO), (const bf16_t*)(ws + WS_CO), (const bf16_t*)(ws + WS_WP), 1024, (const bf16_t*)(ws + WS_G), F, G, bx); );
    PHASE(4,
        SchedT S{(const char*)(ws + WS_MG), (const char*)(ws + WS_WO), 64, 4, 1024, G, bx};
        Epi3 E{args.in[I_XP], args.in[I_XS], (float*)(ws + WS_X1), (bf16_t*)(ws + WS_X1B), (float*)(ws + WS_SS)};
        pg8::gemm_phase(lds, 1024, S, E);
        Fin4 F{args.in[I_XS], (float*)(ws + WS_X1), (bf16_t*)(ws + WS_X1B), (float*)(ws + WS_SS)};
        tail_gemm<1>(lds, (const bf16_t*)(ws + WS_MG), nullptr, nullptr, (const bf16_t*)(ws + WS_WO), 1024, nullptr, F, G, bx); );
    PHASE(5,
        SchedT S{(const char*)(ws + WS_X1B), (const char*)(ws + WS_WFI), 66, 22, 1024, G, bx};
        Epi4 E{(const float*)(ws + WS_SS), (bf16_t*)(ws + WS_ACT)};
        pg8::gemm_phase(lds, 1024, S, E); );
    PHASE(6,
        SchedT S{(const char*)(ws + WS_ACT), (const char*)(ws + WS_WFO), 64, 4, DFF, G, bx};
        Epi5 E{(float*)(ws + WS_X1)};
        pg8::gemm_phase(lds, DFF, S, E);
        Fin6 F{(float*)(ws + WS_X1)};
        tail_gemm<1>(lds, (const bf16_t*)(ws + WS_ACT), nullptr, nullptr, (const bf16_t*)(ws + WS_WFO), DFF, nullptr, F, G, bx); );
    PHASE(7, p7_final(args, gw, NGW, lane); );
#undef PHASE
#undef IN
#undef SEAM
}

extern "C" void kernel_launch(void* const* d_in, const int* in_sizes, int n_in, void* d_out, int out_size, void* d_ws, size_t ws_size, hipStream_t stream) {
    static int grid = 0;
    if (grid == 0) {
        if (n_in != 36 || out_size != (int)O_END || ws_size < WS_END) { fprintf(stderr, "kernel_launch: unexpected problem (n_in %d, out %d, ws %zu); nothing launched\n", n_in, out_size, ws_size); grid = -1; return; }
        int dev = 0, cus = 0;
        if (hipGetDevice(&dev) != hipSuccess || hipDeviceGetAttribute(&cus, hipDeviceAttributeMultiprocessorCount, dev) != hipSuccess) { grid = -1; return; }
        int per_cu = 0;
        if (hipOccupancyMaxActiveBlocksPerMultiprocessor(&per_cu, (const void*)fwd_kernel, NWAVES * 64, 0) != hipSuccess || per_cu < 1)
            fprintf(stderr, "kernel_launch: note: occupancy query reports %d workgroups per CU\n", per_cu);
        (void)hipGetLastError();
        grid = cus;
    }
    if (grid < 0) return;
    (void)hipMemsetAsync((char*)d_ws + WS_CTL, 0, CTL_ZERO_BYTES, stream);
    Args a{};
    for (int i = 0; i < 36; ++i) a.in[i] = (const float*)d_in[i];
    a.out = (float*)d_out; a.ws = (unsigned char*)d_ws;
    if (MK_N_LAUNCHES == 1) { a.ph_lo = 0; a.ph_hi = N_PHASES; a.li = 0; hipLaunchKernelGGL(fwd_kernel, dim3(grid), dim3(NWAVES * 64), 0, stream, a); }
    else for (int li = 0; li < N_PHASES; ++li) { a.ph_lo = li; a.ph_hi = li + 1; a.li = li; hipLaunchKernelGGL(fwd_kernel, dim3(grid), dim3(NWAVES * 64), 0, stream, a); }
}
```

```cpp
#include <hip/hip_runtime.h>
#include <cstdio>
#include <cstdint>

#ifndef MK_N_LAUNCHES
#define MK_N_LAUNCHES 1
#endif

#define LAS __attribute__((address_space(3)))
#define GAS __attribute__((address_space(1)))
typedef unsigned short bf16_t;
typedef short bf16x8 __attribute__((ext_vector_type(8)));
typedef short s16x4 __attribute__((ext_vector_type(4)));
typedef float f32x2 __attribute__((ext_vector_type(2)));
typedef float f32x4 __attribute__((ext_vector_type(4)));
typedef float f32x16 __attribute__((ext_vector_type(16)));
typedef unsigned u32x2 __attribute__((ext_vector_type(2)));
typedef unsigned u32x4 __attribute__((ext_vector_type(4)));
typedef __bf16 bf16x2_t __attribute__((ext_vector_type(2)));

constexpr int DM = 1024, TP = 16384, TS = 512, TT = TP + TS, TMEM = 2048, TALL = TT + TMEM;
constexpr int SEQ = 2048, NBATCH = 8, DSEQ = 32, DBATCH = 16, PAST = 2048;
constexpr int INW = 6144, GATEW = 3072, DFF = 2816;
constexpr float EPS = 1e-6f;
constexpr float LOG2E = 1.4426950408889634f;
constexpr float QSCALE = 0.125f * LOG2E;
constexpr float CSCALE = 0.0625f * LOG2E;
constexpr float LAMBDA_INIT = 0.2f;

constexpr size_t O_YP = 0, O_YS = 16777216, O_KP = 17301504, O_VP = 34078720, O_CP = 50855936, O_HP = 50880512,
                 O_MKP = 50888704, O_MVP = 52985856, O_KS = 55083008, O_VS = 55607296, O_CS = 56131584, O_HS = 56180736, O_END = 56197120;

constexpr size_t MiB = 1u << 20;
constexpr size_t WS_CTL = 0, CTL_ZERO_BYTES = 1 * MiB;
constexpr size_t WS_WCAT = 1 * MiB;
constexpr size_t WS_WP = 23 * MiB;
constexpr size_t WS_WO = 29 * MiB;
constexpr size_t WS_WFI = 31 * MiB;
constexpr size_t WS_WFO = 42 * MiB;
constexpr size_t WS_WRG = 47 * MiB + 512 * 1024;
constexpr size_t WS_XN = 48 * MiB;
constexpr size_t WS_MK = 85 * MiB, WS_MV = 89 * MiB;
constexpr size_t WS_Q = 93 * MiB, WS_K = 126 * MiB, WS_V = 159 * MiB, WS_XB = 192 * MiB, WS_GG = 225 * MiB, WS_QC = 258 * MiB;
constexpr size_t WS_G = 291 * MiB;
constexpr size_t WS_AO = 390 * MiB, WS_BO = 423 * MiB, WS_CO = 456 * MiB;
constexpr size_t WS_MG = 48 * MiB;
constexpr size_t WS_X1B = 291 * MiB;
constexpr size_t WS_X1 = 192 * MiB;
constexpr size_t WS_ACT = 93 * MiB;
constexpr size_t WS_SS = 489 * MiB;
constexpr size_t WS_END = 491 * MiB;
constexpr int CW_BAR = 4096, CW_QUEUE = 16384;

constexpr int RING_BYTES = 131072, EXTRA_OFF = RING_BYTES, MISC_OFF = EXTRA_OFF + 320, LAM_OFF = EXTRA_OFF + 512, LUT_OFF = EXTRA_OFF + 1024;
constexpr int LDS_BYTES = 147456;
constexpr int NWAVES = 8;

__device__ __forceinline__ unsigned pk_bf16(float lo, float hi) { f32x2 v = {lo, hi}; bf16x2_t b = __builtin_convertvector(v, bf16x2_t); return __builtin_bit_cast(unsigned, b); }
__device__ __forceinline__ float bf_lo(unsigned u) { return __uint_as_float(u << 16); }
__device__ __forceinline__ float bf_hi(unsigned u) { return __uint_as_float(u & 0xffff0000u); }
__device__ __forceinline__ float bf2f(bf16_t v) { return __uint_as_float(((unsigned)v) << 16); }
__device__ __forceinline__ float fexp2(float x) { return __builtin_amdgcn_exp2f(x); }
__device__ __forceinline__ float frcp(float x) { return __builtin_amdgcn_rcpf(x); }
__device__ __forceinline__ float sigmoidf_(float x) { return frcp(1.0f + fexp2(-x * LOG2E)); }
__device__ __forceinline__ float gelu_tanh(float x) { const float z = 1.5957691216057308f * (x + 0.044715f * x * x * x); return x * frcp(1.0f + fexp2(-z * LOG2E)); }
__device__ __forceinline__ int crow(int r, int hi) { return (r & 3) + 8 * (r >> 2) + 4 * hi; }
__device__ __forceinline__ u32x4 pack8(f32x4 a, f32x4 b) { u32x4 w; w.x = pk_bf16(a[0], a[1]); w.y = pk_bf16(a[2], a[3]); w.z = pk_bf16(b[0], b[1]); w.w = pk_bf16(b[2], b[3]); return w; }
__device__ __forceinline__ void unpack8(u32x4 w, float* f) { f[0] = bf_lo(w.x); f[1] = bf_hi(w.x); f[2] = bf_lo(w.y); f[3] = bf_hi(w.y); f[4] = bf_lo(w.z); f[5] = bf_hi(w.z); f[6] = bf_lo(w.w); f[7] = bf_hi(w.w); }
__device__ __forceinline__ float wave_sum(float v) {
#pragma unroll
    for (int o = 1; o < 64; o <<= 1) v += __shfl_xor(v, o);
    return v;
}
__device__ __forceinline__ s16x4 vtr(const LAS unsigned char* p) { return __builtin_bit_cast(s16x4, __builtin_amdgcn_ds_read_tr16_b64_v4i16((LAS s16x4*)p)); }
#define MFMA32(a, b, c) __builtin_amdgcn_mfma_f32_32x32x16_bf16((a), (b), (c), 0, 0, 0)

namespace pg8 {
constexpr int BM = 256, BK = 64, HALF = 128, HTB = HALF * BK * 2, STAGE_BYTES = 8 * HTB, NXCD = 8, WGM = 8;
__host__ __device__ __forceinline__ int lds_byte(int r, int c) { const int st = (r >> 4) * 2 + (c >> 5), rr = r & 15, cc = c & 31, ob = rr * 64 + cc * 2; return st * 1024 + (ob ^ (((ob >> 9) & 1) << 5)); }
__host__ __device__ __forceinline__ void stage_rc(int b, int& R, int& C) { const int st = b / 1024, sb = b % 1024, swz = sb ^ (((sb >> 9) & 1) << 5); R = (st >> 1) * 16 + swz / 64; C = (st & 1) * 32 + (swz % 64) / 2; }
__host__ __device__ __forceinline__ int perm32(int rho) { const int n = rho >> 4, i = rho & 15; return 8 * (i >> 2) + 4 * n + (i & 3); }

struct Unit { const char* A; const char* B; int pm, pn, kind; };

__device__ __forceinline__ void tile_order(int L, int nM, int nN, int& pm, int& pn) {
    const int nwg = nM * nN; int wgid = L;
    { const int q = nwg / NXCD, r = nwg % NXCD, xcd = wgid % NXCD, off = wgid / NXCD; wgid = (xcd < r ? xcd * (q + 1) : r * (q + 1) + (xcd - r) * q) + off; }
    const int nig = WGM * nN, gid = wgid / nig, fm = gid * WGM, gsz = (nM - fm) < WGM ? (nM - fm) : WGM;
    pm = fm + ((wgid % nig) % gsz); pn = (wgid % nig) / gsz;
}

template <class Epi, class Sched>
__device__ __forceinline__ void gemm_phase(LAS unsigned char* lds, const int K, const Sched& S, const Epi& E) {
    const int tid = threadIdx.x, wid = __builtin_amdgcn_readfirstlane(tid >> 6), lane = tid & 63, wr = wid >> 2, wc = wid & 3, fr = lane & 15, fq = lane >> 4;
    const int nt = K / BK;
    unsigned voffA[2], voffB[2];
#pragma unroll
    for (int i = 0; i < 2; ++i) { int R, C; stage_rc(tid * 16 + i * 8192, R, C); const int Rb = (R & ~31) + perm32(R & 31);
        voffA[i] = (unsigned)(R * K + C) * 2u; voffB[i] = (unsigned)(Rb * K + C) * 2u; }
    const size_t kstep = (size_t)(BK * 2);
    const size_t hstep = (size_t)HALF * K * 2;
    const unsigned ldsw = (unsigned)wid * 1024u;
    const int aoff = lds_byte(wr * 64 + fr, fq * 8), boff = lds_byte(wc * 32 + fr, fq * 8);
#define PG8_SA(b, h) (((b) * 2 + (h)) * HTB)
#define PG8_SB(b, h) ((4 + (b) * 2 + (h)) * HTB)
#define PG8_STAGE(bufoff, gbase, voff) do { _Pragma("unroll") for (int _i = 0; _i < 2; ++_i) \
        __builtin_amdgcn_global_load_lds((const unsigned*)((const char*)(gbase) + (voff)[_i]), (LAS unsigned*)(lds + (bufoff) + ldsw + _i * 8192), 16, 0, 0); } while (0)
#define PG8_LDA(dst, b, h) do { _Pragma("unroll") for (int m = 0; m < 4; ++m) _Pragma("unroll") for (int k = 0; k < 2; ++k) dst[m][k] = *(const LAS bf16x8*)(lds + PG8_SA(b, h) + aoff + m * 2048 + k * 1024); } while (0)
#define PG8_LDB(dst, b, h) do { _Pragma("unroll") for (int n = 0; n < 2; ++n) _Pragma("unroll") for (int k = 0; k < 2; ++k) dst[n][k] = *(const LAS bf16x8*)(lds + PG8_SB(b, h) + boff + n * 2048 + k * 1024); } while (0)
#define PG8_MMA(ai, bj, At, Bt) do { __builtin_amdgcn_s_setprio(1); _Pragma("unroll") for (int m = 0; m < 4; ++m) _Pragma("unroll") for (int n = 0; n < 2; ++n) _Pragma("unroll") for (int k = 0; k < 2; ++k) \
        acc[ai][bj][m][n] = __builtin_amdgcn_mfma_f32_16x16x32_bf16(Bt[n][k], At[m][k], acc[ai][bj][m][n], 0, 0, 0); __builtin_amdgcn_s_setprio(0); } while (0)
#define PG8_WAIT_V(n) asm volatile("s_waitcnt vmcnt(" #n ")" ::: "memory")
#define PG8_WAIT_L(n) asm volatile("s_waitcnt lgkmcnt(" #n ")" ::: "memory")
#define PG8_BAR __builtin_amdgcn_s_barrier()
#define PG8_SCHED __builtin_amdgcn_sched_barrier(0)
#define PG8_ZERO() do { _Pragma("unroll") for (int a = 0; a < 2; ++a) _Pragma("unroll") for (int b = 0; b < 2; ++b) _Pragma("unroll") for (int m = 0; m < 4; ++m) _Pragma("unroll") for (int n = 0; n < 2; ++n) acc[a][b][m][n] = (f32x4){0.f, 0.f, 0.f, 0.f}; } while (0)
    Unit cur, nxt; int ui = 0;
    if (!S.next(0, cur)) return;
    f32x4 acc[2][2][4][2];
    PG8_ZERO();
    bf16x8 At[4][2], B0[2][2], B1[2][2];
    const char* cA = cur.A; const char* cB = cur.B;
    PG8_STAGE(PG8_SB(0, 0), cB, voffB); PG8_STAGE(PG8_SB(0, 1), cB + hstep, voffB); PG8_STAGE(PG8_SA(0, 0), cA, voffA); PG8_STAGE(PG8_SA(0, 1), cA + hstep, voffA);
    if (wr == 1) PG8_BAR;
    PG8_WAIT_V(2); PG8_BAR;
    PG8_STAGE(PG8_SB(1, 0), cB + kstep, voffB); PG8_STAGE(PG8_SA(1, 0), cA + kstep, voffA); PG8_STAGE(PG8_SB(1, 1), cB + hstep + kstep, voffB);
    PG8_WAIT_V(6); PG8_BAR;
    for (;;) {
        const bool has_next = S.next(ui + 1, nxt);
        const char* nA = has_next ? nxt.A : cA; const char* nB = has_next ? nxt.B : cB;
        for (int t = 0; t < nt; t += 2) {
            const bool last = (t == nt - 2);
            const char* a1 = cA + (size_t)(t + 1) * kstep;
            const char* a2 = last ? nA : cA + (size_t)(t + 2) * kstep; const char* b2 = last ? nB : cB + (size_t)(t + 2) * kstep;
            const char* a3 = a2 + kstep; const char* b3 = b2 + kstep;
            PG8_LDB(B0, 0, 0); PG8_LDB(B1, 0, 1); PG8_SCHED; PG8_LDA(At, 0, 0); PG8_STAGE(PG8_SA(1, 1), a1 + hstep, voffA);
            PG8_WAIT_V(8); PG8_WAIT_L(0); PG8_BAR; PG8_MMA(0, 0, At, B0); PG8_MMA(0, 1, At, B1); PG8_BAR; PG8_SCHED;
            PG8_LDA(At, 0, 1); PG8_STAGE(PG8_SB(0, 0), b2, voffB); PG8_STAGE(PG8_SB(0, 1), b2 + hstep, voffB); PG8_STAGE(PG8_SA(0, 0), a2, voffA);
            PG8_WAIT_V(8); PG8_WAIT_L(0); PG8_BAR; PG8_MMA(1, 0, At, B0); PG8_MMA(1, 1, At, B1); PG8_BAR; PG8_SCHED;
            PG8_LDB(B0, 1, 0); PG8_LDB(B1, 1, 1); PG8_SCHED; PG8_LDA(At, 1, 0); PG8_STAGE(PG8_SA(0, 1), a2 + hstep, voffA);
            PG8_WAIT_V(8); PG8_WAIT_L(0); PG8_BAR; PG8_MMA(0, 0, At, B0); PG8_MMA(0, 1, At, B1); PG8_BAR; PG8_SCHED;
            PG8_LDA(At, 1, 1); PG8_STAGE(PG8_SB(1, 0), b3, voffB); PG8_STAGE(PG8_SB(1, 1), b3 + hstep, voffB); PG8_STAGE(PG8_SA(1, 0), a3, voffA);
            PG8_WAIT_V(8); PG8_WAIT_L(0); PG8_BAR; PG8_MMA(1, 0, At, B0); PG8_MMA(1, 1, At, B1); PG8_BAR; PG8_SCHED;
        }
        if (wr == 0) PG8_BAR;
        const bool zero = E(acc, cur, wr, wc, fr, fq);
        if (!has_next) break;
        if (Epi::ZERO_AFTER || zero) PG8_ZERO();
        cur = nxt; cA = nA; cB = nB; ++ui;
        if (wr == 1) PG8_BAR;
    }
    PG8_WAIT_V(0);
    PG8_BAR;
#undef PG8_SA
#undef PG8_SB
#undef PG8_STAGE
#undef PG8_LDA
#undef PG8_LDB
#undef PG8_MMA
#undef PG8_WAIT_V
#undef PG8_WAIT_L
#undef PG8_BAR
#undef PG8_SCHED
#undef PG8_ZERO
}
}

#define TILE_FOR(...) \
    _Pragma("unroll") for (int ai = 0; ai < 2; ++ai) _Pragma("unroll") for (int m = 0; m < 4; ++m) { const int row = rowb + ai * 128 + m * 16; \
    _Pragma("unroll") for (int bj = 0; bj < 2; ++bj) { const int col = colb + bj * 128; f32x4& v0 = acc[ai][bj][m][0]; f32x4& v1 = acc[ai][bj][m][1]; __VA_ARGS__ } }

#define XB_TMO      128
#define XB_XCNT(j)  (256  + 64 * (j))
#define XB_XSUB(j)  (1280 + 64 * (j))
#define XB_XGEN(j)  (2304 + 64 * (j))
#define XB_TOP      3328
#define XB_TOPGEN   3392
#define XCD_BAR_WORDS 3456
#define XB_SPIN_CAP (1u << 18)
__device__ __forceinline__ unsigned xb_ld(unsigned* p)              { return __hip_atomic_load(p, __ATOMIC_RELAXED, __HIP_MEMORY_SCOPE_AGENT); }
__device__ __forceinline__ unsigned xb_add(unsigned* p, unsigned v) { return __hip_atomic_fetch_add(p, v, __ATOMIC_RELAXED, __HIP_MEMORY_SCOPE_AGENT); }
__device__ __forceinline__ unsigned xb_xcc_id() { return (unsigned)__builtin_amdgcn_s_getreg((3 << 11) | 20) & 0xFu; }
#define XB_SPIN(cond, bar) do { unsigned _sp = 0; while (cond) { __builtin_amdgcn_s_sleep(1); \
    if ((++_sp & 255u) == 0u) { if (xb_ld(&(bar)[XB_TMO])) break; if (_sp > XB_SPIN_CAP) { atomicAdd(&(bar)[XB_TMO], 1u); break; } } } } while (0)
struct XcdBarrier { unsigned* bar; unsigned x; volatile LAS unsigned* st; };
__device__ __forceinline__ XcdBarrier xcd_barrier_post(unsigned* bar, volatile LAS unsigned* st) {
    XcdBarrier b; b.bar = bar; b.x = xb_xcc_id(); b.st = st;
    if (threadIdx.x == 0) (void)xb_add(&bar[XB_XCNT(b.x)], 1u);
    return b;
}
__device__ __forceinline__ void xcd_barrier_complete(unsigned* bar, unsigned x, unsigned& nloc, unsigned& nx) {
    const unsigned G = gridDim.x * gridDim.y * gridDim.z;
    unsigned sum, cnt, mine, sp = 0u;
    for (;;) {
        sum = 0u; cnt = 0u; mine = 0u;
#pragma unroll
        for (unsigned j = 0; j < 16; ++j) { const unsigned c = xb_ld(&bar[XB_XCNT(j)]); sum += c; cnt += (c > 0u) ? 1u : 0u; mine = (j == x) ? c : mine; }
        if (sum == G) break;
        __builtin_amdgcn_s_sleep(1);
        if ((++sp & 255u) == 0u) { if (xb_ld(&bar[XB_TMO])) break; if (sp > XB_SPIN_CAP) { atomicAdd(&bar[XB_TMO], 1u); break; } }
    }
    nloc = mine > 0u ? mine : 1u; nx = cnt > 0u ? cnt : 1u;
}
__device__ __forceinline__ void xcd_barrier(const XcdBarrier& b) {
    asm volatile("s_waitcnt vmcnt(0)" ::: "memory");
    __syncthreads();
    if (threadIdx.x == 0) {
        unsigned* bar = b.bar;
        __builtin_amdgcn_s_waitcnt(0);
        unsigned nloc = b.st[0], nx = b.st[1];
        if (nloc == 0u) { xcd_barrier_complete(bar, b.x, nloc, nx); b.st[0] = nloc; b.st[1] = nx; }
        const unsigned old = xb_add(&bar[XB_XSUB(b.x)], 1u);
        const unsigned gen = old / nloc;
        if (old + 1u == (gen + 1u) * nloc) {
            __builtin_amdgcn_fence(__ATOMIC_RELEASE, "agent");
            asm volatile("s_waitcnt vmcnt(0)" ::: "memory");
            const unsigned og = xb_add(&bar[XB_TOP], 1u);
            const unsigned tg = og / nx;
            if (og + 1u == (tg + 1u) * nx) xb_add(&bar[XB_TOPGEN], 1u);
            else XB_SPIN(xb_ld(&bar[XB_TOPGEN]) == tg, bar);
            __builtin_amdgcn_fence(__ATOMIC_ACQUIRE, "agent");
            xb_add(&bar[XB_XGEN(b.x)], 1u);
            asm volatile("s_waitcnt vmcnt(0)" ::: "memory");
        } else {
            XB_SPIN(xb_ld(&bar[XB_XGEN(b.x)]) == gen, bar);
            __builtin_amdgcn_fence(__ATOMIC_ACQUIRE, "agent");
            asm volatile("s_waitcnt vmcnt(0)" ::: "memory");
        }
    }
    __syncthreads();
}

struct Args { const float* in[36]; float* out; unsigned char* ws; int ph_lo, ph_hi, li, pad; };
enum { I_XP = 0, I_XS, I_MEM, I_CK, I_CV, I_SCONV, I_SLRU, I_CMK, I_CMV, I_REL, I_NMIX, I_WIN, I_LQ1, I_LK1, I_LQ2, I_LK2, I_SUBG, I_CONVW, I_CONVB,
       I_WRGA, I_BRGA, I_WRGX, I_BRGX, I_RGL, I_NMEM, I_WMEM, I_WPA, I_WPB, I_WPC, I_WGATE, I_BGATE, I_WOUT, I_NFFN, I_WFI, I_WFO, I_NFIN };

__device__ __forceinline__ void transpose_item(const float* W, int K, int N, bf16_t* WT, int kb, int nb, int dst_row0, const float* kscale, LAS float* scr, int lane) {
    const int k0 = 64 * kb, n0 = 32 * nb;
#pragma unroll 8
    for (int i = 0; i < 32; ++i) { const int kk = 2 * i + (lane >> 5); scr[kk * 33 + (lane & 31)] = W[(size_t)(k0 + kk) * N + n0 + (lane & 31)]; }
    asm volatile("s_waitcnt lgkmcnt(0)" ::: "memory");
    const int c = lane & 7;
    float sc[8];
#pragma unroll
    for (int e = 0; e < 8; ++e) sc[e] = kscale ? kscale[k0 + 8 * c + e] : 1.0f;
#pragma unroll
    for (int j = 0; j < 4; ++j) { const int n = (lane >> 3) + 8 * j; const LAS float* s = scr + (8 * c) * 33 + n;
        u32x4 o; o.x = pk_bf16(s[0 * 33] * sc[0], s[1 * 33] * sc[1]); o.y = pk_bf16(s[2 * 33] * sc[2], s[3 * 33] * sc[3]);
        o.z = pk_bf16(s[4 * 33] * sc[4], s[5 * 33] * sc[5]); o.w = pk_bf16(s[6 * 33] * sc[6], s[7 * 33] * sc[7]);
        *(u32x4*)(WT + (size_t)(dst_row0 + n) * K + k0 + 8 * c) = o; }
    asm volatile("s_waitcnt lgkmcnt(0)" ::: "memory");
}
__device__ __forceinline__ void norm_row_bf16(const float* xrow, const float* gain, bf16_t* orow, int lane) {
    const f32x4* xr = (const f32x4*)xrow + lane; const f32x4* gr = (const f32x4*)gain + lane;
    f32x4 v[4]; float s = 0.f;
#pragma unroll
    for (int j = 0; j < 4; ++j) { v[j] = xr[64 * j]; s += (v[j].x * v[j].x + v[j].y * v[j].y) + (v[j].z * v[j].z + v[j].w * v[j].w); }
    const float rstd = 1.0f / sqrtf(wave_sum(s) * (1.0f / 1024.0f) + EPS);
    u32x2* o8 = (u32x2*)orow + lane;
#pragma unroll
    for (int j = 0; j < 4; ++j) { const f32x4 g = gr[64 * j]; u32x2 w; w.x = pk_bf16(v[j].x * rstd * g.x, v[j].y * rstd * g.y); w.y = pk_bf16(v[j].z * rstd * g.z, v[j].w * rstd * g.w); o8[64 * j] = w; }
}
__device__ __forceinline__ void p0_prologue(const Args& a, LAS unsigned char* lds, int gw, int NGW, int wave, int lane) {
    LAS float* scr = (LAS float*)(lds + wave * 16384);
    unsigned char* ws = a.ws;
    constexpr int I0 = 16 * 192, I1 = 16 * 96, I2 = 16 * 64, I3 = 16 * 32, I7 = 16 * 176, I8 = 44 * 32, I9 = 64;
    constexpr int NITEMS = I0 + I1 + I2 + 4 * I3 + I7 + I8 + 2 * I9;
    for (int it = gw; it < NITEMS; it += NGW) {
        int r = it;
        if (r < I0) { transpose_item(a.in[I_WIN], 1024, INW, (bf16_t*)(ws + WS_WCAT), r / 192, r % 192, 32 * (r % 192), nullptr, scr, lane); continue; } r -= I0;
        if (r < I1) { transpose_item(a.in[I_WGATE], 1024, GATEW, (bf16_t*)(ws + WS_WCAT), r / 96, r % 96, 6144 + 32 * (r % 96), nullptr, scr, lane); continue; } r -= I1;
        if (r < I2) { transpose_item(a.in[I_WMEM], 1024, 2048, (bf16_t*)(ws + WS_WCAT), r / 64, r % 64, 9216 + 32 * (r % 64), nullptr, scr, lane); continue; } r -= I2;
        if (r < I3) { transpose_item(a.in[I_WPA], 1024, 1024, (bf16_t*)(ws + WS_WP), r / 32, r % 32, 32 * (r % 32), nullptr, scr, lane); continue; } r -= I3;
        if (r < I3) { transpose_item(a.in[I_WPB], 1024, 1024, (bf16_t*)(ws + WS_WP), r / 32, r % 32, 1024 + 32 * (r % 32), nullptr, scr, lane); continue; } r -= I3;
        if (r < I3) { transpose_item(a.in[I_WPC], 1024, 1024, (bf16_t*)(ws + WS_WP), r / 32, r % 32, 2048 + 32 * (r % 32), nullptr, scr, lane); continue; } r -= I3;
        if (r < I3) { transpose_item(a.in[I_WOUT], 1024, 1024, (bf16_t*)(ws + WS_WO), r / 32, r % 32, 32 * (r % 32), nullptr, scr, lane); continue; } r -= I3;
        if (r < I7) { const int nb = r % 176, n0 = 32 * nb; const int ch0 = n0 < DFF ? n0 : n0 - DFF; const int dst = 256 * (ch0 / 128) + (n0 < DFF ? 0 : 128) + (ch0 % 128);
            transpose_item(a.in[I_WFI], 1024, 2 * DFF, (bf16_t*)(ws + WS_WFI), r / 176, nb, dst, a.in[I_NFFN], scr, lane); continue; } r -= I7;
        if (r < I8) { transpose_item(a.in[I_WFO], DFF, 1024, (bf16_t*)(ws + WS_WFO), r / 32, r % 32, 32 * (r % 32), nullptr, scr, lane); continue; } r -= I8;
        if (r < I9) { const int n = r / 8, s = r % 8;
          transpose_item(a.in[I_WRGA] + (size_t)n * 128 * 128, 128, 128, (bf16_t*)(ws + WS_WRG) + (size_t)n * 128 * 128, s / 4, s % 4, 32 * (s % 4), nullptr, scr, lane); continue; } r -= I9;
        { const int n = r / 8, s = r % 8;
          transpose_item(a.in[I_WRGX] + (size_t)n * 128 * 128, 128, 128, (bf16_t*)(ws + WS_WRG) + (size_t)(8 + n) * 128 * 128, s / 4, s % 4, 32 * (s % 4), nullptr, scr, lane); }
    }
    bf16_t* XN = (bf16_t*)(ws + WS_XN);
    for (int m = gw; m < TALL; m += NGW) {
        if (m < TP) norm_row_bf16(a.in[I_XP] + (size_t)m * DM, a.in[I_NMIX], XN + (size_t)m * DM, lane);
        else if (m < TT) norm_row_bf16(a.in[I_XS] + (size_t)(m - TP) * DM, a.in[I_NMIX], XN + (size_t)m * DM, lane);
        else norm_row_bf16(a.in[I_MEM] + (size_t)(m - TT) * DM, a.in[I_NMEM], XN + (size_t)m * DM, lane);
    }
}

struct Sched1 {
    const char* A; const char* B; int G, c;
    __device__ __forceinline__ bool next(int i, pg8::Unit& u) const {
        const int L = i * G + c;
        if (L < 66 * 36) { int pm, pn; pg8::tile_order(L, 66, 36, pm, pn); u.pm = pm; u.pn = pn; u.kind = pn >> 2;
            u.A = A + (size_t)pm * 256 * 1024 * 2; u.B = B + (size_t)pn * 256 * 1024 * 2; return true; }
        const int L2 = L - 66 * 36;
        if (L2 < 64) { int pm, pn; pg8::tile_order(L2, 8, 8, pm, pn); u.pm = pm; u.pn = pn; u.kind = 9;
            u.A = A + (size_t)(66 + pm) * 256 * 1024 * 2; u.B = B + (size_t)(36 + pn) * 256 * 1024 * 2; return true; }
        return false;
    }
};
struct Epi1 {
    static constexpr bool ZERO_AFTER = true;
    bf16_t *Q, *Kb, *Vb, *XB, *GG, *QC, *G, *MK, *MV; float* out; const float* bgate;
    __device__ __forceinline__ bool operator()(f32x4 (&acc)[2][2][4][2], const pg8::Unit& u, int wr, int wc, int fr, int fq) const {
        const int rowb = u.pm * 256 + wr * 64 + fr, colb = (u.pn & 3) * 256 + wc * 32 + 8 * fq;
        const int kind = u.kind;
        if (kind == 0) { TILE_FOR( *(u32x4*)(Q + (size_t)row * DM + col) = pack8(v0 * QSCALE, v1 * QSCALE); ) }
        else if (kind == 1 || kind == 2) {
            bf16_t* B = kind == 1 ? Kb : Vb; const size_t op = kind == 1 ? O_KP : O_VP, os = kind == 1 ? O_KS : O_VS;
            TILE_FOR( *(u32x4*)(B + (size_t)row * DM + col) = pack8(v0, v1);
                      float* o = out + (row < TP ? op + (size_t)row * DM : os + (size_t)(row - TP) * DM) + col; *(f32x4*)o = v0; *(f32x4*)(o + 4) = v1; ) }
        else if (kind == 3) {
            TILE_FOR( *(u32x4*)(XB + (size_t)row * DM + col) = pack8(v0, v1);
                      if (row < TP) { const int s = row & (SEQ - 1); if (s >= SEQ - 3) { float* o = out + O_CP + (size_t)((row >> 11) * 3 + (s - (SEQ - 3))) * DM + col; *(f32x4*)o = v0; *(f32x4*)(o + 4) = v1; } }
                      else { const int rs = row - TP, s = rs & (DSEQ - 1); if (s >= DSEQ - 3) { float* o = out + O_CS + (size_t)((rs >> 5) * 3 + (s - (DSEQ - 3))) * DM + col; *(f32x4*)o = v0; *(f32x4*)(o + 4) = v1; } } ) }
        else if (kind == 4) {
            TILE_FOR( f32x4 g0, g1;
                      _Pragma("unroll") for (int j = 0; j < 4; ++j) { g0[j] = gelu_tanh(v0[j]); g1[j] = gelu_tanh(v1[j]); }
                      *(u32x4*)(GG + (size_t)row * DM + col) = pack8(g0, g1); ) }
        else if (kind == 5) { TILE_FOR( *(u32x4*)(QC + (size_t)row * DM + col) = pack8(v0 * CSCALE, v1 * CSCALE); ) }
        else if (kind <= 8) {
            const int gofs = (kind - 6) * 1024;
            TILE_FOR( const f32x4 b0 = *(const f32x4*)(bgate + gofs + col); const f32x4 b1 = *(const f32x4*)(bgate + gofs + col + 4); f32x4 g0, g1;
                      _Pragma("unroll") for (int j = 0; j < 4; ++j) { g0[j] = sigmoidf_(v0[j] + b0[j]); g1[j] = sigmoidf_(v1[j] + b1[j]); }
                      *(u32x4*)(G + (size_t)row * GATEW + gofs + col) = pack8(g0, g1); ) }
        else {
            bf16_t* B = u.pn < 4 ? MK : MV; const size_t ob = u.pn < 4 ? O_MKP : O_MVP;
            TILE_FOR( *(u32x4*)(B + (size_t)row * DM + col) = pack8(v0, v1);
                      float* o = out + ob + (size_t)row * DM + col; *(f32x4*)o = v0; *(f32x4*)(o + 4) = v1; ) }
        return true;
    }
};

struct Sched2 {
    const char* A0; const char* A1; const char* A2; const char* B; int G, c;
    __device__ __forceinline__ bool next(int i, pg8::Unit& u) const {
        const int j = i / 3, br = i - 3 * j; const int L = j * G + c;
        if (L >= 64 * 4) return false;
        int pm, pn; pg8::tile_order(L, 64, 4, pm, pn); u.pm = pm; u.pn = pn; u.kind = br;
        u.A = (br == 0 ? A0 : br == 1 ? A1 : A2) + (size_t)pm * 256 * 1024 * 2; u.B = B + (size_t)(br * 1024 + pn * 256) * 1024 * 2; return true;
    }
};
struct Epi2 {
    static constexpr bool ZERO_AFTER = false;
    const bf16_t* G; bf16_t* MG;
    __device__ __forceinline__ bool operator()(f32x4 (&acc)[2][2][4][2], const pg8::Unit& u, int wr, int wc, int fr, int fq) const {
        const int rowb = u.pm * 256 + wr * 64 + fr, colb = u.pn * 256 + wc * 32 + 8 * fq;
        const int br = u.kind; const bool last = br == 2;
        TILE_FOR( const bf16_t* gp = G + (size_t)row * GATEW + br * 1024 + col;
                  const u32x4 gc = *(const u32x4*)gp; const u32x4 gn = *(const u32x4*)(gp + 1024);
                  float c[8], n[8]; unpack8(gc, c); unpack8(gn, n); f32x4 o0, o1;
                  _Pragma("unroll") for (int j = 0; j < 8; ++j) { c[j] = fmaxf(c[j], 1e-30f); n[j] = last ? 1.0f : fmaxf(n[j], 1e-30f); }
                  _Pragma("unroll") for (int j = 0; j < 4; ++j) { v0[j] *= c[j] * frcp(n[j]); v1[j] *= c[4 + j] * frcp(n[4 + j]); }
                  _Pragma("unroll") for (int j = 0; j < 4; ++j) { o0[j] = v0[j] * n[j]; o1[j] = v1[j] * n[4 + j]; }
                  *(u32x4*)(MG + (size_t)row * DM + col) = pack8(o0, o1);
                  if (bj == 1) asm volatile("" ::: "memory"); )
        return last;
    }
};

struct SchedT {
    const char* A; const char* B; int nM, nN, K, G, c;
    __device__ __forceinline__ bool next(int i, pg8::Unit& u) const {
        const int L = i * G + c; if (L >= nM * nN) return false;
        int pm, pn; pg8::tile_order(L, nM, nN, pm, pn); u.pm = pm; u.pn = pn; u.kind = 0;
        u.A = A + (size_t)pm * 256 * K * 2; u.B = B + (size_t)pn * 256 * K * 2; return true;
    }
};
struct Epi3 {
    static constexpr bool ZERO_AFTER = true;
    const float* xp; const float* xs; float* X1; bf16_t* X1B; float* SS;
    __device__ __forceinline__ bool operator()(f32x4 (&acc)[2][2][4][2], const pg8::Unit& u, int wr, int wc, int fr, int fq) const {
        const int rowb = u.pm * 256 + wr * 64 + fr, colb = u.pn * 256 + wc * 32 + 8 * fq;
#pragma unroll
        for (int ai = 0; ai < 2; ++ai)
#pragma unroll
            for (int m = 0; m < 4; ++m) { const int row = rowb + ai * 128 + m * 16; float ss = 0.f;
                const float* xr = row < TP ? xp + (size_t)row * DM : xs + (size_t)(row - TP) * DM;
#pragma unroll
                for (int bj = 0; bj < 2; ++bj) { const int col = colb + bj * 128;
                    const f32x4 a0 = acc[ai][bj][m][0] + *(const f32x4*)(xr + col), a1 = acc[ai][bj][m][1] + *(const f32x4*)(xr + col + 4);
                    *(f32x4*)(X1 + (size_t)row * DM + col) = a0; *(f32x4*)(X1 + (size_t)row * DM + col + 4) = a1;
                    *(u32x4*)(X1B + (size_t)row * DM + col) = pack8(a0, a1);
                    ss += (a0[0] * a0[0] + a0[1] * a0[1]) + (a0[2] * a0[2] + a0[3] * a0[3]) + (a1[0] * a1[0] + a1[1] * a1[1]) + (a1[2] * a1[2] + a1[3] * a1[3]); }
                ss += __shfl_xor(ss, 16); ss += __shfl_xor(ss, 32);
                if (fq == 0) SS[(size_t)row * 16 + u.pn * 4 + wc] = ss; }
        return true;
    }
};
struct Epi4 {
    static constexpr bool ZERO_AFTER = true;
    const float* SS; bf16_t* ACT;
    __device__ __forceinline__ bool operator()(f32x4 (&acc)[2][2][4][2], const pg8::Unit& u, int wr, int wc, int fr, int fq) const {
        const int rowb = u.pm * 256 + wr * 64 + fr, colb = u.pn * 128 + wc * 32 + 8 * fq;
#pragma unroll
        for (int ai = 0; ai < 2; ++ai)
#pragma unroll
            for (int m = 0; m < 4; ++m) { const int row = rowb + ai * 128 + m * 16;
                const f32x4 p = *(const f32x4*)(SS + (size_t)row * 16 + 4 * fq); float s = (p[0] + p[1]) + (p[2] + p[3]);
                s += __shfl_xor(s, 16); s += __shfl_xor(s, 32);
                const float rstd = 1.0f / sqrtf(s * (1.0f / 1024.0f) + EPS);
                f32x4 o0, o1;
#pragma unroll
                for (int j = 0; j < 4; ++j) { const float g0 = acc[ai][0][m][0][j] * rstd, u0 = acc[ai][1][m][0][j] * rstd, g1 = acc[ai][0][m][1][j] * rstd, u1 = acc[ai][1][m][1][j] * rstd;
                    o0[j] = g0 * sigmoidf_(g0) * u0; o1[j] = g1 * sigmoidf_(g1) * u1; }
                *(u32x4*)(ACT + (size_t)row * DFF + colb) = pack8(o0, o1); }
        return true;
    }
};
struct Epi5 {
    static constexpr bool ZERO_AFTER = true;
    float* X1;
    __device__ __forceinline__ bool operator()(f32x4 (&acc)[2][2][4][2], const pg8::Unit& u, int wr, int wc, int fr, int fq) const {
        const int rowb = u.pm * 256 + wr * 64 + fr, colb = u.pn * 256 + wc * 32 + 8 * fq;
        TILE_FOR( float* p = X1 + (size_t)row * DM + col; const f32x4 a0 = v0 + *(const f32x4*)p, a1 = v1 + *(const f32x4*)(p + 4); *(f32x4*)p = a0; *(f32x4*)(p + 4) = a1; )
        return true;
    }
};


template <int NSEG, class Fin>
__device__ __forceinline__ void tail_gemm(LAS unsigned char* lds, const bf16_t* A0, const bf16_t* A1, const bf16_t* A2, const bf16_t* Bt, const int Kseg, const bf16_t* G, const Fin& fin, int G_, int bx) {
    const int tid = threadIdx.x, wid = __builtin_amdgcn_readfirstlane(tid >> 6), lane = tid & 63, fr = lane & 15, fq = lane >> 4;
    const int ksl = Kseg / 8, kbase = wid * ksl;
    LAS float* part = (LAS float*)lds;
    for (int tile = bx; tile < 256; tile += G_) {
        const int rt = tile >> 4, ct = tile & 15, r0 = TP + rt * 32, c0 = ct * 64;
        f32x4 tot[2][4];
#pragma unroll
        for (int m = 0; m < 2; ++m)
#pragma unroll
            for (int n = 0; n < 4; ++n) tot[m][n] = (f32x4){0.f, 0.f, 0.f, 0.f};
#pragma unroll
        for (int seg = 0; seg < NSEG; ++seg) {
            const bf16_t* A = seg == 0 ? A0 : seg == 1 ? A1 : A2;
            f32x4 acc[2][4];
#pragma unroll
            for (int m = 0; m < 2; ++m)
#pragma unroll
                for (int n = 0; n < 4; ++n) acc[m][n] = (f32x4){0.f, 0.f, 0.f, 0.f};
            const bf16_t* ap = A + (size_t)(r0 + fr) * Kseg + kbase + 8 * fq;
            const bf16_t* wp = Bt + (size_t)(seg * 1024 + c0 + fr) * Kseg + kbase + 8 * fq;
#pragma unroll 4
            for (int kk = 0; kk < ksl; kk += 32) {
                bf16x8 af[2], wf[4];
#pragma unroll
                for (int m = 0; m < 2; ++m) af[m] = *(const bf16x8*)(ap + (size_t)(16 * m) * Kseg + kk);
#pragma unroll
                for (int n = 0; n < 4; ++n) wf[n] = *(const bf16x8*)(wp + (size_t)(16 * n) * Kseg + kk);
#pragma unroll
                for (int m = 0; m < 2; ++m)
#pragma unroll
                    for (int n = 0; n < 4; ++n) acc[m][n] = __builtin_amdgcn_mfma_f32_16x16x32_bf16(wf[n], af[m], acc[m][n], 0, 0, 0);
            }
            if (G) {
#pragma unroll
                for (int m = 0; m < 2; ++m)
#pragma unroll
                    for (int n = 0; n < 4; ++n) { const u32x2 g = *(const u32x2*)(G + (size_t)(r0 + 16 * m + fr) * GATEW + seg * 1024 + c0 + 16 * n + 4 * fq);
                        tot[m][n][0] += acc[m][n][0] * bf_lo(g.x); tot[m][n][1] += acc[m][n][1] * bf_hi(g.x); tot[m][n][2] += acc[m][n][2] * bf_lo(g.y); tot[m][n][3] += acc[m][n][3] * bf_hi(g.y); }
            } else {
#pragma unroll
                for (int m = 0; m < 2; ++m)
#pragma unroll
                    for (int n = 0; n < 4; ++n) tot[m][n] += acc[m][n];
            }
        }
#pragma unroll
        for (int m = 0; m < 2; ++m)
#pragma unroll
            for (int n = 0; n < 4; ++n) *(LAS f32x4*)(part + wid * 2048 + (16 * m + fr) * 64 + 16 * n + 4 * fq) = tot[m][n];
        __syncthreads();
        { const int row = tid >> 4, c4 = tid & 15;
          f32x4 v = *(const LAS f32x4*)(part + row * 64 + c4 * 4);
#pragma unroll
          for (int w = 1; w < 8; ++w) v += *(const LAS f32x4*)(part + w * 2048 + row * 64 + c4 * 4);
          fin(r0 + row, c0 + c4 * 4, v, ct); }
        __syncthreads();
    }
}
struct Fin3 { bf16_t* MG;
    __device__ __forceinline__ void operator()(int row, int col, f32x4 v, int) const { u32x2 w; w.x = pk_bf16(v[0], v[1]); w.y = pk_bf16(v[2], v[3]); *(u32x2*)(MG + (size_t)row * DM + col) = w; } };
struct Fin4 { const float* xs; float* X1; bf16_t* X1B; float* SS;
    __device__ __forceinline__ void operator()(int row, int col, f32x4 v, int ct) const {
        const f32x4 a = v + *(const f32x4*)(xs + (size_t)(row - TP) * DM + col);
        *(f32x4*)(X1 + (size_t)row * DM + col) = a; u32x2 w; w.x = pk_bf16(a[0], a[1]); w.y = pk_bf16(a[2], a[3]); *(u32x2*)(X1B + (size_t)row * DM + col) = w;
        float ss = (a[0] * a[0] + a[1] * a[1]) + (a[2] * a[2] + a[3] * a[3]);
        ss += __shfl_xor(ss, 1); ss += __shfl_xor(ss, 2); ss += __shfl_xor(ss, 4); ss += __shfl_xor(ss, 8);
        if ((threadIdx.x & 15) == 0) SS[(size_t)row * 16 + ct] = ss; } };
struct Fin6 { float* X1;
    __device__ __forceinline__ void operator()(int row, int col, f32x4 v, int) const { float* p = X1 + (size_t)row * DM + col; *(f32x4*)p = v + *(const f32x4*)p; } };

struct P2Ctx {
    const Args* a; LAS unsigned char* lds; int tid, lane, wid;
    const bf16_t *Q, *Kb, *Vb, *XB, *GG, *QC, *MK, *MV, *WRG; bf16_t *AO, *BO, *CO;
};
template <int NB>
__device__ __forceinline__ float softmax_step(f32x16 (&s)[NB], float& m, float& l) {
    float mx = s[0][0];
#pragma unroll
    for (int b = 0; b < NB; ++b)
#pragma unroll
        for (int r = 0; r < 16; ++r) mx = fmaxf(mx, s[b][r]);
    mx = fmaxf(mx, __shfl_xor(mx, 32));
    const float mn = fmaxf(m, mx), alpha = fexp2(m - mn);
    float ps = 0.f;
#pragma unroll
    for (int b = 0; b < NB; ++b)
#pragma unroll
        for (int r = 0; r < 16; ++r) { const float p = fexp2(s[b][r] - mn); s[b][r] = p; ps += p; }
    l = l * alpha + ps; m = mn;
    return alpha;
}
__device__ __forceinline__ bf16x8 pack_p(const f32x16& s, int h) {
    u32x4 w; w.x = pk_bf16(s[8 * h + 0], s[8 * h + 1]); w.y = pk_bf16(s[8 * h + 2], s[8 * h + 3]); w.z = pk_bf16(s[8 * h + 4], s[8 * h + 5]); w.w = pk_bf16(s[8 * h + 6], s[8 * h + 7]);
    return __builtin_bit_cast(bf16x8, w);
}
__device__ __forceinline__ bf16x8 v_frag(const LAS unsigned char* vimg, int ncb, int s, int cb, int lane) {
    const int hi = lane >> 5, g16 = (lane >> 4) & 1, i = lane & 15;
    const LAS unsigned char* p = vimg + ((2 * s) * ncb + cb) * 512 + (4 * hi + (i >> 2)) * 64 + g16 * 32 + (i & 3) * 8;
    const s16x4 lo = vtr(p), hv = vtr(p + ncb * 512);
    return (bf16x8){lo[0], lo[1], lo[2], lo[3], hv[0], hv[1], hv[2], hv[3]};
}
__device__ __forceinline__ void subln_store(f32x16 (&o)[4], const float* subg, bf16_t* dst  , int lane) {
    const int hi = lane >> 5;
    float ss = 0.f;
#pragma unroll
    for (int cb = 0; cb < 4; ++cb)
#pragma unroll
        for (int r = 0; r < 16; ++r) ss += o[cb][r] * o[cb][r];
    ss += __shfl_xor(ss, 32);
    const float rstd = (1.0f - LAMBDA_INIT) / sqrtf(ss * (1.0f / 128.0f) + EPS);
#pragma unroll
    for (int cb = 0; cb < 4; ++cb)
#pragma unroll
        for (int g = 0; g < 4; ++g) { const int dv0 = 32 * cb + 8 * g + 4 * hi; const f32x4 sg = *(const f32x4*)(subg + dv0);
            u32x2 w; w.x = pk_bf16(o[cb][4 * g + 0] * rstd * sg[0], o[cb][4 * g + 1] * rstd * sg[1]); w.y = pk_bf16(o[cb][4 * g + 2] * rstd * sg[2], o[cb][4 * g + 3] * rstd * sg[3]);
            *(u32x2*)(dst + dv0) = w; }
}

__device__ __forceinline__ void attnA_unit(const P2Ctx& C, int b, int h, int qb) {
    LAS unsigned char* lds = C.lds; const int tid = C.tid, lane = C.lane, wid = C.wid;
    const int comp = wid >> 2, qs = wid & 3, r32 = lane & 31, hi = lane >> 5;
    const int q0 = qb * 128, trow0 = b * SEQ;
    const int qpos = q0 + qs * 32 + r32; const size_t qrow = (size_t)(trow0 + qpos);
    const int qcw = (q0 + qs * 32) >> 6, ntw = qcw + 1, NT = 2 * qb + 2;
    const LAS float* lut = (const LAS float*)(lds + LUT_OFF) + h * 256;
    const float lam = *(const LAS float*)(lds + LAM_OFF);
    bf16x8 qf[4];
#pragma unroll
    for (int ds = 0; ds < 4; ++ds) qf[ds] = *(const bf16x8*)(C.Q + qrow * DM + h * 128 + comp * 64 + ds * 16 + hi * 8);
    u32x4 kreg[2], vreg[2];
    const int kkey = tid >> 3, kch = tid & 7;
#define A_ISSUE(kt) do { const size_t tr_ = (size_t)(trow0 + (kt) * 64); \
        kreg[0] = *(const u32x4*)(C.Kb + (tr_ + kkey) * DM + h * 128 + kch * 8); kreg[1] = *(const u32x4*)(C.Kb + (tr_ + kkey) * DM + h * 128 + 64 + kch * 8); \
        _Pragma("unroll") for (int i_ = 0; i_ < 2; ++i_) { const int idx_ = tid + 512 * i_; vreg[i_] = *(const u32x4*)(C.Vb + (tr_ + (idx_ >> 4)) * DM + h * 128 + (idx_ & 15) * 8); } } while (0)
#define A_WRITE(st) do { LAS unsigned char* sb_ = lds + (st) * 32768; \
        *(LAS u32x4*)(sb_ + kkey * 128 + ((kch ^ ((kkey >> 1) & 7)) << 4)) = kreg[0]; *(LAS u32x4*)(sb_ + 8192 + kkey * 128 + ((kch ^ ((kkey >> 1) & 7)) << 4)) = kreg[1]; \
        _Pragma("unroll") for (int i_ = 0; i_ < 2; ++i_) { const int idx_ = tid + 512 * i_, key_ = idx_ >> 4, ch_ = idx_ & 15; \
            *(LAS u32x4*)(sb_ + 16384 + ((key_ >> 3) * 4 + (ch_ >> 2)) * 512 + (key_ & 7) * 64 + (ch_ & 3) * 16) = vreg[i_]; } } while (0)
    f32x16 o[4];
#pragma unroll
    for (int cb = 0; cb < 4; ++cb)
#pragma unroll
        for (int r = 0; r < 16; ++r) o[cb][r] = 0.f;
    float m = -1e30f, l = 0.f;
    A_ISSUE(0); A_WRITE(0); __syncthreads();
    for (int kt = 0; kt < NT; ++kt) {
        if (kt + 1 < NT) A_ISSUE(kt + 1);
        if (kt < ntw) {
            const LAS unsigned char* sb = lds + (kt & 1) * 32768;
            const int relmax = kt * 64 + 63 - (q0 + qs * 32);
            const bool far = (relmax + 192 <= 0);
            f32x16 s[2];
            { const float c0 = far ? lut[0] : 0.f;
#pragma unroll
              for (int kb = 0; kb < 2; ++kb)
#pragma unroll
                  for (int r = 0; r < 16; ++r) s[kb][r] = c0; }
#pragma unroll
            for (int ds = 0; ds < 4; ++ds)
#pragma unroll
                for (int kb = 0; kb < 2; ++kb) { const int key = kb * 32 + r32, ch = 2 * ds + hi;
                    const bf16x8 kf = *(const LAS bf16x8*)(sb + comp * 8192 + key * 128 + ((ch ^ ((key >> 1) & 7)) << 4));
                    s[kb] = MFMA32(kf, qf[ds], s[kb]); }
            if (!far) {
#pragma unroll
                for (int kb = 0; kb < 2; ++kb)
#pragma unroll
                    for (int r = 0; r < 16; ++r) { const int rel = kt * 64 + kb * 32 + crow(r, hi) - qpos; const int idx = rel + 192 > 0 ? rel + 192 : 0; s[kb][r] += lut[idx]; }
            }
            const float alpha = softmax_step<2>(s, m, l);
#pragma unroll
            for (int cb = 0; cb < 4; ++cb)
#pragma unroll
                for (int r = 0; r < 16; ++r) o[cb][r] *= alpha;
            bf16x8 pf[4];
            pf[0] = pack_p(s[0], 0); pf[1] = pack_p(s[0], 1); pf[2] = pack_p(s[1], 0); pf[3] = pack_p(s[1], 1);
#pragma unroll
            for (int cb = 0; cb < 4; ++cb)
#pragma unroll
                for (int ks = 0; ks < 4; ++ks) o[cb] = MFMA32(v_frag(sb + 16384, 4, ks, cb, lane), pf[ks], o[cb]);
        }
        if (kt + 1 < NT) A_WRITE((kt + 1) & 1);
        __syncthreads();
    }
#undef A_ISSUE
#undef A_WRITE
    l += __shfl_xor(l, 32);
    const float inv = 1.0f / l;
    LAS float* X2 = (LAS float*)(lds + 65536);
    if (comp == 1) {
#pragma unroll
        for (int cb = 0; cb < 4; ++cb)
#pragma unroll
            for (int r = 0; r < 16; ++r) X2[((qs * 4 + cb) * 16 + r) * 64 + lane] = o[cb][r] * inv;
    }
    __syncthreads();
    if (comp == 0) {
#pragma unroll
        for (int cb = 0; cb < 4; ++cb)
#pragma unroll
            for (int r = 0; r < 16; ++r) o[cb][r] = o[cb][r] * inv - lam * X2[((qs * 4 + cb) * 16 + r) * 64 + lane];
        subln_store(o, C.a->in[I_SUBG], C.AO + qrow * DM + h * 128, lane);
    }
    __syncthreads();
}

__device__ __forceinline__ void attnB_unit(const P2Ctx& C, int b, int h) {
    LAS unsigned char* lds = C.lds; const int tid = C.tid, lane = C.lane, wid = C.wid;
    const int comp = wid >> 2, q4 = wid & 3, r32 = lane & 31, hi = lane >> 5;
    const LAS float* lut = (const LAS float*)(lds + LUT_OFF) + h * 256;
    const float lam = *(const LAS float*)(lds + LAM_OFF);
    const size_t trow0 = (size_t)(TP + b * DSEQ);
    const float* ck = C.a->in[I_CK]; const float* cv = C.a->in[I_CV];
    { const int c = tid >> 8, row = (tid >> 3) & 31, ch = tid & 7;
      *(LAS u32x4*)(lds + c * 4096 + row * 128 + ((ch ^ ((row >> 1) & 7)) << 4)) = *(const u32x4*)(C.Q + (trow0 + row) * DM + h * 128 + c * 64 + ch * 8); }
    LAS unsigned char* VL = lds + 8192;
    f32x4 vst[4][2];
    const int vkey = (tid >> 4) & 31, vch = tid & 15;
#define B_ISSUEV(it) do { _Pragma("unroll") for (int i_ = 0; i_ < 4; ++i_) { const float* p_ = cv + (((size_t)(b * PAST + (i_ * 16 + (it)) * 32 + vkey)) * 8 + h) * 128 + vch * 8; \
        vst[i_][0] = *(const f32x4*)p_; vst[i_][1] = *(const f32x4*)(p_ + 4); } } while (0)
#define B_WRITEV(st) do { _Pragma("unroll") for (int i_ = 0; i_ < 4; ++i_) \
        *(LAS u32x4*)(VL + ((st) * 4 + i_) * 8192 + ((vkey >> 3) * 4 + (vch >> 2)) * 512 + (vkey & 7) * 64 + (vch & 3) * 16) = pack8(vst[i_][0], vst[i_][1]); } while (0)
    f32x4 kst[4][2];
#define B_ISSUEK(it) do { const float* p_ = ck + ((((size_t)(b * PAST + (q4 * 16 + (it)) * 32 + r32)) * 8 + h) * 2 + comp) * 64 + hi * 8; \
        _Pragma("unroll") for (int ds_ = 0; ds_ < 4; ++ds_) { kst[ds_][0] = *(const f32x4*)(p_ + ds_ * 16); kst[ds_][1] = *(const f32x4*)(p_ + ds_ * 16 + 4); } } while (0)
    f32x16 o[4];
#pragma unroll
    for (int cb = 0; cb < 4; ++cb)
#pragma unroll
        for (int r = 0; r < 16; ++r) o[cb][r] = 0.f;
    float m = -1e30f, l = 0.f;
    B_ISSUEV(0); B_ISSUEK(0); B_WRITEV(0); __syncthreads();
    for (int it = 0; it <= 16; ++it) {
        const bool active = (it < 16) || (q4 == 0);
        bf16x8 kf[4];
        if (it < 16) {
#pragma unroll
            for (int ds = 0; ds < 4; ++ds) kf[ds] = __builtin_bit_cast(bf16x8, pack8(kst[ds][0], kst[ds][1]));
        } else {
#pragma unroll
            for (int ds = 0; ds < 4; ++ds) kf[ds] = *(const bf16x8*)(C.Kb + (trow0 + r32) * DM + h * 128 + comp * 64 + ds * 16 + hi * 8);
        }
        u32x4 vnew = (u32x4){0u, 0u, 0u, 0u};
        if (it + 1 < 16) { B_ISSUEV(it + 1); B_ISSUEK(it + 1); }
        else if (it + 1 == 16) { if (tid < 512) vnew = *(const u32x4*)(C.Vb + (trow0 + vkey) * DM + h * 128 + vch * 8); }
        if (active) {
            const int kpos0 = it < 16 ? (q4 * 16 + it) * 32 : PAST;
            const LAS unsigned char* vimg = VL + ((it & 1) * 4 + (it < 16 ? q4 : 0)) * 8192;
            const int qpos = PAST + r32;
            const bool far = (kpos0 + 31 - PAST + 192 <= 0);
            f32x16 s[1];
            { const float c0 = far ? lut[0] : 0.f;
#pragma unroll
              for (int r = 0; r < 16; ++r) s[0][r] = c0; }
#pragma unroll
            for (int ds = 0; ds < 4; ++ds) { const int ch = 2 * ds + hi;
                const bf16x8 qf = *(const LAS bf16x8*)(lds + comp * 4096 + r32 * 128 + ((ch ^ ((r32 >> 1) & 7)) << 4));
                s[0] = MFMA32(kf[ds], qf, s[0]); }
            if (!far) {
#pragma unroll
                for (int r = 0; r < 16; ++r) { const int rel = kpos0 + crow(r, hi) - qpos; const int idx = rel + 192 > 0 ? rel + 192 : 0; s[0][r] += lut[idx]; }
            }
            const float alpha = softmax_step<1>(s, m, l);
#pragma unroll
            for (int cb = 0; cb < 4; ++cb)
#pragma unroll
                for (int r = 0; r < 16; ++r) o[cb][r] *= alpha;
            const bf16x8 p0 = pack_p(s[0], 0), p1 = pack_p(s[0], 1);
#pragma unroll
            for (int cb = 0; cb < 4; ++cb) { o[cb] = MFMA32(v_frag(vimg, 4, 0, cb, lane), p0, o[cb]); o[cb] = MFMA32(v_frag(vimg, 4, 1, cb, lane), p1, o[cb]); }
        }
        if (it + 1 < 16) { B_WRITEV((it + 1) & 1); }
        else if (it + 1 == 16) { *(LAS u32x4*)(VL + (0 * 4 + 0) * 8192 + ((vkey >> 3) * 4 + (vch >> 2)) * 512 + (vkey & 7) * 64 + (vch & 3) * 16) = vnew; }
        __syncthreads();
    }
#undef B_ISSUEV
#undef B_WRITEV
#undef B_ISSUEK
    l += __shfl_xor(l, 32);
    LAS float* MX = (LAS float*)(lds + 73728);
    if (hi == 0) MX[wid * 32 + r32] = m;
    __syncthreads();
    float M = MX[(comp * 4 + 0) * 32 + r32];
#pragma unroll
    for (int j = 1; j < 4; ++j) M = fmaxf(M, MX[(comp * 4 + j) * 32 + r32]);
    const float f = fexp2(m - M);
    l *= f;
#pragma unroll
    for (int cb = 0; cb < 4; ++cb)
#pragma unroll
        for (int r = 0; r < 16; ++r) o[cb][r] *= f;
    if (hi == 0) MX[256 + wid * 32 + r32] = l;
    __syncthreads();
    float L = 0.f;
#pragma unroll
    for (int j = 0; j < 4; ++j) L += MX[256 + (comp * 4 + j) * 32 + r32];
    const float inv = 1.0f / L;
    LAS float* R = (LAS float*)(lds + 8192);
#define B_PUT(slot) do { _Pragma("unroll") for (int cb = 0; cb < 4; ++cb) _Pragma("unroll") for (int r = 0; r < 16; ++r) R[(slot) * 4096 + (cb * 16 + r) * 64 + lane] = o[cb][r]; } while (0)
#define B_ADD(slot) do { _Pragma("unroll") for (int cb = 0; cb < 4; ++cb) _Pragma("unroll") for (int r = 0; r < 16; ++r) o[cb][r] += R[(slot) * 4096 + (cb * 16 + r) * 64 + lane]; } while (0)
    if (q4 >= 2) B_PUT(comp * 2 + (q4 - 2));
    __syncthreads();
    if (q4 < 2) B_ADD(comp * 2 + q4);
    __syncthreads();
    if (q4 == 1) B_PUT(comp);
    __syncthreads();
    if (q4 == 0) { B_ADD(comp);
#pragma unroll
        for (int cb = 0; cb < 4; ++cb)
#pragma unroll
            for (int r = 0; r < 16; ++r) o[cb][r] *= inv; }
    __syncthreads();
    if (q4 == 0 && comp == 1) B_PUT(0);
    __syncthreads();
    if (wid == 0) {
#pragma unroll
        for (int cb = 0; cb < 4; ++cb)
#pragma unroll
            for (int r = 0; r < 16; ++r) o[cb][r] -= lam * R[(cb * 16 + r) * 64 + lane];
        subln_store(o, C.a->in[I_SUBG], C.AO + (trow0 + r32) * DM + h * 128, lane);
    }
    __syncthreads();
#undef B_PUT
#undef B_ADD
}

template <bool SAMPLE>
__device__ __forceinline__ void attnC_unit(const P2Ctx& C, int b, int h, int qblk) {
    LAS unsigned char* lds = C.lds; const int tid = C.tid, lane = C.lane, wid = C.wid;
    const int dvh = wid >> 2, qs = wid & 3, r32 = lane & 31, hi = lane >> 5;
    const size_t trow0 = SAMPLE ? (size_t)(TP + b * DSEQ) : (size_t)(b * SEQ + qblk * 128);
    const int nq = SAMPLE ? DSEQ : 128;
    LAS unsigned char* QL = lds + 65536;
#pragma unroll
    for (int i = 0; i < 8; ++i) { const int idx = tid + 512 * i, row = idx >> 5, ch = idx & 31;
        u32x4 v = (u32x4){0u, 0u, 0u, 0u};
        if (row < nq) v = *(const u32x4*)(C.QC + (trow0 + row) * DM + h * 256 + ch * 8);
        *(LAS u32x4*)(QL + row * 512 + (((ch & 16) | ((ch ^ row) & 15)) << 4)) = v; }
    u32x4 kreg[2], vreg[2];
#define C_ISSUE(kt) do { _Pragma("unroll") for (int i_ = 0; i_ < 2; ++i_) { const int idx_ = tid + 512 * i_, key_ = idx_ >> 5, ch_ = idx_ & 31; const int mrow_ = (kt) * 32 + key_; \
        if (SAMPLE) { const float* pk_ = C.a->in[I_CMK] + (((size_t)(b * 256 + mrow_)) * 4 + h) * 256 + ch_ * 8; const float* pv_ = C.a->in[I_CMV] + (((size_t)(b * 256 + mrow_)) * 4 + h) * 256 + ch_ * 8; \
            kreg[i_] = pack8(*(const f32x4*)pk_, *(const f32x4*)(pk_ + 4)); vreg[i_] = pack8(*(const f32x4*)pv_, *(const f32x4*)(pv_ + 4)); } \
        else { kreg[i_] = *(const u32x4*)(C.MK + ((size_t)(b * 256 + mrow_)) * DM + h * 256 + ch_ * 8); vreg[i_] = *(const u32x4*)(C.MV + ((size_t)(b * 256 + mrow_)) * DM + h * 256 + ch_ * 8); } } } while (0)
#define C_WRITE(st) do { LAS unsigned char* sb_ = lds + (st) * 32768; _Pragma("unroll") for (int i_ = 0; i_ < 2; ++i_) { const int idx_ = tid + 512 * i_, key_ = idx_ >> 5, ch_ = idx_ & 31; \
        *(LAS u32x4*)(sb_ + key_ * 512 + (((ch_ & 16) | ((ch_ ^ key_) & 15)) << 4)) = kreg[i_]; \
        *(LAS u32x4*)(sb_ + 16384 + ((key_ >> 3) * 8 + (ch_ >> 2)) * 512 + (key_ & 7) * 64 + (ch_ & 3) * 16) = vreg[i_]; } } while (0)
    f32x16 o[4];
#pragma unroll
    for (int cb = 0; cb < 4; ++cb)
#pragma unroll
        for (int r = 0; r < 16; ++r) o[cb][r] = 0.f;
    float m = -1e30f, l = 0.f;
    const bool active = SAMPLE ? (qs == 0) : true;
    C_ISSUE(0); C_WRITE(0); __syncthreads();
    for (int kt = 0; kt < 8; ++kt) {
        if (kt + 1 < 8) C_ISSUE(kt + 1);
        if (active) {
            const LAS unsigned char* sb = lds + (kt & 1) * 32768;
            f32x16 s[1];
#pragma unroll
            for (int r = 0; r < 16; ++r) s[0][r] = 0.f;
            const int qrow = qs * 32 + r32;
#pragma unroll
            for (int ds = 0; ds < 16; ++ds) { const int ch = 2 * ds + hi;
                const bf16x8 kf = *(const LAS bf16x8*)(sb + r32 * 512 + (((ch & 16) | ((ch ^ r32) & 15)) << 4));
                const bf16x8 qf = *(const LAS bf16x8*)(QL + qrow * 512 + (((ch & 16) | ((ch ^ qrow) & 15)) << 4));
                s[0] = MFMA32(kf, qf, s[0]); }
            const float alpha = softmax_step<1>(s, m, l);
#pragma unroll
            for (int cb = 0; cb < 4; ++cb)
#pragma unroll
                for (int r = 0; r < 16; ++r) o[cb][r] *= alpha;
            const bf16x8 p0 = pack_p(s[0], 0), p1 = pack_p(s[0], 1);
#pragma unroll
            for (int cb = 0; cb < 4; ++cb) { o[cb] = MFMA32(v_frag(sb + 16384, 8, 0, dvh * 4 + cb, lane), p0, o[cb]); o[cb] = MFMA32(v_frag(sb + 16384, 8, 1, dvh * 4 + cb, lane), p1, o[cb]); }
        }
        if (kt + 1 < 8) C_WRITE((kt + 1) & 1);
        __syncthreads();
    }
#undef C_ISSUE
#undef C_WRITE
    if (active) {
        l += __shfl_xor(l, 32);
        const float inv = 1.0f / l;
        bf16_t* dst = C.CO + (trow0 + qs * 32 + r32) * DM + h * 256 + dvh * 128;
#pragma unroll
        for (int cb = 0; cb < 4; ++cb)
#pragma unroll
            for (int g = 0; g < 4; ++g) { const int dv0 = 32 * cb + 8 * g + 4 * hi;
                u32x2 w; w.x = pk_bf16(o[cb][4 * g + 0] * inv, o[cb][4 * g + 1] * inv); w.y = pk_bf16(o[cb][4 * g + 2] * inv, o[cb][4 * g + 3] * inv);
                *(u32x2*)(dst + dv0) = w; }
    }
    __syncthreads();
}

__device__ __forceinline__ void lru_unit(const P2Ctx& C, int sg, int n) {
    LAS unsigned char* lds = C.lds; const int tid = C.tid, lane = C.lane, wid = C.wid;
    const Args& a = *C.a;
    const bool smp = sg >= 8; const int b = smp ? sg - 8 : sg; const int S = smp ? DSEQ : SEQ; const size_t t0 = smp ? (size_t)(TP + b * DSEQ) : (size_t)(b * SEQ);
    LAS unsigned char* XC = lds;
    LAS float* AA = (LAS float*)(lds + 16384);
    LAS float* UU = (LAS float*)(lds + 49152);
    LAS float* SEG = (LAS float*)(lds + 81920);
    LAS float* CAR = (LAS float*)(lds + 86016);
    const int r32 = lane & 31, hi = lane >> 5, chb = wid & 3, tkb = wid >> 2;
    const int chl = chb * 32 + r32, chg = n * 128 + chl;
    const float ba = a.in[I_BRGA][chg], bx = a.in[I_BRGX][chg];
    const float sp8 = 8.0f * log1pf(expf(-a.in[I_RGL][chg]));
    const int cg = tid & 15;
    if (tid < 128) CAR[tid] = smp ? a.in[I_SLRU][b * 1024 + n * 128 + tid] : 0.f;
    const int nchunks = (S + 63) / 64;
    for (int ck = 0; ck < nchunks; ++ck) {
#pragma unroll
        for (int i = 0; i < 2; ++i) { const int tok = (tid >> 4) + 32 * i, tt = ck * 64 + tok;
            float xc[8];
            { const float* cbp = a.in[I_CONVB] + n * 128 + cg * 8; const f32x4 c0 = *(const f32x4*)cbp, c1 = *(const f32x4*)(cbp + 4);
              xc[0] = c0[0]; xc[1] = c0[1]; xc[2] = c0[2]; xc[3] = c0[3]; xc[4] = c1[0]; xc[5] = c1[1]; xc[6] = c1[2]; xc[7] = c1[3]; }
#pragma unroll
            for (int j = 0; j < 4; ++j) { const int ts = tt - 3 + j; float x[8]; float cw[8];
                { const float* cwp = a.in[I_CONVW] + j * 1024 + n * 128 + cg * 8; const f32x4 c0 = *(const f32x4*)cwp, c1 = *(const f32x4*)(cwp + 4);
                  cw[0] = c0[0]; cw[1] = c0[1]; cw[2] = c0[2]; cw[3] = c0[3]; cw[4] = c1[0]; cw[5] = c1[1]; cw[6] = c1[2]; cw[7] = c1[3]; }
                if (ts >= 0 && ts < S) { const u32x4 w = *(const u32x4*)(C.XB + (t0 + ts) * DM + n * 128 + cg * 8); unpack8(w, x); }
                else if (ts < 0 && smp) { const float* p = a.in[I_SCONV] + (size_t)(b * 3 + ts + 3) * DM + n * 128 + cg * 8; const f32x4 p0 = *(const f32x4*)p, p1 = *(const f32x4*)(p + 4);
                    x[0] = p0[0]; x[1] = p0[1]; x[2] = p0[2]; x[3] = p0[3]; x[4] = p1[0]; x[5] = p1[1]; x[6] = p1[2]; x[7] = p1[3]; }
                else {
#pragma unroll
                    for (int e = 0; e < 8; ++e) x[e] = 0.f; }
#pragma unroll
                for (int e = 0; e < 8; ++e) xc[e] += cw[e] * x[e]; }
            u32x4 w; w.x = pk_bf16(xc[0], xc[1]); w.y = pk_bf16(xc[2], xc[3]); w.z = pk_bf16(xc[4], xc[5]); w.w = pk_bf16(xc[6], xc[7]);
            *(LAS u32x4*)(XC + tok * 256 + ((cg ^ (tok & 15)) << 4)) = w; }
        __syncthreads();
        f32x16 da, dx;
#pragma unroll
        for (int r = 0; r < 16; ++r) { da[r] = 0.f; dx[r] = 0.f; }
        { const int tokA = tkb * 32 + r32;
          const bf16_t* wpa = C.WRG + ((size_t)n * 128 + chl) * 128 + hi * 8; const bf16_t* wpx = wpa + (size_t)8 * 128 * 128;
#pragma unroll
          for (int ks = 0; ks < 8; ++ks) { const bf16x8 xf = *(const LAS bf16x8*)(XC + tokA * 256 + (((2 * ks + hi) ^ (tokA & 15)) << 4));
              const bf16x8 wa = *(const bf16x8*)(wpa + ks * 16), wx = *(const bf16x8*)(wpx + ks * 16);
              da = MFMA32(xf, wa, da); dx = MFMA32(xf, wx, dx); } }
#pragma unroll
        for (int r = 0; r < 16; ++r) { const int tokl = tkb * 32 + crow(r, hi);
            const float xcv = bf2f(*(const LAS bf16_t*)(XC + tokl * 256 + ((((chl >> 3)) ^ (tokl & 15)) << 4) + (chl & 7) * 2));
            const float rg = sigmoidf_(da[r] + ba), ig = sigmoidf_(dx[r] + bx);
            const float log_a = -sp8 * rg;
            const float x2 = 2.0f * log_a;
            const float om = x2 > -0.25f ? -x2 * (1.0f + x2 * (0.5f + x2 * (0.16666667f + x2 * (0.041666668f + x2 * 0.0083333333f)))) : 1.0f - fexp2(x2 * LOG2E);
            float av = fexp2(log_a * LOG2E), uv = sqrtf(om) * (ig * xcv);
            if (ck * 64 + tokl >= S) { av = 1.0f; uv = 0.f; }
            AA[tokl * 128 + chl] = av; UU[tokl * 128 + chl] = uv; }
        __syncthreads();
        { const int c = tid & 127, seg = tid >> 7;
          float A = 1.f, B = 0.f;
#pragma unroll
          for (int t = 0; t < 16; ++t) { const int tok = seg * 16 + t; const float av = AA[tok * 128 + c], uv = UU[tok * 128 + c]; B = av * B + uv; A *= av; }
          SEG[(seg * 128 + c) * 2] = A; SEG[(seg * 128 + c) * 2 + 1] = B;
          __syncthreads();
          float hin = CAR[c];
          for (int s = 0; s < seg; ++s) hin = SEG[(s * 128 + c) * 2] * hin + SEG[(s * 128 + c) * 2 + 1];
          float hv = hin;
#pragma unroll
          for (int t = 0; t < 16; ++t) { const int tok = seg * 16 + t, tt = ck * 64 + tok; const float av = AA[tok * 128 + c], uv = UU[tok * 128 + c]; hv = av * hv + uv;
              if (tt < S) { const size_t off = (t0 + tt) * DM + n * 128 + c; const float gg = bf2f(C.GG[off]);
                  C.BO[off] = (bf16_t)(pk_bf16(hv * gg, 0.f) & 0xffffu); } }
          __syncthreads();
          if (seg == 3) CAR[c] = hv; }
    }
    __syncthreads();
    if (tid < 128) a.out[(smp ? O_HS : O_HP) + (size_t)b * 1024 + n * 128 + tid] = CAR[tid];
    __syncthreads();
}


__device__ __forceinline__ void lru_unit_p(const P2Ctx& C, int b, int n, int chq) {
    LAS unsigned char* lds = C.lds; const int tid = C.tid, lane = C.lane, wid = C.wid;
    const Args& a = *C.a;
    const size_t t0 = (size_t)(b * SEQ);
    LAS unsigned char* XC = lds;
    LAS float* AA = (LAS float*)(lds + 65536);
    LAS float* UU = (LAS float*)(lds + 98304);
    LAS float* SEG = (LAS float*)(lds + EXTRA_OFF + 9216);
    LAS float* CAR = (LAS float*)(lds + EXTRA_OFF + 13312);
    const int r32 = lane & 31, hi = lane >> 5;
    const int chl = chq * 32 + r32, chg = n * 128 + chl;
    const bf16_t* wpa = C.WRG + ((size_t)n * 128 + chl) * 128 + hi * 8; const bf16_t* wpx = wpa + (size_t)8 * 128 * 128;
    const float ba = a.in[I_BRGA][chg], bx = a.in[I_BRGX][chg];
    const float sp8 = 8.0f * log1pf(expf(-a.in[I_RGL][chg]));
    const int cg = tid & 15, run = tid >> 4;
    if (tid < 32) CAR[tid] = 0.f;
    for (int ck = 0; ck < 8; ++ck) {
        { float cw[4][8], cb8[8];
          { const float* cbp = a.in[I_CONVB] + n * 128 + cg * 8; const f32x4 c0 = *(const f32x4*)cbp, c1 = *(const f32x4*)(cbp + 4);
            cb8[0] = c0[0]; cb8[1] = c0[1]; cb8[2] = c0[2]; cb8[3] = c0[3]; cb8[4] = c1[0]; cb8[5] = c1[1]; cb8[6] = c1[2]; cb8[7] = c1[3]; }
#pragma unroll
          for (int j = 0; j < 4; ++j) { const float* cwp = a.in[I_CONVW] + j * 1024 + n * 128 + cg * 8; const f32x4 c0 = *(const f32x4*)cwp, c1 = *(const f32x4*)(cwp + 4);
              cw[j][0] = c0[0]; cw[j][1] = c0[1]; cw[j][2] = c0[2]; cw[j][3] = c0[3]; cw[j][4] = c1[0]; cw[j][5] = c1[1]; cw[j][6] = c1[2]; cw[j][7] = c1[3]; }
#pragma unroll
          for (int sr = 0; sr < 2; ++sr) { const int tk0 = run * 8 + sr * 4, tt0 = ck * 256 + tk0;
              u32x4 rows[7];
#pragma unroll
              for (int i = 0; i < 7; ++i) { const int ts = tt0 - 3 + i; rows[i] = ts >= 0 ? *(const u32x4*)(C.XB + (t0 + ts) * DM + n * 128 + cg * 8) : (u32x4){0u, 0u, 0u, 0u}; }
              float xc[4][8];
#pragma unroll
              for (int t = 0; t < 4; ++t)
#pragma unroll
                  for (int e = 0; e < 8; ++e) xc[t][e] = cb8[e];
#pragma unroll
              for (int i = 0; i < 7; ++i) { float x[8]; unpack8(rows[i], x);
#pragma unroll
                  for (int j = 0; j < 4; ++j) { const int t = i - j;
                      if (t >= 0 && t < 4) {
#pragma unroll
                          for (int e = 0; e < 8; ++e) xc[t][e] += cw[j][e] * x[e]; } } }
#pragma unroll
              for (int t = 0; t < 4; ++t) { const int tok = tk0 + t; u32x4 w; w.x = pk_bf16(xc[t][0], xc[t][1]); w.y = pk_bf16(xc[t][2], xc[t][3]); w.z = pk_bf16(xc[t][4], xc[t][5]); w.w = pk_bf16(xc[t][6], xc[t][7]);
                  *(LAS u32x4*)(XC + tok * 256 + ((cg ^ (tok & 15)) << 4)) = w; } } }
        bf16x8 wa[8], wx[8];
#pragma unroll
        for (int ks = 0; ks < 8; ++ks) { wa[ks] = *(const bf16x8*)(wpa + ks * 16); wx[ks] = *(const bf16x8*)(wpx + ks * 16); }
        __syncthreads();
        f32x16 da, dx;
#pragma unroll
        for (int r = 0; r < 16; ++r) { da[r] = 0.f; dx[r] = 0.f; }
        { const int tokA = wid * 32 + r32;
#pragma unroll
          for (int ks = 0; ks < 8; ++ks) { const bf16x8 xf = *(const LAS bf16x8*)(XC + tokA * 256 + (((2 * ks + hi) ^ (tokA & 15)) << 4));
              da = MFMA32(xf, wa[ks], da); dx = MFMA32(xf, wx[ks], dx); } }
#pragma unroll
        for (int r = 0; r < 16; ++r) { const int tokl = wid * 32 + crow(r, hi);
            const float xcv = bf2f(*(const LAS bf16_t*)(XC + tokl * 256 + (((chl >> 3) ^ (tokl & 15)) << 4) + (chl & 7) * 2));
            const float rg = sigmoidf_(da[r] + ba), ig = sigmoidf_(dx[r] + bx);
            const float log_a = -sp8 * rg;
            const float x2 = 2.0f * log_a;
            const float om = x2 > -0.25f ? -x2 * (1.0f + x2 * (0.5f + x2 * (0.16666667f + x2 * (0.041666668f + x2 * 0.0083333333f)))) : 1.0f - fexp2(x2 * LOG2E);
            AA[tokl * 32 + r32] = fexp2(log_a * LOG2E); UU[tokl * 32 + r32] = sqrtf(om) * (ig * xcv); }
        __syncthreads();
        { const int c = tid & 31, seg = tid >> 5;
          const size_t off0 = (t0 + ck * 256 + seg * 16) * DM + n * 128 + chq * 32 + c;
          bf16_t gg[16];
#pragma unroll
          for (int t = 0; t < 16; ++t) gg[t] = C.GG[off0 + (size_t)t * DM];
          float A = 1.f, B = 0.f;
#pragma unroll
          for (int t = 0; t < 16; ++t) { const int tok = seg * 16 + t; const float av = AA[tok * 32 + c], uv = UU[tok * 32 + c]; B = av * B + uv; A *= av; }
          SEG[(seg * 32 + c) * 2] = A; SEG[(seg * 32 + c) * 2 + 1] = B;
          __syncthreads();
          float hin = CAR[c];
          for (int s = 0; s < seg; ++s) hin = SEG[(s * 32 + c) * 2] * hin + SEG[(s * 32 + c) * 2 + 1];
          float hv = hin;
#pragma unroll
          for (int t = 0; t < 16; ++t) { const int tok = seg * 16 + t; const float av = AA[tok * 32 + c], uv = UU[tok * 32 + c]; hv = av * hv + uv;
              C.BO[off0 + (size_t)t * DM] = (bf16_t)(pk_bf16(hv * bf2f(gg[t]), 0.f) & 0xffffu); }
          __syncthreads();
          if (seg == 15) CAR[c] = hv; }
    }
    __syncthreads();
    if (tid < 32) a.out[O_HP + (size_t)b * 1024 + n * 128 + chq * 32 + tid] = CAR[tid];
    __syncthreads();
}

constexpr int P2_N_LRU_P = 256, P2_N_B = 128, P2_N_A = 1024, P2_N_CP = 512, P2_N_CS = 64, P2_N_LRU_S = 128;
constexpr int P2_NITEMS = P2_N_LRU_P + P2_N_B + P2_N_A + P2_N_CP + P2_N_CS + P2_N_LRU_S;
__device__ __forceinline__ void p2_mixers(const Args& a, LAS unsigned char* lds, int tid, int lane, int wid, int rep) {
    unsigned char* ws0 = a.ws;
    { LAS float* lut = (LAS float*)(lds + LUT_OFF);
      for (int e = tid; e < 8 * 256; e += 512) { const int h = e >> 8, rel = (e & 255) - 192; const int nn = rel < 0 ? -rel : rel;
          int bk = nn < 8 ? nn : (nn >= 91 ? 15 : nn >= 64 ? 14 : nn >= 46 ? 13 : nn >= 32 ? 12 : nn >= 23 ? 11 : nn >= 16 ? 10 : nn >= 12 ? 9 : 8);
          if (rel > 0) bk += 16;
          lut[e] = a.in[I_REL][bk * 8 + h] * LOG2E; }
      if (tid < 64) { float d1 = a.in[I_LQ1][tid] * a.in[I_LK1][tid], d2 = a.in[I_LQ2][tid] * a.in[I_LK2][tid]; d1 = wave_sum(d1); d2 = wave_sum(d2);
          if (tid == 0) *(LAS float*)(lds + LAM_OFF) = expf(d1) - expf(d2) + LAMBDA_INIT; } }
    __syncthreads();
    unsigned* queue = (unsigned*)(ws0 + WS_CTL) + CW_QUEUE + 64 * rep;
    volatile LAS unsigned* slot = (volatile LAS unsigned*)(lds + MISC_OFF + 64);
    for (;;) {
        if (tid == 0) *slot = __hip_atomic_fetch_add(queue, 1u, __ATOMIC_RELAXED, __HIP_MEMORY_SCOPE_AGENT);
        __syncthreads();
        int it = (int)*slot;
        __syncthreads();
        if (it >= P2_NITEMS) break;
        int tid_ = tid; asm volatile("" : "+v"(tid_));
        unsigned char* ws = ws0; asm volatile("" : "+s"(ws));
        P2Ctx C; C.a = &a; C.lds = lds; C.tid = tid_; C.lane = tid_ & 63; C.wid = __builtin_amdgcn_readfirstlane(tid_ >> 6);
        C.Q = (const bf16_t*)(ws + WS_Q); C.Kb = (const bf16_t*)(ws + WS_K); C.Vb = (const bf16_t*)(ws + WS_V); C.XB = (const bf16_t*)(ws + WS_XB); C.GG = (const bf16_t*)(ws + WS_GG);
        C.QC = (const bf16_t*)(ws + WS_QC); C.MK = (const bf16_t*)(ws + WS_MK); C.MV = (const bf16_t*)(ws + WS_MV); C.WRG = (const bf16_t*)(ws + WS_WRG);
        C.AO = (bf16_t*)(ws + WS_AO); C.BO = (bf16_t*)(ws + WS_BO); C.CO = (bf16_t*)(ws + WS_CO);
#ifndef UNIT_MASK
#define UNIT_MASK 0xFF
#endif
#ifndef DUPU
#define DUPU 0
#endif
        if (it < P2_N_LRU_P) { if (UNIT_MASK & 1) lru_unit_p(C, it >> 5, (it >> 2) & 7, it & 3); if (DUPU & 1) lru_unit_p(C, it >> 5, (it >> 2) & 7, it & 3); continue; } it -= P2_N_LRU_P;
        if (it < P2_N_B) { if (UNIT_MASK & 2) attnB_unit(C, it >> 3, it & 7); if (DUPU & 2) attnB_unit(C, it >> 3, it & 7); continue; } it -= P2_N_B;
        if (it < P2_N_A) { const int qb = 15 - (it >> 6), bh = it & 63; if (UNIT_MASK & 4) attnA_unit(C, bh >> 3, bh & 7, qb); if (DUPU & 4) attnA_unit(C, bh >> 3, bh & 7, qb); continue; } it -= P2_N_A;
        if (it < P2_N_CP) { const int qblk = it & 15, bh = it >> 4; if (UNIT_MASK & 8) attnC_unit<false>(C, bh >> 2, bh & 3, qblk); if (DUPU & 8) attnC_unit<false>(C, bh >> 2, bh & 3, qblk); continue; } it -= P2_N_CP;
        if (it < P2_N_CS) { if (UNIT_MASK & 16) attnC_unit<true>(C, it >> 2, it & 3, 0); continue; } it -= P2_N_CS;
        if (UNIT_MASK & 1) lru_unit(C, 8 + (it >> 3), it & 7);
    }
}

__device__ __forceinline__ void p7_final(const Args& a, int gw, int NGW, int lane) {
    const float* X2 = (const float*)(a.ws + WS_X1);
    const f32x4* gr = (const f32x4*)a.in[I_NFIN] + lane;
    for (int mrow = gw; mrow < TT; mrow += NGW) {
        const f32x4* xr = (const f32x4*)(X2 + (size_t)mrow * DM) + lane;
        f32x4 v[4]; float s = 0.f;
#pragma unroll
        for (int j = 0; j < 4; ++j) { v[j] = xr[64 * j]; s += (v[j].x * v[j].x + v[j].y * v[j].y) + (v[j].z * v[j].z + v[j].w * v[j].w); }
        const float rstd = 1.0f / sqrtf(wave_sum(s) * (1.0f / 1024.0f) + EPS);
        f32x4* o = (f32x4*)(a.out + (mrow < TP ? O_YP + (size_t)mrow * DM : O_YS + (size_t)(mrow - TP) * DM)) + lane;
#pragma unroll
        for (int j = 0; j < 4; ++j) { const f32x4 g = gr[64 * j]; o[64 * j] = v[j] * rstd * g; }
    }
}

constexpr int N_PHASES = 8;
__global__ void __launch_bounds__(NWAVES * 64, 2) fwd_kernel(Args args) {
    __shared__ __attribute__((aligned(16))) unsigned char lds_raw[LDS_BYTES];
    LAS unsigned char* lds = (LAS unsigned char*)lds_raw;
    const int tid = threadIdx.x, lane = tid & 63, wave = __builtin_amdgcn_readfirstlane(tid >> 6);
    const int G = gridDim.x, bx = blockIdx.x;
    const int vcu = (G % 8 == 0) ? (bx % 8) * (G / 8) + bx / 8 : bx;
    const int gw = vcu * NWAVES + wave, NGW = G * NWAVES;
    unsigned char* ws = args.ws;
    unsigned* ctl = (unsigned*)(ws + WS_CTL);
    for (int u = tid; u < (LDS_BYTES - EXTRA_OFF) / 4; u += NWAVES * 64) ((LAS unsigned*)(lds + EXTRA_OFF))[u] = 0u;
    __syncthreads();
    XcdBarrier bar; bar.bar = ctl + CW_BAR; bar.x = 0; bar.st = nullptr;
    if (MK_N_LAUNCHES == 1) bar = xcd_barrier_post(ctl + CW_BAR, (volatile LAS unsigned*)(lds + MISC_OFF + 32));
    const int lo = args.ph_lo, hi = args.ph_hi;
#ifndef PH_MASK
#define PH_MASK 0xFF
#endif
#define IN(k) (((PH_MASK >> (k)) & 1) && lo <= (k) && (k) < hi)
#define SEAM(k) do { if (IN(k) && IN((k) + 1)) xcd_barrier(bar); } while (0)

#ifndef DUP_MASK
#define DUP_MASK 0
#endif
#define PHASE(k, ...) do { if (IN(k)) { { const int rep_ = 0; (void)rep_; __VA_ARGS__ } if ((DUP_MASK >> (k)) & 1) { xcd_barrier(bar); { const int rep_ = 1; (void)rep_; __VA_ARGS__ } } } SEAM(k); } while (0)

    PHASE(0, p0_prologue(args, lds, gw, NGW, wave, lane); );
    PHASE(1,
        Sched1 S{(const char*)(ws + WS_XN), (const char*)(ws + WS_WCAT), G, bx};
        Epi1 E{(bf16_t*)(ws + WS_Q), (bf16_t*)(ws + WS_K), (bf16_t*)(ws + WS_V), (bf16_t*)(ws + WS_XB), (bf16_t*)(ws + WS_GG), (bf16_t*)(ws + WS_QC), (bf16_t*)(ws + WS_G),
               (bf16_t*)(ws + WS_MK), (bf16_t*)(ws + WS_MV), args.out, args.in[I_BGATE]};
        pg8::gemm_phase(lds, 1024, S, E); );
    PHASE(2, p2_mixers(args, lds, tid, lane, wave, rep_); );
    PHASE(3,
        Sched2 S{(const char*)(ws + WS_AO), (const char*)(ws + WS_BO), (const char*)(ws + WS_CO), (const char*)(ws + WS_WP), G, bx};
        Epi2 E{(const bf16_t*)(ws + WS_G), (bf16_t*)(ws + WS_MG)};
        pg8::gemm_phase(lds, 1024, S, E);
        Fin3 F{(bf16_t*)(ws + WS_MG)};
        tail_gemm<3>(lds, (const bf16_t*)(ws + WS_AO), (const bf16_t*)(ws + WS_BO), (const bf16_t*)(ws + WS_CO), (const bf16_t*)(ws + WS_WP), 1024, (const bf16_t*)(ws + WS_G), F, G, bx); );
    PHASE(4,
        SchedT S{(const char*)(ws + WS_MG), (const char*)(ws + WS_WO), 64, 4, 1024, G, bx};
        Epi3 E{args.in[I_XP], args.in[I_XS], (float*)(ws + WS_X1), (bf16_t*)(ws + WS_X1B), (float*)(ws + WS_SS)};
        pg8::gemm_phase(lds, 1024, S, E);
        Fin4 F{args.in[I_XS], (float*)(ws + WS_X1), (bf16_t*)(ws + WS_X1B), (float*)(ws + WS_SS)};
        tail_gemm<1>(lds, (const bf16_t*)(ws + WS_MG), nullptr, nullptr, (const bf16_t*)(ws + WS_WO), 1024, nullptr, F, G, bx); );
    PHASE(5,
        SchedT S{(const char*)(ws + WS_X1B), (const char*)(ws + WS_WFI), 66, 22, 1024, G, bx};
        Epi4 E{(const float*)(ws + WS_SS), (bf16_t*)(ws + WS_ACT)};
        pg8::gemm_phase(lds, 1024, S, E); );
    PHASE(6,
        SchedT S{(const char*)(ws + WS_ACT), (const char*)(ws + WS_WFO), 64, 4, DFF, G, bx};
        Epi5 E{(float*)(ws + WS_X1)};
        pg8::gemm_phase(lds, DFF, S, E);
        Fin6 F{(float*)(ws + WS_X1)};
        tail_gemm<1>(lds, (const bf16_t*)(ws + WS_ACT), nullptr, nullptr, (const bf16_t*)(ws + WS_WFO), DFF, nullptr, F, G, bx); );
    PHASE(7, p7_final(args, gw, NGW, lane); );
#undef PHASE
#undef IN
#undef SEAM
}

extern "C" void kernel_launch(void* const* d_in, const int* in_sizes, int n_in, void* d_out, int out_size, void* d_ws, size_t ws_size, hipStream_t stream) {
    static int grid = 0;
    if (grid == 0) {
        if (n_in != 36 || out_size != (int)O_END || ws_size < WS_END) { fprintf(stderr, "kernel_launch: unexpected problem (n_in %d, out %d, ws %zu); nothing launched\n", n_in, out_size, ws_size); grid = -1; return; }
        int dev = 0, cus = 0;
        if (hipGetDevice(&dev) != hipSuccess || hipDeviceGetAttribute(&cus, hipDeviceAttributeMultiprocessorCount, dev) != hipSuccess) { grid = -1; return; }
        int per_cu = 0;
        if (hipOccupancyMaxActiveBlocksPerMultiprocessor(&per_cu, (const void*)fwd_kernel, NWAVES * 64, 0) != hipSuccess || per_cu < 1)
            fprintf(stderr, "kernel_launch: note: occupancy query reports %d workgroups per CU\n", per_cu);
        (void)hipGetLastError();
        grid = cus;
    }
    if (grid < 0) return;
    (void)hipMemsetAsync((char*)d_ws + WS_CTL, 0, CTL_ZERO_BYTES, stream);
    Args a{};
    for (int i = 0; i < 36; ++i) a.in[i] = (const float*)d_in[i];
    a.out = (float*)d_out; a.ws = (unsigned char*)d_ws;
    if (MK_N_LAUNCHES == 1) { a.ph_lo = 0; a.ph_hi = N_PHASES; a.li = 0; hipLaunchKernelGGL(fwd_kernel, dim3(grid), dim3(NWAVES * 64), 0, stream, a); }
    else for (int li = 0; li < N_PHASES; ++li) { a.ph_lo = li; a.ph_hi = li + 1; a.li = li; hipLaunchKernelGGL(fwd_kernel, dim3(grid), dim3(NWAVES * 64), 0, stream, a); }
}
```

```cpp
#include <hip/hip_runtime.h>
#include <cstdio>
#include <cstdint>

#ifndef MK_N_LAUNCHES
#define MK_N_LAUNCHES 1
#endif

#define LAS __attribute__((address_space(3)))
#define GAS __attribute__((address_space(1)))
typedef unsigned short bf16_t;
typedef short bf16x8 __attribute__((ext_vector_type(8)));
typedef short s16x4 __attribute__((ext_vector_type(4)));
typedef float f32x2 __attribute__((ext_vector_type(2)));
typedef float f32x4 __attribute__((ext_vector_type(4)));
typedef float f32x16 __attribute__((ext_vector_type(16)));
typedef unsigned u32x2 __attribute__((ext_vector_type(2)));
typedef unsigned u32x4 __attribute__((ext_vector_type(4)));
typedef __bf16 bf16x2_t __attribute__((ext_vector_type(2)));

constexpr int DM = 1024, TP = 16384, TS = 512, TT = TP + TS, TMEM = 2048, TALL = TT + TMEM;
constexpr int SEQ = 2048, NBATCH = 8, DSEQ = 32, DBATCH = 16, PAST = 2048;
constexpr int INW = 6144, GATEW = 3072, DFF = 2816;
constexpr float EPS = 1e-6f;
constexpr float LOG2E = 1.4426950408889634f;
constexpr float QSCALE = 0.125f * LOG2E;
constexpr float CSCALE = 0.0625f * LOG2E;
constexpr float LAMBDA_INIT = 0.2f;

constexpr size_t O_YP = 0, O_YS = 16777216, O_KP = 17301504, O_VP = 34078720, O_CP = 50855936, O_HP = 50880512,
                 O_MKP = 50888704, O_MVP = 52985856, O_KS = 55083008, O_VS = 55607296, O_CS = 56131584, O_HS = 56180736, O_END = 56197120;

constexpr size_t MiB = 1u << 20;
constexpr size_t WS_CTL = 0, CTL_ZERO_BYTES = 1 * MiB;
constexpr size_t WS_WCAT = 1 * MiB;
constexpr size_t WS_WP = 23 * MiB;
constexpr size_t WS_WO = 29 * MiB;
constexpr size_t WS_WFI = 31 * MiB;
constexpr size_t WS_WFO = 42 * MiB;
constexpr size_t WS_WRG = 47 * MiB + 512 * 1024;
constexpr size_t WS_XN = 48 * MiB;
constexpr size_t WS_MK = 85 * MiB, WS_MV = 89 * MiB;
constexpr size_t WS_Q = 93 * MiB, WS_K = 126 * MiB, WS_V = 159 * MiB, WS_XB = 192 * MiB, WS_GG = 225 * MiB, WS_QC = 258 * MiB;
constexpr size_t WS_G = 291 * MiB;
constexpr size_t WS_AO = 390 * MiB, WS_BO = 423 * MiB, WS_CO = 456 * MiB;
constexpr size_t WS_MG = 48 * MiB;
constexpr size_t WS_X1B = 291 * MiB;
constexpr size_t WS_X1 = 192 * MiB;
constexpr size_t WS_ACT = 93 * MiB;
constexpr size_t WS_SS = 489 * MiB;
constexpr size_t WS_END = 491 * MiB;
constexpr int CW_BAR = 4096, CW_QUEUE = 16384;

constexpr int RING_BYTES = 131072, EXTRA_OFF = RING_BYTES, MISC_OFF = EXTRA_OFF + 320, LAM_OFF = EXTRA_OFF + 512, LUT_OFF = EXTRA_OFF + 1024;
constexpr int LDS_BYTES = 147456;
constexpr int NWAVES = 8;

__device__ __forceinline__ unsigned pk_bf16(float lo, float hi) { f32x2 v = {lo, hi}; bf16x2_t b = __builtin_convertvector(v, bf16x2_t); return __builtin_bit_cast(unsigned, b); }
__device__ __forceinline__ float bf_lo(unsigned u) { return __uint_as_float(u << 16); }
__device__ __forceinline__ float bf_hi(unsigned u) { return __uint_as_float(u & 0xffff0000u); }
__device__ __forceinline__ float bf2f(bf16_t v) { return __uint_as_float(((unsigned)v) << 16); }
__device__ __forceinline__ float fexp2(float x) { return __builtin_amdgcn_exp2f(x); }
__device__ __forceinline__ float frcp(float x) { return __builtin_amdgcn_rcpf(x); }
__device__ __forceinline__ float sigmoidf_(float x) { return frcp(1.0f + fexp2(-x * LOG2E)); }
__device__ __forceinline__ float gelu_tanh(float x) { const float z = 1.5957691216057308f * (x + 0.044715f * x * x * x); return x * frcp(1.0f + fexp2(-z * LOG2E)); }
__device__ __forceinline__ int crow(int r, int hi) { return (r & 3) + 8 * (r >> 2) + 4 * hi; }
__device__ __forceinline__ u32x4 pack8(f32x4 a, f32x4 b) { u32x4 w; w.x = pk_bf16(a[0], a[1]); w.y = pk_bf16(a[2], a[3]); w.z = pk_bf16(b[0], b[1]); w.w = pk_bf16(b[2], b[3]); return w; }
__device__ __forceinline__ void unpack8(u32x4 w, float* f) { f[0] = bf_lo(w.x); f[1] = bf_hi(w.x); f[2] = bf_lo(w.y); f[3] = bf_hi(w.y); f[4] = bf_lo(w.z); f[5] = bf_hi(w.z); f[6] = bf_lo(w.w); f[7] = bf_hi(w.w); }
__device__ __forceinline__ float wave_sum(float v) {
#pragma unroll
    for (int o = 1; o < 64; o <<= 1) v += __shfl_xor(v, o);
    return v;
}
__device__ __forceinline__ s16x4 vtr(const LAS unsigned char* p) { return __builtin_bit_cast(s16x4, __builtin_amdgcn_ds_read_tr16_b64_v4i16((LAS s16x4*)p)); }
#define MFMA32(a, b, c) __builtin_amdgcn_mfma_f32_32x32x16_bf16((a), (b), (c), 0, 0, 0)

namespace pg8 {
constexpr int BM = 256, BK = 64, HALF = 128, HTB = HALF * BK * 2, STAGE_BYTES = 8 * HTB, NXCD = 8, WGM = 8;
__host__ __device__ __forceinline__ int lds_byte(int r, int c) { const int st = (r >> 4) * 2 + (c >> 5), rr = r & 15, cc = c & 31, ob = rr * 64 + cc * 2; return st * 1024 + (ob ^ (((ob >> 9) & 1) << 5)); }
__host__ __device__ __forceinline__ void stage_rc(int b, int& R, int& C) { const int st = b / 1024, sb = b % 1024, swz = sb ^ (((sb >> 9) & 1) << 5); R = (st >> 1) * 16 + swz / 64; C = (st & 1) * 32 + (swz % 64) / 2; }
__host__ __device__ __forceinline__ int perm32(int rho) { const int n = rho >> 4, i = rho & 15; return 8 * (i >> 2) + 4 * n + (i & 3); }

struct Unit { const char* A; const char* B; int pm, pn, kind; };

__device__ __forceinline__ void tile_order(int L, int nM, int nN, int& pm, int& pn) {
    const int nwg = nM * nN; int wgid = L;
    { const int q = nwg / NXCD, r = nwg % NXCD, xcd = wgid % NXCD, off = wgid / NXCD; wgid = (xcd < r ? xcd * (q + 1) : r * (q + 1) + (xcd - r) * q) + off; }
    const int nig = WGM * nN, gid = wgid / nig, fm = gid * WGM, gsz = (nM - fm) < WGM ? (nM - fm) : WGM;
    pm = fm + ((wgid % nig) % gsz); pn = (wgid % nig) / gsz;
}

template <class Epi, class Sched>
__device__ __forceinline__ void gemm_phase(LAS unsigned char* lds, const int K, const Sched& S, const Epi& E) {
    const int tid = threadIdx.x, wid = __builtin_amdgcn_readfirstlane(tid >> 6), lane = tid & 63, wr = wid >> 2, wc = wid & 3, fr = lane & 15, fq = lane >> 4;
    const int nt = K / BK;
    unsigned voffA[2], voffB[2];
#pragma unroll
    for (int i = 0; i < 2; ++i) { int R, C; stage_rc(tid * 16 + i * 8192, R, C); const int Rb = (R & ~31) + perm32(R & 31);
        voffA[i] = (unsigned)(R * K + C) * 2u; voffB[i] = (unsigned)(Rb * K + C) * 2u; }
    const size_t kstep = (size_t)(BK * 2);
    const size_t hstep = (size_t)HALF * K * 2;
    const unsigned ldsw = (unsigned)wid * 1024u;
    const int aoff = lds_byte(wr * 64 + fr, fq * 8), boff = lds_byte(wc * 32 + fr, fq * 8);
#define PG8_SA(b, h) (((b) * 2 + (h)) * HTB)
#define PG8_SB(b, h) ((4 + (b) * 2 + (h)) * HTB)
#define PG8_STAGE(bufoff, gbase, voff) do { _Pragma("unroll") for (int _i = 0; _i < 2; ++_i) \
        __builtin_amdgcn_global_load_lds((const unsigned*)((const char*)(gbase) + (voff)[_i]), (LAS unsigned*)(lds + (bufoff) + ldsw + _i * 8192), 16, 0, 0); } while (0)
#define PG8_LDA(dst, b, h) do { _Pragma("unroll") for (int m = 0; m < 4; ++m) _Pragma("unroll") for (int k = 0; k < 2; ++k) dst[m][k] = *(const LAS bf16x8*)(lds + PG8_SA(b, h) + aoff + m * 2048 + k * 1024); } while (0)
#define PG8_LDB(dst, b, h) do { _Pragma("unroll") for (int n = 0; n < 2; ++n) _Pragma("unroll") for (int k = 0; k < 2; ++k) dst[n][k] = *(const LAS bf16x8*)(lds + PG8_SB(b, h) + boff + n * 2048 + k * 1024); } while (0)
#define PG8_MMA(ai, bj, At, Bt) do { __builtin_amdgcn_s_setprio(1); _Pragma("unroll") for (int m = 0; m < 4; ++m) _Pragma("unroll") for (int n = 0; n < 2; ++n) _Pragma("unroll") for (int k = 0; k < 2; ++k) \
        acc[ai][bj][m][n] = __builtin_amdgcn_mfma_f32_16x16x32_bf16(Bt[n][k], At[m][k], acc[ai][bj][m][n], 0, 0, 0); __builtin_amdgcn_s_setprio(0); } while (0)
#define PG8_WAIT_V(n) asm volatile("s_waitcnt vmcnt(" #n ")" ::: "memory")
#define PG8_WAIT_L(n) asm volatile("s_waitcnt lgkmcnt(" #n ")" ::: "memory")
#define PG8_BAR __builtin_amdgcn_s_barrier()
#define PG8_SCHED __builtin_amdgcn_sched_barrier(0)
#define PG8_ZERO() do { _Pragma("unroll") for (int a = 0; a < 2; ++a) _Pragma("unroll") for (int b = 0; b < 2; ++b) _Pragma("unroll") for (int m = 0; m < 4; ++m) _Pragma("unroll") for (int n = 0; n < 2; ++n) acc[a][b][m][n] = (f32x4){0.f, 0.f, 0.f, 0.f}; } while (0)
    Unit cur, nxt; int ui = 0;
    if (!S.next(0, cur)) return;
    f32x4 acc[2][2][4][2];
    PG8_ZERO();
    bf16x8 At[4][2], B0[2][2], B1[2][2];
    const char* cA = cur.A; const char* cB = cur.B;
    PG8_STAGE(PG8_SB(0, 0), cB, voffB); PG8_STAGE(PG8_SB(0, 1), cB + hstep, voffB); PG8_STAGE(PG8_SA(0, 0), cA, voffA); PG8_STAGE(PG8_SA(0, 1), cA + hstep, voffA);
    if (wr == 1) PG8_BAR;
    PG8_WAIT_V(2); PG8_BAR;
    PG8_STAGE(PG8_SB(1, 0), cB + kstep, voffB); PG8_STAGE(PG8_SA(1, 0), cA + kstep, voffA); PG8_STAGE(PG8_SB(1, 1), cB + hstep + kstep, voffB);
    PG8_WAIT_V(6); PG8_BAR;
    for (;;) {
        const bool has_next = S.next(ui + 1, nxt);
        const char* nA = has_next ? nxt.A : cA; const char* nB = has_next ? nxt.B : cB;
        for (int t = 0; t < nt; t += 2) {
            const bool last = (t == nt - 2);
            const char* a1 = cA + (size_t)(t + 1) * kstep;
            const char* a2 = last ? nA : cA + (size_t)(t + 2) * kstep; const char* b2 = last ? nB : cB + (size_t)(t + 2) * kstep;
            const char* a3 = a2 + kstep; const char* b3 = b2 + kstep;
            PG8_LDB(B0, 0, 0); PG8_LDB(B1, 0, 1); PG8_SCHED; PG8_LDA(At, 0, 0); PG8_STAGE(PG8_SA(1, 1), a1 + hstep, voffA);
            PG8_WAIT_V(8); PG8_WAIT_L(0); PG8_BAR; PG8_MMA(0, 0, At, B0); PG8_MMA(0, 1, At, B1); PG8_BAR; PG8_SCHED;
            PG8_LDA(At, 0, 1); PG8_STAGE(PG8_SB(0, 0), b2, voffB); PG8_STAGE(PG8_SB(0, 1), b2 + hstep, voffB); PG8_STAGE(PG8_SA(0, 0), a2, voffA);
            PG8_WAIT_V(8); PG8_WAIT_L(0); PG8_BAR; PG8_MMA(1, 0, At, B0); PG8_MMA(1, 1, At, B1); PG8_BAR; PG8_SCHED;
            PG8_LDB(B0, 1, 0); PG8_LDB(B1, 1, 1); PG8_SCHED; PG8_LDA(At, 1, 0); PG8_STAGE(PG8_SA(0, 1), a2 + hstep, voffA);
            PG8_WAIT_V(8); PG8_WAIT_L(0); PG8_BAR; PG8_MMA(0, 0, At, B0); PG8_MMA(0, 1, At, B1); PG8_BAR; PG8_SCHED;
            PG8_LDA(At, 1, 1); PG8_STAGE(PG8_SB(1, 0), b3, voffB); PG8_STAGE(PG8_SB(1, 1), b3 + hstep, voffB); PG8_STAGE(PG8_SA(1, 0), a3, voffA);
            PG8_WAIT_V(8); PG8_WAIT_L(0); PG8_BAR; PG8_MMA(1, 0, At, B0); PG8_MMA(1, 1, At, B1); PG8_BAR; PG8_SCHED;
        }
        if (wr == 0) PG8_BAR;
        const bool zero = E(acc, cur, wr, wc, fr, fq);
        if (!has_next) break;
        if (Epi::ZERO_AFTER || zero) PG8_ZERO();
        cur = nxt; cA = nA; cB = nB; ++ui;
        if (wr == 1) PG8_BAR;
    }
    PG8_WAIT_V(0);
    PG8_BAR;
#undef PG8_SA
#undef PG8_SB
#undef PG8_STAGE
#undef PG8_LDA
#undef PG8_LDB
#undef PG8_MMA
#undef PG8_WAIT_V
#undef PG8_WAIT_L
#undef PG8_BAR
#undef PG8_SCHED
#undef PG8_ZERO
}
}

#define TILE_FOR(...) \
    _Pragma("unroll") for (int ai = 0; ai < 2; ++ai) _Pragma("unroll") for (int m = 0; m < 4; ++m) { const int row = rowb + ai * 128 + m * 16; \
    _Pragma("unroll") for (int bj = 0; bj < 2; ++bj) { const int col = colb + bj * 128; f32x4& v0 = acc[ai][bj][m][0]; f32x4& v1 = acc[ai][bj][m][1]; __VA_ARGS__ } }

#define XB_TMO      128
#define XB_XCNT(j)  (256  + 64 * (j))
#define XB_XSUB(j)  (1280 + 64 * (j))
#define XB_XGEN(j)  (2304 + 64 * (j))
#define XB_TOP      3328
#define XB_TOPGEN   3392
#define XCD_BAR_WORDS 3456
#define XB_SPIN_CAP (1u << 18)
__device__ __forceinline__ unsigned xb_ld(unsigned* p)              { return __hip_atomic_load(p, __ATOMIC_RELAXED, __HIP_MEMORY_SCOPE_AGENT); }
__device__ __forceinline__ unsigned xb_add(unsigned* p, unsigned v) { return __hip_atomic_fetch_add(p, v, __ATOMIC_RELAXED, __HIP_MEMORY_SCOPE_AGENT); }
__device__ __forceinline__ unsigned xb_xcc_id() { return (unsigned)__builtin_amdgcn_s_getreg((3 << 11) | 20) & 0xFu; }
#define XB_SPIN(cond, bar) do { unsigned _sp = 0; while (cond) { __builtin_amdgcn_s_sleep(1); \
    if ((++_sp & 255u) == 0u) { if (xb_ld(&(bar)[XB_TMO])) break; if (_sp > XB_SPIN_CAP) { atomicAdd(&(bar)[XB_TMO], 1u); break; } } } } while (0)
struct XcdBarrier { unsigned* bar; unsigned x; volatile LAS unsigned* st; };
__device__ __forceinline__ XcdBarrier xcd_barrier_post(unsigned* bar, volatile LAS unsigned* st) {
    XcdBarrier b; b.bar = bar; b.x = xb_xcc_id(); b.st = st;
    if (threadIdx.x == 0) (void)xb_add(&bar[XB_XCNT(b.x)], 1u);
    return b;
}
__device__ __forceinline__ void xcd_barrier_complete(unsigned* bar, unsigned x, unsigned& nloc, unsigned& nx) {
    const unsigned G = gridDim.x * gridDim.y * gridDim.z;
    unsigned sum, cnt, mine, sp = 0u;
    for (;;) {
        sum = 0u; cnt = 0u; mine = 0u;
#pragma unroll
        for (unsigned j = 0; j < 16; ++j) { const unsigned c = xb_ld(&bar[XB_XCNT(j)]); sum += c; cnt += (c > 0u) ? 1u : 0u; mine = (j == x) ? c : mine; }
        if (sum == G) break;
        __builtin_amdgcn_s_sleep(1);
        if ((++sp & 255u) == 0u) { if (xb_ld(&bar[XB_TMO])) break; if (sp > XB_SPIN_CAP) { atomicAdd(&bar[XB_TMO], 1u); break; } }
    }
    nloc = mine > 0u ? mine : 1u; nx = cnt > 0u ? cnt : 1u;
}
__device__ __forceinline__ void xcd_barrier(const XcdBarrier& b) {
    asm volatile("s_waitcnt vmcnt(0)" ::: "memory");
    __syncthreads();
    if (threadIdx.x == 0) {
        unsigned* bar = b.bar;
        __builtin_amdgcn_s_waitcnt(0);
        unsigned nloc = b.st[0], nx = b.st[1];
        if (nloc == 0u) { xcd_barrier_complete(bar, b.x, nloc, nx); b.st[0] = nloc; b.st[1] = nx; }
        const unsigned old = xb_add(&bar[XB_XSUB(b.x)], 1u);
        const unsigned gen = old / nloc;
        if (old + 1u == (gen + 1u) * nloc) {
            __builtin_amdgcn_fence(__ATOMIC_RELEASE, "agent");
            asm volatile("s_waitcnt vmcnt(0)" ::: "memory");
            const unsigned og = xb_add(&bar[XB_TOP], 1u);
            const unsigned tg = og / nx;
            if (og + 1u == (tg + 1u) * nx) xb_add(&bar[XB_TOPGEN], 1u);
            else XB_SPIN(xb_ld(&bar[XB_TOPGEN]) == tg, bar);
            __builtin_amdgcn_fence(__ATOMIC_ACQUIRE, "agent");
            xb_add(&bar[XB_XGEN(b.x)], 1u);
            asm volatile("s_waitcnt vmcnt(0)" ::: "memory");
        } else {
            XB_SPIN(xb_ld(&bar[XB_XGEN(b.x)]) == gen, bar);
            __builtin_amdgcn_fence(__ATOMIC_ACQUIRE, "agent");
            asm volatile("s_waitcnt vmcnt(0)" ::: "memory");
        }
    }
    __syncthreads();
}

struct Args { const float* in[36]; float* out; unsigned char* ws; int ph_lo, ph_hi, li, pad; };
typedef const __attribute__((address_space(4))) Args CArgs;
#define KARGS() ({ CArgs* p_ = (CArgs*)__builtin_amdgcn_kernarg_segment_ptr(); asm volatile("" : "+s"(p_)); p_; })
enum { I_XP = 0, I_XS, I_MEM, I_CK, I_CV, I_SCONV, I_SLRU, I_CMK, I_CMV, I_REL, I_NMIX, I_WIN, I_LQ1, I_LK1, I_LQ2, I_LK2, I_SUBG, I_CONVW, I_CONVB,
       I_WRGA, I_BRGA, I_WRGX, I_BRGX, I_RGL, I_NMEM, I_WMEM, I_WPA, I_WPB, I_WPC, I_WGATE, I_BGATE, I_WOUT, I_NFFN, I_WFI, I_WFO, I_NFIN };

__device__ __forceinline__ void transpose_item(const float* W, int K, int N, bf16_t* WT, int kb, int nb, int dst_row0, const float* kscale, LAS float* scr, int lane) {
    const int k0 = 64 * kb, n0 = 32 * nb;
#pragma unroll 8
    for (int i = 0; i < 32; ++i) { const int kk = 2 * i + (lane >> 5); scr[kk * 33 + (lane & 31)] = W[(size_t)(k0 + kk) * N + n0 + (lane & 31)]; }
    asm volatile("s_waitcnt lgkmcnt(0)" ::: "memory");
    const int c = lane & 7;
    float sc[8];
#pragma unroll
    for (int e = 0; e < 8; ++e) sc[e] = kscale ? kscale[k0 + 8 * c + e] : 1.0f;
#pragma unroll
    for (int j = 0; j < 4; ++j) { const int n = (lane >> 3) + 8 * j; const LAS float* s = scr + (8 * c) * 33 + n;
        u32x4 o; o.x = pk_bf16(s[0 * 33] * sc[0], s[1 * 33] * sc[1]); o.y = pk_bf16(s[2 * 33] * sc[2], s[3 * 33] * sc[3]);
        o.z = pk_bf16(s[4 * 33] * sc[4], s[5 * 33] * sc[5]); o.w = pk_bf16(s[6 * 33] * sc[6], s[7 * 33] * sc[7]);
        *(u32x4*)(WT + (size_t)(dst_row0 + n) * K + k0 + 8 * c) = o; }
    asm volatile("s_waitcnt lgkmcnt(0)" ::: "memory");
}
__device__ __forceinline__ void norm_row_bf16(const float* xrow, const float* gain, bf16_t* orow, int lane) {
    const f32x4* xr = (const f32x4*)xrow + lane; const f32x4* gr = (const f32x4*)gain + lane;
    f32x4 v[4]; float s = 0.f;
#pragma unroll
    for (int j = 0; j < 4; ++j) { v[j] = xr[64 * j]; s += (v[j].x * v[j].x + v[j].y * v[j].y) + (v[j].z * v[j].z + v[j].w * v[j].w); }
    const float rstd = 1.0f / sqrtf(wave_sum(s) * (1.0f / 1024.0f) + EPS);
    u32x2* o8 = (u32x2*)orow + lane;
#pragma unroll
    for (int j = 0; j < 4; ++j) { const f32x4 g = gr[64 * j]; u32x2 w; w.x = pk_bf16(v[j].x * rstd * g.x, v[j].y * rstd * g.y); w.y = pk_bf16(v[j].z * rstd * g.z, v[j].w * rstd * g.w); o8[64 * j] = w; }
}
__device__ __forceinline__ void p0_prologue(CArgs& a, LAS unsigned char* lds, int gw, int NGW, int wave, int lane) {
    LAS float* scr = (LAS float*)(lds + wave * 16384);
    unsigned char* ws = a.ws;
    constexpr int I0 = 16 * 192, I1 = 16 * 96, I2 = 16 * 64, I3 = 16 * 32, I7 = 16 * 176, I8 = 44 * 32, I9 = 64;
    constexpr int NITEMS = I0 + I1 + I2 + 4 * I3 + I7 + I8 + 2 * I9;
    for (int it = gw; it < NITEMS; it += NGW) {
        int r = it;
        if (r < I0) { transpose_item(a.in[I_WIN], 1024, INW, (bf16_t*)(ws + WS_WCAT), r / 192, r % 192, 32 * (r % 192), nullptr, scr, lane); continue; } r -= I0;
        if (r < I1) { transpose_item(a.in[I_WGATE], 1024, GATEW, (bf16_t*)(ws + WS_WCAT), r / 96, r % 96, 6144 + 32 * (r % 96), nullptr, scr, lane); continue; } r -= I1;
        if (r < I2) { transpose_item(a.in[I_WMEM], 1024, 2048, (bf16_t*)(ws + WS_WCAT), r / 64, r % 64, 9216 + 32 * (r % 64), nullptr, scr, lane); continue; } r -= I2;
        if (r < I3) { transpose_item(a.in[I_WPA], 1024, 1024, (bf16_t*)(ws + WS_WP), r / 32, r % 32, 32 * (r % 32), nullptr, scr, lane); continue; } r -= I3;
        if (r < I3) { transpose_item(a.in[I_WPB], 1024, 1024, (bf16_t*)(ws + WS_WP), r / 32, r % 32, 1024 + 32 * (r % 32), nullptr, scr, lane); continue; } r -= I3;
        if (r < I3) { transpose_item(a.in[I_WPC], 1024, 1024, (bf16_t*)(ws + WS_WP), r / 32, r % 32, 2048 + 32 * (r % 32), nullptr, scr, lane); continue; } r -= I3;
        if (r < I3) { transpose_item(a.in[I_WOUT], 1024, 1024, (bf16_t*)(ws + WS_WO), r / 32, r % 32, 32 * (r % 32), nullptr, scr, lane); continue; } r -= I3;
        if (r < I7) { const int nb = r % 176, n0 = 32 * nb; const int ch0 = n0 < DFF ? n0 : n0 - DFF; const int dst = 256 * (ch0 / 128) + (n0 < DFF ? 0 : 128) + (ch0 % 128);
            transpose_item(a.in[I_WFI], 1024, 2 * DFF, (bf16_t*)(ws + WS_WFI), r / 176, nb, dst, a.in[I_NFFN], scr, lane); continue; } r -= I7;
        if (r < I8) { transpose_item(a.in[I_WFO], DFF, 1024, (bf16_t*)(ws + WS_WFO), r / 32, r % 32, 32 * (r % 32), nullptr, scr, lane); continue; } r -= I8;
        if (r < I9) { const int n = r / 8, s = r % 8;
          transpose_item(a.in[I_WRGA] + (size_t)n * 128 * 128, 128, 128, (bf16_t*)(ws + WS_WRG) + (size_t)n * 128 * 128, s / 4, s % 4, 32 * (s % 4), nullptr, scr, lane); continue; } r -= I9;
        { const int n = r / 8, s = r % 8;
          transpose_item(a.in[I_WRGX] + (size_t)n * 128 * 128, 128, 128, (bf16_t*)(ws + WS_WRG) + (size_t)(8 + n) * 128 * 128, s / 4, s % 4, 32 * (s % 4), nullptr, scr, lane); }
    }
    bf16_t* XN = (bf16_t*)(ws + WS_XN);
    for (int m = gw; m < TALL; m += NGW) {
        if (m < TP) norm_row_bf16(a.in[I_XP] + (size_t)m * DM, a.in[I_NMIX], XN + (size_t)m * DM, lane);
        else if (m < TT) norm_row_bf16(a.in[I_XS] + (size_t)(m - TP) * DM, a.in[I_NMIX], XN + (size_t)m * DM, lane);
        else norm_row_bf16(a.in[I_MEM] + (size_t)(m - TT) * DM, a.in[I_NMEM], XN + (size_t)m * DM, lane);
    }
}

struct Sched1 {
    const char* A; const char* B; int G, c;
    __device__ __forceinline__ bool next(int i, pg8::Unit& u) const {
        const int L = i * G + c;
        if (L < 66 * 36) { int pm, pn; pg8::tile_order(L, 66, 36, pm, pn); u.pm = pm; u.pn = pn; u.kind = pn >> 2;
            u.A = A + (size_t)pm * 256 * 1024 * 2; u.B = B + (size_t)pn * 256 * 1024 * 2; return true; }
        const int L2 = L - 66 * 36;
        if (L2 < 64) { int pm, pn; pg8::tile_order(L2, 8, 8, pm, pn); u.pm = pm; u.pn = pn; u.kind = 9;
            u.A = A + (size_t)(66 + pm) * 256 * 1024 * 2; u.B = B + (size_t)(36 + pn) * 256 * 1024 * 2; return true; }
        return false;
    }
};
struct Epi1 {
    static constexpr bool ZERO_AFTER = true;
    bf16_t *Q, *Kb, *Vb, *XB, *GG, *QC, *G, *MK, *MV; float* out; const float* bgate;
    __device__ __forceinline__ bool operator()(f32x4 (&acc)[2][2][4][2], const pg8::Unit& u, int wr, int wc, int fr, int fq) const {
        const int rowb = u.pm * 256 + wr * 64 + fr, colb = (u.pn & 3) * 256 + wc * 32 + 8 * fq;
        const int kind = u.kind;
        if (kind == 0) { TILE_FOR( *(u32x4*)(Q + (size_t)row * DM + col) = pack8(v0 * QSCALE, v1 * QSCALE); ) }
        else if (kind == 1 || kind == 2) {
            bf16_t* B = kind == 1 ? Kb : Vb; const size_t op = kind == 1 ? O_KP : O_VP, os = kind == 1 ? O_KS : O_VS;
            TILE_FOR( *(u32x4*)(B + (size_t)row * DM + col) = pack8(v0, v1);
                      float* o = out + (row < TP ? op + (size_t)row * DM : os + (size_t)(row - TP) * DM) + col; *(f32x4*)o = v0; *(f32x4*)(o + 4) = v1; ) }
        else if (kind == 3) {
            TILE_FOR( *(u32x4*)(XB + (size_t)row * DM + col) = pack8(v0, v1);
                      if (row < TP) { const int s = row & (SEQ - 1); if (s >= SEQ - 3) { float* o = out + O_CP + (size_t)((row >> 11) * 3 + (s - (SEQ - 3))) * DM + col; *(f32x4*)o = v0; *(f32x4*)(o + 4) = v1; } }
                      else { const int rs = row - TP, s = rs & (DSEQ - 1); if (s >= DSEQ - 3) { float* o = out + O_CS + (size_t)((rs >> 5) * 3 + (s - (DSEQ - 3))) * DM + col; *(f32x4*)o = v0; *(f32x4*)(o + 4) = v1; } } ) }
        else if (kind == 4) {
            TILE_FOR( f32x4 g0, g1;
                      _Pragma("unroll") for (int j = 0; j < 4; ++j) { g0[j] = gelu_tanh(v0[j]); g1[j] = gelu_tanh(v1[j]); }
                      *(u32x4*)(GG + (size_t)row * DM + col) = pack8(g0, g1); ) }
        else if (kind == 5) { TILE_FOR( *(u32x4*)(QC + (size_t)row * DM + col) = pack8(v0 * CSCALE, v1 * CSCALE); ) }
        else if (kind <= 8) {
            const int gofs = (kind - 6) * 1024;
            TILE_FOR( const f32x4 b0 = *(const f32x4*)(bgate + gofs + col); const f32x4 b1 = *(const f32x4*)(bgate + gofs + col + 4); f32x4 g0, g1;
                      _Pragma("unroll") for (int j = 0; j < 4; ++j) { g0[j] = sigmoidf_(v0[j] + b0[j]); g1[j] = sigmoidf_(v1[j] + b1[j]); }
                      *(u32x4*)(G + (size_t)row * GATEW + gofs + col) = pack8(g0, g1); ) }
        else {
            bf16_t* B = u.pn < 4 ? MK : MV; const size_t ob = u.pn < 4 ? O_MKP : O_MVP;
            TILE_FOR( *(u32x4*)(B + (size_t)row * DM + col) = pack8(v0, v1);
                      float* o = out + ob + (size_t)row * DM + col; *(f32x4*)o = v0; *(f32x4*)(o + 4) = v1; ) }
        return true;
    }
};

struct Sched2 {
    const char* A0; const char* A1; const char* A2; const char* B; int G, c;
    __device__ __forceinline__ bool next(int i, pg8::Unit& u) const {
        const int j = i / 3, br = i - 3 * j; const int L = j * G + c;
        if (L >= 64 * 4) return false;
        int pm, pn; pg8::tile_order(L, 64, 4, pm, pn); u.pm = pm; u.pn = pn; u.kind = br;
        u.A = (br == 0 ? A0 : br == 1 ? A1 : A2) + (size_t)pm * 256 * 1024 * 2; u.B = B + (size_t)(br * 1024 + pn * 256) * 1024 * 2; return true;
    }
};
struct Epi2 {
    static constexpr bool ZERO_AFTER = false;
    const bf16_t* G; bf16_t* MG;
    __device__ __forceinline__ bool operator()(f32x4 (&acc)[2][2][4][2], const pg8::Unit& u, int wr, int wc, int fr, int fq) const {
        const int rowb = u.pm * 256 + wr * 64 + fr, colb = u.pn * 256 + wc * 32 + 8 * fq;
        const int br = u.kind; const bool last = br == 2;
        TILE_FOR( const bf16_t* gp = G + (size_t)row * GATEW + br * 1024 + col;
                  const u32x4 gc = *(const u32x4*)gp; const u32x4 gn = *(const u32x4*)(gp + 1024);
                  float c[8], n[8]; unpack8(gc, c); unpack8(gn, n); f32x4 o0, o1;
                  _Pragma("unroll") for (int j = 0; j < 8; ++j) { c[j] = fmaxf(c[j], 1e-30f); n[j] = last ? 1.0f : fmaxf(n[j], 1e-30f); }
                  _Pragma("unroll") for (int j = 0; j < 4; ++j) { v0[j] *= c[j] * frcp(n[j]); v1[j] *= c[4 + j] * frcp(n[4 + j]); }
                  _Pragma("unroll") for (int j = 0; j < 4; ++j) { o0[j] = v0[j] * n[j]; o1[j] = v1[j] * n[4 + j]; }
                  *(u32x4*)(MG + (size_t)row * DM + col) = pack8(o0, o1);
                  if (bj == 1) asm volatile("" ::: "memory"); )
        return last;
    }
};

struct SchedT {
    const char* A; const char* B; int nM, nN, K, G, c;
    __device__ __forceinline__ bool next(int i, pg8::Unit& u) const {
        const int L = i * G + c; if (L >= nM * nN) return false;
        int pm, pn; pg8::tile_order(L, nM, nN, pm, pn); u.pm = pm; u.pn = pn; u.kind = 0;
        u.A = A + (size_t)pm * 256 * K * 2; u.B = B + (size_t)pn * 256 * K * 2; return true;
    }
};
struct Epi3 {
    static constexpr bool ZERO_AFTER = true;
    const float* xp; const float* xs; float* X1; bf16_t* X1B; float* SS;
    __device__ __forceinline__ bool operator()(f32x4 (&acc)[2][2][4][2], const pg8::Unit& u, int wr, int wc, int fr, int fq) const {
        const int rowb = u.pm * 256 + wr * 64 + fr, colb = u.pn * 256 + wc * 32 + 8 * fq;
#pragma unroll
        for (int ai = 0; ai < 2; ++ai)
#pragma unroll
            for (int m = 0; m < 4; ++m) { const int row = rowb + ai * 128 + m * 16; float ss = 0.f;
                const float* xr = row < TP ? xp + (size_t)row * DM : xs + (size_t)(row - TP) * DM;
#pragma unroll
                for (int bj = 0; bj < 2; ++bj) { const int col = colb + bj * 128;
                    const f32x4 a0 = acc[ai][bj][m][0] + *(const f32x4*)(xr + col), a1 = acc[ai][bj][m][1] + *(const f32x4*)(xr + col + 4);
                    *(f32x4*)(X1 + (size_t)row * DM + col) = a0; *(f32x4*)(X1 + (size_t)row * DM + col + 4) = a1;
                    *(u32x4*)(X1B + (size_t)row * DM + col) = pack8(a0, a1);
                    ss += (a0[0] * a0[0] + a0[1] * a0[1]) + (a0[2] * a0[2] + a0[3] * a0[3]) + (a1[0] * a1[0] + a1[1] * a1[1]) + (a1[2] * a1[2] + a1[3] * a1[3]); }
                ss += __shfl_xor(ss, 16); ss += __shfl_xor(ss, 32);
                if (fq == 0) SS[(size_t)row * 16 + u.pn * 4 + wc] = ss; }
        return true;
    }
};
struct Epi4 {
    static constexpr bool ZERO_AFTER = true;
    const float* SS; bf16_t* ACT;
    __device__ __forceinline__ bool operator()(f32x4 (&acc)[2][2][4][2], const pg8::Unit& u, int wr, int wc, int fr, int fq) const {
        const int rowb = u.pm * 256 + wr * 64 + fr, colb = u.pn * 128 + wc * 32 + 8 * fq;
#pragma unroll
        for (int ai = 0; ai < 2; ++ai)
#pragma unroll
            for (int m = 0; m < 4; ++m) { const int row = rowb + ai * 128 + m * 16;
                const f32x4 p = *(const f32x4*)(SS + (size_t)row * 16 + 4 * fq); float s = (p[0] + p[1]) + (p[2] + p[3]);
                s += __shfl_xor(s, 16); s += __shfl_xor(s, 32);
                const float rstd = 1.0f / sqrtf(s * (1.0f / 1024.0f) + EPS);
                f32x4 o0, o1;
#pragma unroll
                for (int j = 0; j < 4; ++j) { const float g0 = acc[ai][0][m][0][j] * rstd, u0 = acc[ai][1][m][0][j] * rstd, g1 = acc[ai][0][m][1][j] * rstd, u1 = acc[ai][1][m][1][j] * rstd;
                    o0[j] = g0 * sigmoidf_(g0) * u0; o1[j] = g1 * sigmoidf_(g1) * u1; }
                *(u32x4*)(ACT + (size_t)row * DFF + colb) = pack8(o0, o1); }
        return true;
    }
};
struct Epi5 {
    static constexpr bool ZERO_AFTER = true;
    float* X1;
    __device__ __forceinline__ bool operator()(f32x4 (&acc)[2][2][4][2], const pg8::Unit& u, int wr, int wc, int fr, int fq) const {
        const int rowb = u.pm * 256 + wr * 64 + fr, colb = u.pn * 256 + wc * 32 + 8 * fq;
        TILE_FOR( float* p = X1 + (size_t)row * DM + col; const f32x4 a0 = v0 + *(const f32x4*)p, a1 = v1 + *(const f32x4*)(p + 4); *(f32x4*)p = a0; *(f32x4*)(p + 4) = a1; )
        return true;
    }
};


template <int NSEG, class Fin>
__device__ __forceinline__ void tail_gemm(LAS unsigned char* lds, const bf16_t* A0, const bf16_t* A1, const bf16_t* A2, const bf16_t* Bt, const int Kseg, const bf16_t* G, const Fin& fin, int G_, int bx) {
    const int tid = threadIdx.x, wid = __builtin_amdgcn_readfirstlane(tid >> 6), lane = tid & 63, fr = lane & 15, fq = lane >> 4;
    const int ksl = Kseg / 8, kbase = wid * ksl;
    LAS float* part = (LAS float*)lds;
    for (int tile = bx; tile < 256; tile += G_) {
        const int rt = tile >> 4, ct = tile & 15, r0 = TP + rt * 32, c0 = ct * 64;
        f32x4 tot[2][4];
#pragma unroll
        for (int m = 0; m < 2; ++m)
#pragma unroll
            for (int n = 0; n < 4; ++n) tot[m][n] = (f32x4){0.f, 0.f, 0.f, 0.f};
#pragma unroll
        for (int seg = 0; seg < NSEG; ++seg) {
            const bf16_t* A = seg == 0 ? A0 : seg == 1 ? A1 : A2;
            f32x4 acc[2][4];
#pragma unroll
            for (int m = 0; m < 2; ++m)
#pragma unroll
                for (int n = 0; n < 4; ++n) acc[m][n] = (f32x4){0.f, 0.f, 0.f, 0.f};
            const bf16_t* ap = A + (size_t)(r0 + fr) * Kseg + kbase + 8 * fq;
            const bf16_t* wp = Bt + (size_t)(seg * 1024 + c0 + fr) * Kseg + kbase + 8 * fq;
#pragma unroll 4
            for (int kk = 0; kk < ksl; kk += 32) {
                bf16x8 af[2], wf[4];
#pragma unroll
                for (int m = 0; m < 2; ++m) af[m] = *(const bf16x8*)(ap + (size_t)(16 * m) * Kseg + kk);
#pragma unroll
                for (int n = 0; n < 4; ++n) wf[n] = *(const bf16x8*)(wp + (size_t)(16 * n) * Kseg + kk);
#pragma unroll
                for (int m = 0; m < 2; ++m)
#pragma unroll
                    for (int n = 0; n < 4; ++n) acc[m][n] = __builtin_amdgcn_mfma_f32_16x16x32_bf16(wf[n], af[m], acc[m][n], 0, 0, 0);
            }
            if (G) {
#pragma unroll
                for (int m = 0; m < 2; ++m)
#pragma unroll
                    for (int n = 0; n < 4; ++n) { const u32x2 g = *(const u32x2*)(G + (size_t)(r0 + 16 * m + fr) * GATEW + seg * 1024 + c0 + 16 * n + 4 * fq);
                        tot[m][n][0] += acc[m][n][0] * bf_lo(g.x); tot[m][n][1] += acc[m][n][1] * bf_hi(g.x); tot[m][n][2] += acc[m][n][2] * bf_lo(g.y); tot[m][n][3] += acc[m][n][3] * bf_hi(g.y); }
            } else {
#pragma unroll
                for (int m = 0; m < 2; ++m)
#pragma unroll
                    for (int n = 0; n < 4; ++n) tot[m][n] += acc[m][n];
            }
        }
#pragma unroll
        for (int m = 0; m < 2; ++m)
#pragma unroll
            for (int n = 0; n < 4; ++n) *(LAS f32x4*)(part + wid * 2048 + (16 * m + fr) * 64 + 16 * n + 4 * fq) = tot[m][n];
        __syncthreads();
        { const int row = tid >> 4, c4 = tid & 15;
          f32x4 v = *(const LAS f32x4*)(part + row * 64 + c4 * 4);
#pragma unroll
          for (int w = 1; w < 8; ++w) v += *(const LAS f32x4*)(part + w * 2048 + row * 64 + c4 * 4);
          fin(r0 + row, c0 + c4 * 4, v, ct); }
        __syncthreads();
    }
}
struct Fin3 { bf16_t* MG;
    __device__ __forceinline__ void operator()(int row, int col, f32x4 v, int) const { u32x2 w; w.x = pk_bf16(v[0], v[1]); w.y = pk_bf16(v[2], v[3]); *(u32x2*)(MG + (size_t)row * DM + col) = w; } };
struct Fin4 { const float* xs; float* X1; bf16_t* X1B; float* SS;
    __device__ __forceinline__ void operator()(int row, int col, f32x4 v, int ct) const {
        const f32x4 a = v + *(const f32x4*)(xs + (size_t)(row - TP) * DM + col);
        *(f32x4*)(X1 + (size_t)row * DM + col) = a; u32x2 w; w.x = pk_bf16(a[0], a[1]); w.y = pk_bf16(a[2], a[3]); *(u32x2*)(X1B + (size_t)row * DM + col) = w;
        float ss = (a[0] * a[0] + a[1] * a[1]) + (a[2] * a[2] + a[3] * a[3]);
        ss += __shfl_xor(ss, 1); ss += __shfl_xor(ss, 2); ss += __shfl_xor(ss, 4); ss += __shfl_xor(ss, 8);
        if ((threadIdx.x & 15) == 0) SS[(size_t)row * 16 + ct] = ss; } };
struct Fin6 { float* X1;
    __device__ __forceinline__ void operator()(int row, int col, f32x4 v, int) const { float* p = X1 + (size_t)row * DM + col; *(f32x4*)p = v + *(const f32x4*)p; } };

struct P2Ctx {
    CArgs* a; LAS unsigned char* lds; int tid, lane, wid;
    const bf16_t *Q, *Kb, *Vb, *XB, *GG, *QC, *MK, *MV, *WRG; bf16_t *AO, *BO, *CO;
};
template <int NB>
__device__ __forceinline__ float softmax_step(f32x16 (&s)[NB], float& m, float& l) {
    float mx = s[0][0];
#pragma unroll
    for (int b = 0; b < NB; ++b)
#pragma unroll
        for (int r = 0; r < 16; ++r) mx = fmaxf(mx, s[b][r]);
    mx = fmaxf(mx, __shfl_xor(mx, 32));
    const float mn = fmaxf(m, mx), alpha = fexp2(m - mn);
    float ps = 0.f;
#pragma unroll
    for (int b = 0; b < NB; ++b)
#pragma unroll
        for (int r = 0; r < 16; ++r) { const float p = fexp2(s[b][r] - mn); s[b][r] = p; ps += p; }
    l = l * alpha + ps; m = mn;
    return alpha;
}
__device__ __forceinline__ bf16x8 pack_p(const f32x16& s, int h) {
    u32x4 w; w.x = pk_bf16(s[8 * h + 0], s[8 * h + 1]); w.y = pk_bf16(s[8 * h + 2], s[8 * h + 3]); w.z = pk_bf16(s[8 * h + 4], s[8 * h + 5]); w.w = pk_bf16(s[8 * h + 6], s[8 * h + 7]);
    return __builtin_bit_cast(bf16x8, w);
}
__device__ __forceinline__ bf16x8 v_frag(const LAS unsigned char* vimg, int ncb, int s, int cb, int lane) {
    const int hi = lane >> 5, g16 = (lane >> 4) & 1, i = lane & 15;
    const LAS unsigned char* p = vimg + ((2 * s) * ncb + cb) * 512 + (4 * hi + (i >> 2)) * 64 + g16 * 32 + (i & 3) * 8;
    const s16x4 lo = vtr(p), hv = vtr(p + ncb * 512);
    return (bf16x8){lo[0], lo[1], lo[2], lo[3], hv[0], hv[1], hv[2], hv[3]};
}
template <int NCB>
__device__ __forceinline__ void v_frags_asm(const LAS unsigned char* vimg, int cb, int lane, bf16x8 (&vf)[4]) {
    const int hi = lane >> 5, g16 = (lane >> 4) & 1, i = lane & 15;
    const unsigned a = (unsigned)(unsigned long long)(vimg + cb * 512 + (4 * hi + (i >> 2)) * 64 + g16 * 32 + (i & 3) * 8);
    s16x4 lo[4], hv[4];
#define VTR_(dst, off) asm volatile("ds_read_b64_tr_b16 %0, %1 offset:%2" : "=&v"(dst) : "v"(a), "i"(off) : "memory")
    VTR_(lo[0], 0 * NCB * 512); VTR_(hv[0], 1 * NCB * 512); VTR_(lo[1], 2 * NCB * 512); VTR_(hv[1], 3 * NCB * 512);
    VTR_(lo[2], 4 * NCB * 512); VTR_(hv[2], 5 * NCB * 512); VTR_(lo[3], 6 * NCB * 512); VTR_(hv[3], 7 * NCB * 512);
#undef VTR_
    asm volatile("s_waitcnt lgkmcnt(0)" : "+v"(lo[0]), "+v"(hv[0]), "+v"(lo[1]), "+v"(hv[1]), "+v"(lo[2]), "+v"(hv[2]), "+v"(lo[3]), "+v"(hv[3]) :: "memory");
    __builtin_amdgcn_sched_barrier(0);
#pragma unroll
    for (int ks = 0; ks < 4; ++ks) vf[ks] = (bf16x8){lo[ks][0], lo[ks][1], lo[ks][2], lo[ks][3], hv[ks][0], hv[ks][1], hv[ks][2], hv[ks][3]};
}
__device__ __forceinline__ void subln_store(f32x16 (&o)[4], const float* subg, bf16_t* dst  , int lane) {
    const int hi = lane >> 5;
    float ss = 0.f;
#pragma unroll
    for (int cb = 0; cb < 4; ++cb)
#pragma unroll
        for (int r = 0; r < 16; ++r) ss += o[cb][r] * o[cb][r];
    ss += __shfl_xor(ss, 32);
    const float rstd = (1.0f - LAMBDA_INIT) / sqrtf(ss * (1.0f / 128.0f) + EPS);
#pragma unroll
    for (int cb = 0; cb < 4; ++cb)
#pragma unroll
        for (int g = 0; g < 4; ++g) { const int dv0 = 32 * cb + 8 * g + 4 * hi; const f32x4 sg = *(const f32x4*)(subg + dv0);
            u32x2 w; w.x = pk_bf16(o[cb][4 * g + 0] * rstd * sg[0], o[cb][4 * g + 1] * rstd * sg[1]); w.y = pk_bf16(o[cb][4 * g + 2] * rstd * sg[2], o[cb][4 * g + 3] * rstd * sg[3]);
            *(u32x2*)(dst + dv0) = w; }
}

constexpr float ATHR = 8.0f;
__device__ __forceinline__ void attnA_unit(const P2Ctx& C, int b, int h, int qb) {
    LAS unsigned char* lds = C.lds; const int lane = C.lane, wid = C.wid;
    const int comp = wid >> 2, qs = wid & 3, r32 = lane & 31, hi = lane >> 5;
    const int q0 = qb * 128, trow0 = b * SEQ;
    const int qpos = q0 + qs * 32 + r32; const size_t qrow = (size_t)(trow0 + qpos);
    const int qcw = (q0 + qs * 32) >> 6, ntw = qcw + 1, NT = 2 * qb + 2;
    const LAS float* lut = (const LAS float*)(lds + LUT_OFF) + h * 256;
    const float lam = *(const LAS float*)(lds + LAM_OFF);
    bf16x8 qf[4];
#pragma unroll
    for (int ds = 0; ds < 4; ++ds) qf[ds] = *(const bf16x8*)(C.Q + qrow * DM + h * 128 + comp * 64 + ds * 16 + hi * 8);
    const int kkey = 8 * wid + (lane >> 3), kchs = (lane & 7) ^ ((kkey >> 1) & 7);
    const bf16_t* ksrc = C.Kb + ((size_t)trow0 + kkey) * DM + h * 128 + kchs * 8;
    const bf16_t* vsrc[2];
#pragma unroll
    for (int i = 0; i < 2; ++i) { const int p = 2 * wid + i, kg = p >> 1, cbv = 2 * (p & 1) + (lane >> 5), vkey = kg * 8 + ((lane >> 2) & 7), vch = cbv * 4 + (lane & 3);
        vsrc[i] = C.Vb + ((size_t)trow0 + vkey) * DM + h * 128 + vch * 8; }
#define A_DMA(kt) do { LAS unsigned char* sb_ = lds + ((kt) & 3) * 32768; const size_t go_ = (size_t)(kt) * 64 * DM; \
        __builtin_amdgcn_global_load_lds((const unsigned*)(ksrc + go_), (LAS unsigned*)(sb_ + wid * 1024), 16, 0, 0); \
        __builtin_amdgcn_global_load_lds((const unsigned*)(ksrc + go_ + 64), (LAS unsigned*)(sb_ + 8192 + wid * 1024), 16, 0, 0); \
        __builtin_amdgcn_global_load_lds((const unsigned*)(vsrc[0] + go_), (LAS unsigned*)(sb_ + 16384 + (2 * wid) * 1024), 16, 0, 0); \
        __builtin_amdgcn_global_load_lds((const unsigned*)(vsrc[1] + go_), (LAS unsigned*)(sb_ + 16384 + (2 * wid + 1) * 1024), 16, 0, 0); } while (0)
#define A_WAITBAR(ahead) do { if ((ahead) >= 2) asm volatile("s_waitcnt vmcnt(8)" ::: "memory"); else if ((ahead) == 1) asm volatile("s_waitcnt vmcnt(4)" ::: "memory"); else asm volatile("s_waitcnt vmcnt(0)" ::: "memory"); \
        __builtin_amdgcn_s_barrier(); asm volatile("" ::: "memory"); } while (0)
    f32x16 o[4];
#pragma unroll
    for (int cb = 0; cb < 4; ++cb)
#pragma unroll
        for (int r = 0; r < 16; ++r) o[cb][r] = 0.f;
    float mhat = 0.f, l = 0.f;
    bf16x8 pf[4];
#pragma unroll
    for (int i = 0; i < 4; ++i) pf[i] = (bf16x8){0, 0, 0, 0, 0, 0, 0, 0};
#define A_PV(kt) do { const LAS unsigned char* vimg_ = lds + ((kt) & 3) * 32768 + 16384; \
        _Pragma("unroll") for (int cb = 0; cb < 4; ++cb) { bf16x8 vf[4]; v_frags_asm<4>(vimg_, cb, lane, vf); \
            _Pragma("unroll") for (int ks = 0; ks < 4; ++ks) o[cb] = MFMA32(vf[ks], pf[ks], o[cb]); } } while (0)
    A_DMA(0); A_DMA(1);
    A_WAITBAR(1);
    for (int kt = 0; kt < NT; ++kt) {
        if (kt + 2 < NT) A_DMA(kt + 2);
        if (comp == 1 && kt >= 1 && kt - 1 < ntw) A_PV(kt - 1);
        if (kt < ntw) {
            const LAS unsigned char* sb = lds + (kt & 3) * 32768;
            const LAS unsigned char* kb = sb + comp * 8192;
            const int relmax = kt * 64 + 63 - (q0 + qs * 32);
            const bool far = (relmax + 192 <= 0);
            f32x16 s[2];
            { const float c0 = (far ? lut[0] : 0.f) - mhat;
#pragma unroll
              for (int kb2 = 0; kb2 < 2; ++kb2)
#pragma unroll
                  for (int r = 0; r < 16; ++r) s[kb2][r] = c0; }
#pragma unroll
            for (int ds = 0; ds < 4; ++ds)
#pragma unroll
                for (int kb2 = 0; kb2 < 2; ++kb2) { const int key = kb2 * 32 + r32, ch = 2 * ds + hi;
                    const bf16x8 kf = *(const LAS bf16x8*)(kb + key * 128 + ((ch ^ ((key >> 1) & 7)) << 4));
                    s[kb2] = MFMA32(kf, qf[ds], s[kb2]); }
            if (!far) {
#pragma unroll
                for (int kb2 = 0; kb2 < 2; ++kb2)
#pragma unroll
                    for (int r = 0; r < 16; ++r) { const int rel = kt * 64 + kb2 * 32 + crow(r, hi) - qpos; const int idx = rel + 192 > 0 ? rel + 192 : 0; s[kb2][r] += lut[idx]; }
            }
            float mx = fmaxf(s[0][0], s[1][0]);
#pragma unroll
            for (int r = 1; r < 16; ++r) mx = fmaxf(fmaxf(mx, s[0][r]), s[1][r]);
            mx = fmaxf(mx, __shfl_xor(mx, 32));
            if (kt == 0 || __any(mx > ATHR)) {
                const float dl = kt == 0 ? mx : fmaxf(mx, 0.f);
                mhat += dl;
                const float f = kt == 0 ? 1.0f : fexp2(-dl); l *= f;
#pragma unroll
                for (int kb2 = 0; kb2 < 2; ++kb2)
#pragma unroll
                    for (int r = 0; r < 16; ++r) s[kb2][r] -= dl;
#pragma unroll
                for (int cb = 0; cb < 4; ++cb)
#pragma unroll
                    for (int r = 0; r < 16; ++r) o[cb][r] *= f;
            }
            float ps = 0.f;
#pragma unroll
            for (int kb2 = 0; kb2 < 2; ++kb2)
#pragma unroll
                for (int r = 0; r < 16; ++r) { const float p = fexp2(s[kb2][r]); s[kb2][r] = p; ps += p; }
            l += ps;
            pf[0] = pack_p(s[0], 0); pf[1] = pack_p(s[0], 1); pf[2] = pack_p(s[1], 0); pf[3] = pack_p(s[1], 1);
            if (comp == 0) A_PV(kt);
        }
        { const int lastt = NT - 1 < kt + 2 ? NT - 1 : kt + 2; const int ahead = lastt - (kt + 1); A_WAITBAR(ahead); }
    }
    if (comp == 1 && NT - 1 < ntw) A_PV(NT - 1);
    __syncthreads();
#undef A_DMA
#undef A_WAITBAR
#undef A_PV
    l += __shfl_xor(l, 32);
    const float inv = 1.0f / l;
    LAS float* X2 = (LAS float*)(lds + 65536);
    if (comp == 1) {
#pragma unroll
        for (int cb = 0; cb < 4; ++cb)
#pragma unroll
            for (int r = 0; r < 16; ++r) X2[((qs * 4 + cb) * 16 + r) * 64 + lane] = o[cb][r] * inv;
    }
    __syncthreads();
    if (comp == 0) {
#pragma unroll
        for (int cb = 0; cb < 4; ++cb)
#pragma unroll
            for (int r = 0; r < 16; ++r) o[cb][r] = o[cb][r] * inv - lam * X2[((qs * 4 + cb) * 16 + r) * 64 + lane];
        subln_store(o, C.a->in[I_SUBG], C.AO + qrow * DM + h * 128, lane);
    }
    __syncthreads();
}

__device__ __forceinline__ void attnB_unit(const P2Ctx& C, int b, int h) {
    LAS unsigned char* lds = C.lds; const int tid = C.tid, lane = C.lane, wid = C.wid;
    const int comp = wid >> 2, q4 = wid & 3, r32 = lane & 31, hi = lane >> 5;
    const LAS float* lut = (const LAS float*)(lds + LUT_OFF) + h * 256;
    const float lam = *(const LAS float*)(lds + LAM_OFF);
    const size_t trow0 = (size_t)(TP + b * DSEQ);
    const float* ck = C.a->in[I_CK]; const float* cv = C.a->in[I_CV];
    { const int c = tid >> 8, row = (tid >> 3) & 31, ch = tid & 7;
      *(LAS u32x4*)(lds + c * 4096 + row * 128 + ((ch ^ ((row >> 1) & 7)) << 4)) = *(const u32x4*)(C.Q + (trow0 + row) * DM + h * 128 + c * 64 + ch * 8); }
    LAS unsigned char* VL = lds + 8192;
    f32x4 vst[4][2];
    const int vkey = (tid >> 4) & 31, vch = tid & 15;
#define B_ISSUEV(it) do { _Pragma("unroll") for (int i_ = 0; i_ < 4; ++i_) { const float* p_ = cv + (((size_t)(b * PAST + (i_ * 16 + (it)) * 32 + vkey)) * 8 + h) * 128 + vch * 8; \
        vst[i_][0] = *(const f32x4*)p_; vst[i_][1] = *(const f32x4*)(p_ + 4); } } while (0)
#define B_WRITEV(st) do { _Pragma("unroll") for (int i_ = 0; i_ < 4; ++i_) \
        *(LAS u32x4*)(VL + ((st) * 4 + i_) * 8192 + ((vkey >> 3) * 4 + (vch >> 2)) * 512 + (vkey & 7) * 64 + (vch & 3) * 16) = pack8(vst[i_][0], vst[i_][1]); } while (0)
    f32x4 kst[4][2];
#define B_ISSUEK(it) do { const float* p_ = ck + ((((size_t)(b * PAST + (q4 * 16 + (it)) * 32 + r32)) * 8 + h) * 2 + comp) * 64 + hi * 8; \
        _Pragma("unroll") for (int ds_ = 0; ds_ < 4; ++ds_) { kst[ds_][0] = *(const f32x4*)(p_ + ds_ * 16); kst[ds_][1] = *(const f32x4*)(p_ + ds_ * 16 + 4); } } while (0)
    f32x16 o[4];
#pragma unroll
    for (int cb = 0; cb < 4; ++cb)
#pragma unroll
        for (int r = 0; r < 16; ++r) o[cb][r] = 0.f;
    float m = -1e30f, l = 0.f;
    B_ISSUEV(0); B_ISSUEK(0); B_WRITEV(0); __syncthreads();
    for (int it = 0; it <= 16; ++it) {
        const bool active = (it < 16) || (q4 == 0);
        bf16x8 kf[4];
        if (it < 16) {
#pragma unroll
            for (int ds = 0; ds < 4; ++ds) kf[ds] = __builtin_bit_cast(bf16x8, pack8(kst[ds][0], kst[ds][1]));
        } else {
#pragma unroll
            for (int ds = 0; ds < 4; ++ds) kf[ds] = *(const bf16x8*)(C.Kb + (trow0 + r32) * DM + h * 128 + comp * 64 + ds * 16 + hi * 8);
        }
        u32x4 vnew = (u32x4){0u, 0u, 0u, 0u};
        if (it + 1 < 16) { B_ISSUEV(it + 1); B_ISSUEK(it + 1); }
        else if (it + 1 == 16) { if (tid < 512) vnew = *(const u32x4*)(C.Vb + (trow0 + vkey) * DM + h * 128 + vch * 8); }
        if (active) {
            const int kpos0 = it < 16 ? (q4 * 16 + it) * 32 : PAST;
            const LAS unsigned char* vimg = VL + ((it & 1) * 4 + (it < 16 ? q4 : 0)) * 8192;
            const int qpos = PAST + r32;
            const bool far = (kpos0 + 31 - PAST + 192 <= 0);
            f32x16 s[1];
            { const float c0 = far ? lut[0] : 0.f;
#pragma unroll
              for (int r = 0; r < 16; ++r) s[0][r] = c0; }
#pragma unroll
            for (int ds = 0; ds < 4; ++ds) { const int ch = 2 * ds + hi;
                const bf16x8 qf = *(const LAS bf16x8*)(lds + comp * 4096 + r32 * 128 + ((ch ^ ((r32 >> 1) & 7)) << 4));
                s[0] = MFMA32(kf[ds], qf, s[0]); }
            if (!far) {
#pragma unroll
                for (int r = 0; r < 16; ++r) { const int rel = kpos0 + crow(r, hi) - qpos; const int idx = rel + 192 > 0 ? rel + 192 : 0; s[0][r] += lut[idx]; }
            }
            const float alpha = softmax_step<1>(s, m, l);
#pragma unroll
            for (int cb = 0; cb < 4; ++cb)
#pragma unroll
                for (int r = 0; r < 16; ++r) o[cb][r] *= alpha;
            const bf16x8 p0 = pack_p(s[0], 0), p1 = pack_p(s[0], 1);
#pragma unroll
            for (int cb = 0; cb < 4; ++cb) { o[cb] = MFMA32(v_frag(vimg, 4, 0, cb, lane), p0, o[cb]); o[cb] = MFMA32(v_frag(vimg, 4, 1, cb, lane), p1, o[cb]); }
        }
        if (it + 1 < 16) { B_WRITEV((it + 1) & 1); }
        else if (it + 1 == 16) { *(LAS u32x4*)(VL + (0 * 4 + 0) * 8192 + ((vkey >> 3) * 4 + (vch >> 2)) * 512 + (vkey & 7) * 64 + (vch & 3) * 16) = vnew; }
        __syncthreads();
    }
#undef B_ISSUEV
#undef B_WRITEV
#undef B_ISSUEK
    l += __shfl_xor(l, 32);
    LAS float* MX = (LAS float*)(lds + 73728);
    if (hi == 0) MX[wid * 32 + r32] = m;
    __syncthreads();
    float M = MX[(comp * 4 + 0) * 32 + r32];
#pragma unroll
    for (int j = 1; j < 4; ++j) M = fmaxf(M, MX[(comp * 4 + j) * 32 + r32]);
    const float f = fexp2(m - M);
    l *= f;
#pragma unroll
    for (int cb = 0; cb < 4; ++cb)
#pragma unroll
        for (int r = 0; r < 16; ++r) o[cb][r] *= f;
    if (hi == 0) MX[256 + wid * 32 + r32] = l;
    __syncthreads();
    float L = 0.f;
#pragma unroll
    for (int j = 0; j < 4; ++j) L += MX[256 + (comp * 4 + j) * 32 + r32];
    const float inv = 1.0f / L;
    LAS float* R = (LAS float*)(lds + 8192);
#define B_PUT(slot) do { _Pragma("unroll") for (int cb = 0; cb < 4; ++cb) _Pragma("unroll") for (int r = 0; r < 16; ++r) R[(slot) * 4096 + (cb * 16 + r) * 64 + lane] = o[cb][r]; } while (0)
#define B_ADD(slot) do { _Pragma("unroll") for (int cb = 0; cb < 4; ++cb) _Pragma("unroll") for (int r = 0; r < 16; ++r) o[cb][r] += R[(slot) * 4096 + (cb * 16 + r) * 64 + lane]; } while (0)
    if (q4 >= 2) B_PUT(comp * 2 + (q4 - 2));
    __syncthreads();
    if (q4 < 2) B_ADD(comp * 2 + q4);
    __syncthreads();
    if (q4 == 1) B_PUT(comp);
    __syncthreads();
    if (q4 == 0) { B_ADD(comp);
#pragma unroll
        for (int cb = 0; cb < 4; ++cb)
#pragma unroll
            for (int r = 0; r < 16; ++r) o[cb][r] *= inv; }
    __syncthreads();
    if (q4 == 0 && comp == 1) B_PUT(0);
    __syncthreads();
    if (wid == 0) {
#pragma unroll
        for (int cb = 0; cb < 4; ++cb)
#pragma unroll
            for (int r = 0; r < 16; ++r) o[cb][r] -= lam * R[(cb * 16 + r) * 64 + lane];
        subln_store(o, C.a->in[I_SUBG], C.AO + (trow0 + r32) * DM + h * 128, lane);
    }
    __syncthreads();
#undef B_PUT
#undef B_ADD
}

template <bool SAMPLE>
__device__ __forceinline__ void attnC_unit(const P2Ctx& C, int b, int h, int qblk) {
    LAS unsigned char* lds = C.lds; const int tid = C.tid, lane = C.lane, wid = C.wid;
    const int dvh = wid >> 2, qs = wid & 3, r32 = lane & 31, hi = lane >> 5;
    const size_t trow0 = SAMPLE ? (size_t)(TP + b * DSEQ) : (size_t)(b * SEQ + qblk * 128);
    const int nq = SAMPLE ? DSEQ : 128;
    LAS unsigned char* QL = lds + 65536;
#pragma unroll
    for (int i = 0; i < 8; ++i) { const int idx = tid + 512 * i, row = idx >> 5, ch = idx & 31;
        u32x4 v = (u32x4){0u, 0u, 0u, 0u};
        if (row < nq) v = *(const u32x4*)(C.QC + (trow0 + row) * DM + h * 256 + ch * 8);
        *(LAS u32x4*)(QL + row * 512 + (((ch & 16) | ((ch ^ row) & 15)) << 4)) = v; }
    u32x4 kreg[2], vreg[2];
#define C_ISSUE(kt) do { _Pragma("unroll") for (int i_ = 0; i_ < 2; ++i_) { const int idx_ = tid + 512 * i_, key_ = idx_ >> 5, ch_ = idx_ & 31; const int mrow_ = (kt) * 32 + key_; \
        if (SAMPLE) { const float* pk_ = C.a->in[I_CMK] + (((size_t)(b * 256 + mrow_)) * 4 + h) * 256 + ch_ * 8; const float* pv_ = C.a->in[I_CMV] + (((size_t)(b * 256 + mrow_)) * 4 + h) * 256 + ch_ * 8; \
            kreg[i_] = pack8(*(const f32x4*)pk_, *(const f32x4*)(pk_ + 4)); vreg[i_] = pack8(*(const f32x4*)pv_, *(const f32x4*)(pv_ + 4)); } \
        else { kreg[i_] = *(const u32x4*)(C.MK + ((size_t)(b * 256 + mrow_)) * DM + h * 256 + ch_ * 8); vreg[i_] = *(const u32x4*)(C.MV + ((size_t)(b * 256 + mrow_)) * DM + h * 256 + ch_ * 8); } } } while (0)
#define C_WRITE(st) do { LAS unsigned char* sb_ = lds + (st) * 32768; _Pragma("unroll") for (int i_ = 0; i_ < 2; ++i_) { const int idx_ = tid + 512 * i_, key_ = idx_ >> 5, ch_ = idx_ & 31; \
        *(LAS u32x4*)(sb_ + key_ * 512 + (((ch_ & 16) | ((ch_ ^ key_) & 15)) << 4)) = kreg[i_]; \
        *(LAS u32x4*)(sb_ + 16384 + ((key_ >> 3) * 8 + (ch_ >> 2)) * 512 + (key_ & 7) * 64 + (ch_ & 3) * 16) = vreg[i_]; } } while (0)
    f32x16 o[4];
#pragma unroll
    for (int cb = 0; cb < 4; ++cb)
#pragma unroll
        for (int r = 0; r < 16; ++r) o[cb][r] = 0.f;
    float m = -1e30f, l = 0.f;
    const bool active = SAMPLE ? (qs == 0) : true;
    C_ISSUE(0); C_WRITE(0); __syncthreads();
    for (int kt = 0; kt < 8; ++kt) {
        if (kt + 1 < 8) C_ISSUE(kt + 1);
        if (active) {
            const LAS unsigned char* sb = lds + (kt & 1) * 32768;
            f32x16 s[1];
#pragma unroll
            for (int r = 0; r < 16; ++r) s[0][r] = 0.f;
            const int qrow = qs * 32 + r32;
#pragma unroll
            for (int ds = 0; ds < 16; ++ds) { const int ch = 2 * ds + hi;
                const bf16x8 kf = *(const LAS bf16x8*)(sb + r32 * 512 + (((ch & 16) | ((ch ^ r32) & 15)) << 4));
                const bf16x8 qf = *(const LAS bf16x8*)(QL + qrow * 512 + (((ch & 16) | ((ch ^ qrow) & 15)) << 4));
                s[0] = MFMA32(kf, qf, s[0]); }
            const float alpha = softmax_step<1>(s, m, l);
#pragma unroll
            for (int cb = 0; cb < 4; ++cb)
#pragma unroll
                for (int r = 0; r < 16; ++r) o[cb][r] *= alpha;
            const bf16x8 p0 = pack_p(s[0], 0), p1 = pack_p(s[0], 1);
#pragma unroll
            for (int cb = 0; cb < 4; ++cb) { o[cb] = MFMA32(v_frag(sb + 16384, 8, 0, dvh * 4 + cb, lane), p0, o[cb]); o[cb] = MFMA32(v_frag(sb + 16384, 8, 1, dvh * 4 + cb, lane), p1, o[cb]); }
        }
        if (kt + 1 < 8) C_WRITE((kt + 1) & 1);
        __syncthreads();
    }
#undef C_ISSUE
#undef C_WRITE
    if (active) {
        l += __shfl_xor(l, 32);
        const float inv = 1.0f / l;
        bf16_t* dst = C.CO + (trow0 + qs * 32 + r32) * DM + h * 256 + dvh * 128;
#pragma unroll
        for (int cb = 0; cb < 4; ++cb)
#pragma unroll
            for (int g = 0; g < 4; ++g) { const int dv0 = 32 * cb + 8 * g + 4 * hi;
                u32x2 w; w.x = pk_bf16(o[cb][4 * g + 0] * inv, o[cb][4 * g + 1] * inv); w.y = pk_bf16(o[cb][4 * g + 2] * inv, o[cb][4 * g + 3] * inv);
                *(u32x2*)(dst + dv0) = w; }
    }
    __syncthreads();
}

__device__ __forceinline__ void lru_unit(const P2Ctx& C, int sg, int n) {
    LAS unsigned char* lds = C.lds; const int tid = C.tid, lane = C.lane, wid = C.wid;
    CArgs& a = *C.a;
    const bool smp = sg >= 8; const int b = smp ? sg - 8 : sg; const int S = smp ? DSEQ : SEQ; const size_t t0 = smp ? (size_t)(TP + b * DSEQ) : (size_t)(b * SEQ);
    LAS unsigned char* XC = lds;
    LAS float* AA = (LAS float*)(lds + 16384);
    LAS float* UU = (LAS float*)(lds + 49152);
    LAS float* SEG = (LAS float*)(lds + 81920);
    LAS float* CAR = (LAS float*)(lds + 86016);
    const int r32 = lane & 31, hi = lane >> 5, chb = wid & 3, tkb = wid >> 2;
    const int chl = chb * 32 + r32, chg = n * 128 + chl;
    const float ba = a.in[I_BRGA][chg], bx = a.in[I_BRGX][chg];
    const float sp8 = 8.0f * log1pf(expf(-a.in[I_RGL][chg]));
    const int cg = tid & 15;
    if (tid < 128) CAR[tid] = smp ? a.in[I_SLRU][b * 1024 + n * 128 + tid] : 0.f;
    const int nchunks = (S + 63) / 64;
    for (int ck = 0; ck < nchunks; ++ck) {
#pragma unroll
        for (int i = 0; i < 2; ++i) { const int tok = (tid >> 4) + 32 * i, tt = ck * 64 + tok;
            float xc[8];
            { const float* cbp = a.in[I_CONVB] + n * 128 + cg * 8; const f32x4 c0 = *(const f32x4*)cbp, c1 = *(const f32x4*)(cbp + 4);
              xc[0] = c0[0]; xc[1] = c0[1]; xc[2] = c0[2]; xc[3] = c0[3]; xc[4] = c1[0]; xc[5] = c1[1]; xc[6] = c1[2]; xc[7] = c1[3]; }
#pragma unroll
            for (int j = 0; j < 4; ++j) { const int ts = tt - 3 + j; float x[8]; float cw[8];
                { const float* cwp = a.in[I_CONVW] + j * 1024 + n * 128 + cg * 8; const f32x4 c0 = *(const f32x4*)cwp, c1 = *(const f32x4*)(cwp + 4);
                  cw[0] = c0[0]; cw[1] = c0[1]; cw[2] = c0[2]; cw[3] = c0[3]; cw[4] = c1[0]; cw[5] = c1[1]; cw[6] = c1[2]; cw[7] = c1[3]; }
                if (ts >= 0 && ts < S) { const u32x4 w = *(const u32x4*)(C.XB + (t0 + ts) * DM + n * 128 + cg * 8); unpack8(w, x); }
                else if (ts < 0 && smp) { const float* p = a.in[I_SCONV] + (size_t)(b * 3 + ts + 3) * DM + n * 128 + cg * 8; const f32x4 p0 = *(const f32x4*)p, p1 = *(const f32x4*)(p + 4);
                    x[0] = p0[0]; x[1] = p0[1]; x[2] = p0[2]; x[3] = p0[3]; x[4] = p1[0]; x[5] = p1[1]; x[6] = p1[2]; x[7] = p1[3]; }
                else {
#pragma unroll
                    for (int e = 0; e < 8; ++e) x[e] = 0.f; }
#pragma unroll
                for (int e = 0; e < 8; ++e) xc[e] += cw[e] * x[e]; }
            u32x4 w; w.x = pk_bf16(xc[0], xc[1]); w.y = pk_bf16(xc[2], xc[3]); w.z = pk_bf16(xc[4], xc[5]); w.w = pk_bf16(xc[6], xc[7]);
            *(LAS u32x4*)(XC + tok * 256 + ((cg ^ (tok & 15)) << 4)) = w; }
        __syncthreads();
        f32x16 da, dx;
#pragma unroll
        for (int r = 0; r < 16; ++r) { da[r] = 0.f; dx[r] = 0.f; }
        { const int tokA = tkb * 32 + r32;
          const bf16_t* wpa = C.WRG + ((size_t)n * 128 + chl) * 128 + hi * 8; const bf16_t* wpx = wpa + (size_t)8 * 128 * 128;
#pragma unroll
          for (int ks = 0; ks < 8; ++ks) { const bf16x8 xf = *(const LAS bf16x8*)(XC + tokA * 256 + (((2 * ks + hi) ^ (tokA & 15)) << 4));
              const bf16x8 wa = *(const bf16x8*)(wpa + ks * 16), wx = *(const bf16x8*)(wpx + ks * 16);
              da = MFMA32(xf, wa, da); dx = MFMA32(xf, wx, dx); } }
#pragma unroll
        for (int r = 0; r < 16; ++r) { const int tokl = tkb * 32 + crow(r, hi);
            const float xcv = bf2f(*(const LAS bf16_t*)(XC + tokl * 256 + ((((chl >> 3)) ^ (tokl & 15)) << 4) + (chl & 7) * 2));
            const float rg = sigmoidf_(da[r] + ba), ig = sigmoidf_(dx[r] + bx);
            const float log_a = -sp8 * rg;
            const float x2 = 2.0f * log_a;
            const float om = x2 > -0.25f ? -x2 * (1.0f + x2 * (0.5f + x2 * (0.16666667f + x2 * (0.041666668f + x2 * 0.0083333333f)))) : 1.0f - fexp2(x2 * LOG2E);
            float av = fexp2(log_a * LOG2E), uv = sqrtf(om) * (ig * xcv);
            if (ck * 64 + tokl >= S) { av = 1.0f; uv = 0.f; }
            AA[tokl * 128 + chl] = av; UU[tokl * 128 + chl] = uv; }
        __syncthreads();
        { const int c = tid & 127, seg = tid >> 7;
          float A = 1.f, B = 0.f;
#pragma unroll
          for (int t = 0; t < 16; ++t) { const int tok = seg * 16 + t; const float av = AA[tok * 128 + c], uv = UU[tok * 128 + c]; B = av * B + uv; A *= av; }
          SEG[(seg * 128 + c) * 2] = A; SEG[(seg * 128 + c) * 2 + 1] = B;
          __syncthreads();
          float hin = CAR[c];
          for (int s = 0; s < seg; ++s) hin = SEG[(s * 128 + c) * 2] * hin + SEG[(s * 128 + c) * 2 + 1];
          float hv = hin;
#pragma unroll
          for (int t = 0; t < 16; ++t) { const int tok = seg * 16 + t, tt = ck * 64 + tok; const float av = AA[tok * 128 + c], uv = UU[tok * 128 + c]; hv = av * hv + uv;
              if (tt < S) { const size_t off = (t0 + tt) * DM + n * 128 + c; const float gg = bf2f(C.GG[off]);
                  C.BO[off] = (bf16_t)(pk_bf16(hv * gg, 0.f) & 0xffffu); } }
          __syncthreads();
          if (seg == 3) CAR[c] = hv; }
    }
    __syncthreads();
    if (tid < 128) a.out[(smp ? O_HS : O_HP) + (size_t)b * 1024 + n * 128 + tid] = CAR[tid];
    __syncthreads();
}


__device__ __forceinline__ void lru_unit_p(const P2Ctx& C, int b, int n, int chq) {
    LAS unsigned char* lds = C.lds; const int tid = C.tid, lane = C.lane, wid = C.wid;
    CArgs& a = *C.a;
    const size_t t0 = (size_t)(b * SEQ);
    LAS unsigned char* XC = lds;
    LAS float* AA = (LAS float*)(lds + 65536);
    LAS float* UU = (LAS float*)(lds + 98304);
    LAS float* SEG = (LAS float*)(lds + EXTRA_OFF + 9216);
    LAS float* CAR = (LAS float*)(lds + EXTRA_OFF + 13312);
    const int r32 = lane & 31, hi = lane >> 5;
    const int chl = chq * 32 + r32, chg = n * 128 + chl;
    const bf16_t* wpa = C.WRG + ((size_t)n * 128 + chl) * 128 + hi * 8; const bf16_t* wpx = wpa + (size_t)8 * 128 * 128;
    const float ba = a.in[I_BRGA][chg], bx = a.in[I_BRGX][chg];
    const float sp8 = 8.0f * log1pf(expf(-a.in[I_RGL][chg]));
    const int cg = tid & 15, run = tid >> 4;
    if (tid < 32) CAR[tid] = 0.f;
    for (int ck = 0; ck < 8; ++ck) {
        { float cw[4][8], cb8[8];
          { const float* cbp = a.in[I_CONVB] + n * 128 + cg * 8; const f32x4 c0 = *(const f32x4*)cbp, c1 = *(const f32x4*)(cbp + 4);
            cb8[0] = c0[0]; cb8[1] = c0[1]; cb8[2] = c0[2]; cb8[3] = c0[3]; cb8[4] = c1[0]; cb8[5] = c1[1]; cb8[6] = c1[2]; cb8[7] = c1[3]; }
#pragma unroll
          for (int j = 0; j < 4; ++j) { const float* cwp = a.in[I_CONVW] + j * 1024 + n * 128 + cg * 8; const f32x4 c0 = *(const f32x4*)cwp, c1 = *(const f32x4*)(cwp + 4);
              cw[j][0] = c0[0]; cw[j][1] = c0[1]; cw[j][2] = c0[2]; cw[j][3] = c0[3]; cw[j][4] = c1[0]; cw[j][5] = c1[1]; cw[j][6] = c1[2]; cw[j][7] = c1[3]; }
#pragma unroll
          for (int sr = 0; sr < 2; ++sr) { const int tk0 = run * 8 + sr * 4, tt0 = ck * 256 + tk0;
              u32x4 rows[7];
#pragma unroll
              for (int i = 0; i < 7; ++i) { const int ts = tt0 - 3 + i; rows[i] = ts >= 0 ? *(const u32x4*)(C.XB + (t0 + ts) * DM + n * 128 + cg * 8) : (u32x4){0u, 0u, 0u, 0u}; }
              float xc[4][8];
#pragma unroll
              for (int t = 0; t < 4; ++t)
#pragma unroll
                  for (int e = 0; e < 8; ++e) xc[t][e] = cb8[e];
#pragma unroll
              for (int i = 0; i < 7; ++i) { float x[8]; unpack8(rows[i], x);
#pragma unroll
                  for (int j = 0; j < 4; ++j) { const int t = i - j;
                      if (t >= 0 && t < 4) {
#pragma unroll
                          for (int e = 0; e < 8; ++e) xc[t][e] += cw[j][e] * x[e]; } } }
#pragma unroll
              for (int t = 0; t < 4; ++t) { const int tok = tk0 + t; u32x4 w; w.x = pk_bf16(xc[t][0], xc[t][1]); w.y = pk_bf16(xc[t][2], xc[t][3]); w.z = pk_bf16(xc[t][4], xc[t][5]); w.w = pk_bf16(xc[t][6], xc[t][7]);
                  *(LAS u32x4*)(XC + tok * 256 + ((cg ^ (tok & 15)) << 4)) = w; } } }
        bf16x8 wa[8], wx[8];
#pragma unroll
        for (int ks = 0; ks < 8; ++ks) { wa[ks] = *(const bf16x8*)(wpa + ks * 16); wx[ks] = *(const bf16x8*)(wpx + ks * 16); }
        __syncthreads();
        f32x16 da, dx;
#pragma unroll
        for (int r = 0; r < 16; ++r) { da[r] = 0.f; dx[r] = 0.f; }
        { const int tokA = wid * 32 + r32;
#pragma unroll
          for (int ks = 0; ks < 8; ++ks) { const bf16x8 xf = *(const LAS bf16x8*)(XC + tokA * 256 + (((2 * ks + hi) ^ (tokA & 15)) << 4));
              da = MFMA32(xf, wa[ks], da); dx = MFMA32(xf, wx[ks], dx); } }
#pragma unroll
        for (int r = 0; r < 16; ++r) { const int tokl = wid * 32 + crow(r, hi);
            const float xcv = bf2f(*(const LAS bf16_t*)(XC + tokl * 256 + (((chl >> 3) ^ (tokl & 15)) << 4) + (chl & 7) * 2));
            const float rg = sigmoidf_(da[r] + ba), ig = sigmoidf_(dx[r] + bx);
            const float log_a = -sp8 * rg;
            const float x2 = 2.0f * log_a;
            const float om = x2 > -0.25f ? -x2 * (1.0f + x2 * (0.5f + x2 * (0.16666667f + x2 * (0.041666668f + x2 * 0.0083333333f)))) : 1.0f - fexp2(x2 * LOG2E);
            AA[tokl * 32 + r32] = fexp2(log_a * LOG2E); UU[tokl * 32 + r32] = sqrtf(om) * (ig * xcv); }
        __syncthreads();
        { const int c = tid & 31, seg = tid >> 5;
          const size_t off0 = (t0 + ck * 256 + seg * 16) * DM + n * 128 + chq * 32 + c;
          bf16_t gg[16];
#pragma unroll
          for (int t = 0; t < 16; ++t) gg[t] = C.GG[off0 + (size_t)t * DM];
          float A = 1.f, B = 0.f;
#pragma unroll
          for (int t = 0; t < 16; ++t) { const int tok = seg * 16 + t; const float av = AA[tok * 32 + c], uv = UU[tok * 32 + c]; B = av * B + uv; A *= av; }
          SEG[(seg * 32 + c) * 2] = A; SEG[(seg * 32 + c) * 2 + 1] = B;
          __syncthreads();
          float hin = CAR[c];
          for (int s = 0; s < seg; ++s) hin = SEG[(s * 32 + c) * 2] * hin + SEG[(s * 32 + c) * 2 + 1];
          float hv = hin;
#pragma unroll
          for (int t = 0; t < 16; ++t) { const int tok = seg * 16 + t; const float av = AA[tok * 32 + c], uv = UU[tok * 32 + c]; hv = av * hv + uv;
              C.BO[off0 + (size_t)t * DM] = (bf16_t)(pk_bf16(hv * bf2f(gg[t]), 0.f) & 0xffffu); }
          __syncthreads();
          if (seg == 15) CAR[c] = hv; }
    }
    __syncthreads();
    if (tid < 32) a.out[O_HP + (size_t)b * 1024 + n * 128 + chq * 32 + tid] = CAR[tid];
    __syncthreads();
}

constexpr int P2_N_LRU_P = 256, P2_N_B = 128, P2_N_A = 1024, P2_N_CP = 512, P2_N_CS = 64, P2_N_LRU_S = 128;
constexpr int P2_NITEMS = P2_N_LRU_P + P2_N_B + P2_N_A + P2_N_CP + P2_N_CS + P2_N_LRU_S;
__device__ __forceinline__ void p2_mixers(CArgs& a0, LAS unsigned char* lds, int tid, int lane, int wid, int rep) {
    CArgs& a = a0;
    unsigned char* ws0 = a.ws;
    { LAS float* lut = (LAS float*)(lds + LUT_OFF);
      for (int e = tid; e < 8 * 256; e += 512) { const int h = e >> 8, rel = (e & 255) - 192; const int nn = rel < 0 ? -rel : rel;
          int bk = nn < 8 ? nn : (nn >= 91 ? 15 : nn >= 64 ? 14 : nn >= 46 ? 13 : nn >= 32 ? 12 : nn >= 23 ? 11 : nn >= 16 ? 10 : nn >= 12 ? 9 : 8);
          if (rel > 0) bk += 16;
          lut[e] = a.in[I_REL][bk * 8 + h] * LOG2E; }
      if (tid < 64) { float d1 = a.in[I_LQ1][tid] * a.in[I_LK1][tid], d2 = a.in[I_LQ2][tid] * a.in[I_LK2][tid]; d1 = wave_sum(d1); d2 = wave_sum(d2);
          if (tid == 0) *(LAS float*)(lds + LAM_OFF) = expf(d1) - expf(d2) + LAMBDA_INIT; } }
    __syncthreads();
    unsigned* queue = (unsigned*)(ws0 + WS_CTL) + CW_QUEUE + 64 * rep;
    volatile LAS unsigned* slot = (volatile LAS unsigned*)(lds + MISC_OFF + 64);
    for (;;) {
        if (tid == 0) *slot = __hip_atomic_fetch_add(queue, 1u, __ATOMIC_RELAXED, __HIP_MEMORY_SCOPE_AGENT);
        __syncthreads();
        int it = (int)*slot;
        __syncthreads();
        if (it >= P2_NITEMS) break;
        int tid_ = tid; asm volatile("" : "+v"(tid_));
        P2Ctx C; C.a = KARGS(); unsigned char* ws = C.a->ws; C.lds = lds; C.tid = tid_; C.lane = tid_ & 63; C.wid = __builtin_amdgcn_readfirstlane(tid_ >> 6);
        C.Q = (const bf16_t*)(ws + WS_Q); C.Kb = (const bf16_t*)(ws + WS_K); C.Vb = (const bf16_t*)(ws + WS_V); C.XB = (const bf16_t*)(ws + WS_XB); C.GG = (const bf16_t*)(ws + WS_GG);
        C.QC = (const bf16_t*)(ws + WS_QC); C.MK = (const bf16_t*)(ws + WS_MK); C.MV = (const bf16_t*)(ws + WS_MV); C.WRG = (const bf16_t*)(ws + WS_WRG);
        C.AO = (bf16_t*)(ws + WS_AO); C.BO = (bf16_t*)(ws + WS_BO); C.CO = (bf16_t*)(ws + WS_CO);
#ifndef UNIT_MASK
#define UNIT_MASK 0xFF
#endif
#ifndef DUPU
#define DUPU 0
#endif
        if (it < P2_N_LRU_P) { if (UNIT_MASK & 1) for (int rp = 0; rp < ((DUPU & 1) ? 2 : 1); ++rp) lru_unit_p(C, it >> 5, (it >> 2) & 7, it & 3); continue; } it -= P2_N_LRU_P;
        if (it < P2_N_B) { if (UNIT_MASK & 2) for (int rp = 0; rp < ((DUPU & 2) ? 2 : 1); ++rp) attnB_unit(C, it >> 3, it & 7); continue; } it -= P2_N_B;
        if (it < P2_N_A) { const int qb = 15 - (it >> 6), bh = it & 63; if (UNIT_MASK & 4) for (int rp = 0; rp < ((DUPU & 4) ? 2 : 1); ++rp) attnA_unit(C, bh >> 3, bh & 7, qb); continue; } it -= P2_N_A;
        if (it < P2_N_CP) { const int qblk = it & 15, bh = it >> 4; if (UNIT_MASK & 8) for (int rp = 0; rp < ((DUPU & 8) ? 2 : 1); ++rp) attnC_unit<false>(C, bh >> 2, bh & 3, qblk); continue; } it -= P2_N_CP;
        if (it < P2_N_CS) { if (UNIT_MASK & 16) attnC_unit<true>(C, it >> 2, it & 3, 0); continue; } it -= P2_N_CS;
        if (UNIT_MASK & 1) lru_unit(C, 8 + (it >> 3), it & 7);
    }
}

__device__ __forceinline__ void p7_final(CArgs& a, int gw, int NGW, int lane) {
    const float* X2 = (const float*)(a.ws + WS_X1);
    const f32x4* gr = (const f32x4*)a.in[I_NFIN] + lane;
    for (int mrow = gw; mrow < TT; mrow += NGW) {
        const f32x4* xr = (const f32x4*)(X2 + (size_t)mrow * DM) + lane;
        f32x4 v[4]; float s = 0.f;
#pragma unroll
        for (int j = 0; j < 4; ++j) { v[j] = xr[64 * j]; s += (v[j].x * v[j].x + v[j].y * v[j].y) + (v[j].z * v[j].z + v[j].w * v[j].w); }
        const float rstd = 1.0f / sqrtf(wave_sum(s) * (1.0f / 1024.0f) + EPS);
        f32x4* o = (f32x4*)(a.out + (mrow < TP ? O_YP + (size_t)mrow * DM : O_YS + (size_t)(mrow - TP) * DM)) + lane;
#pragma unroll
        for (int j = 0; j < 4; ++j) { const f32x4 g = gr[64 * j]; o[64 * j] = v[j] * rstd * g; }
    }
}

constexpr int N_PHASES = 8;
__global__ void __launch_bounds__(NWAVES * 64, 2) fwd_kernel(Args args) {
    __shared__ __attribute__((aligned(16))) unsigned char lds_raw[LDS_BYTES];
    LAS unsigned char* lds = (LAS unsigned char*)lds_raw;
    const int tid = threadIdx.x, lane = tid & 63, wave = __builtin_amdgcn_readfirstlane(tid >> 6);
    const int G = gridDim.x, bx = blockIdx.x;
    const int vcu = (G % 8 == 0) ? (bx % 8) * (G / 8) + bx / 8 : bx;
    const int gw = vcu * NWAVES + wave, NGW = G * NWAVES;
    unsigned char* ws0 = KARGS()->ws;
    unsigned* ctl = (unsigned*)(ws0 + WS_CTL);
    for (int u = tid; u < (LDS_BYTES - EXTRA_OFF) / 4; u += NWAVES * 64) ((LAS unsigned*)(lds + EXTRA_OFF))[u] = 0u;
    __syncthreads();
    XcdBarrier bar; bar.bar = ctl + CW_BAR; bar.x = 0; bar.st = nullptr;
    if (MK_N_LAUNCHES == 1) bar = xcd_barrier_post(ctl + CW_BAR, (volatile LAS unsigned*)(lds + MISC_OFF + 32));
    const int lo = KARGS()->ph_lo, hi = KARGS()->ph_hi;
#ifndef PH_MASK
#define PH_MASK 0xFF
#endif
#define IN(k) (((PH_MASK >> (k)) & 1) && lo <= (k) && (k) < hi)
#define SEAM(k) do { if (IN(k) && IN((k) + 1)) xcd_barrier(bar); } while (0)

#ifndef DUP_MASK
#define DUP_MASK 0
#endif
#define PHASE(k, ...) do { if (IN(k)) { { const int rep_ = 0; (void)rep_; CArgs& args = *KARGS(); unsigned char* ws = args.ws; (void)ws; __VA_ARGS__ } if ((DUP_MASK >> (k)) & 1) { xcd_barrier(bar); { const int rep_ = 1; (void)rep_; CArgs& args = *KARGS(); unsigned char* ws = args.ws; (void)ws; __VA_ARGS__ } } } SEAM(k); } while (0)

    PHASE(0, p0_prologue(args, lds, gw, NGW, wave, lane); );
    PHASE(1,
        Sched1 S{(const char*)(ws + WS_XN), (const char*)(ws + WS_WCAT), G, bx};
        Epi1 E{(bf16_t*)(ws + WS_Q), (bf16_t*)(ws + WS_K), (bf16_t*)(ws + WS_V), (bf16_t*)(ws + WS_XB), (bf16_t*)(ws + WS_GG), (bf16_t*)(ws + WS_QC), (bf16_t*)(ws + WS_G),
               (bf16_t*)(ws + WS_MK), (bf16_t*)(ws + WS_MV), args.out, args.in[I_BGATE]};
        pg8::gemm_phase(lds, 1024, S, E); );
    PHASE(2, p2_mixers(args, lds, tid, lane, wave, rep_); );
    PHASE(3,
        Sched2 S{(const char*)(ws + WS_AO), (const char*)(ws + WS_BO), (const char*)(ws + WS_CO), (const char*)(ws + WS_WP), G, bx};
        Epi2 E{(const bf16_t*)(ws + WS_G), (bf16_t*)(ws + WS_MG)};
        pg8::gemm_phase(lds, 1024, S, E);
        Fin3 F{(bf16_t*)(ws + WS_MG)};
        tail_gemm<3>(lds, (const bf16_t*)(ws + WS_AO), (const bf16_t*)(ws + WS_BO), (const bf16_t*)(ws + WS_CO), (const bf16_t*)(ws + WS_WP), 1024, (const bf16_t*)(ws + WS_G), F, G, bx); );
    PHASE(4,
        SchedT S{(const char*)(ws + WS_MG), (const char*)(ws + WS_WO), 64, 4, 1024, G, bx};
        Epi3 E{args.in[I_XP], args.in[I_XS], (float*)(ws + WS_X1), (bf16_t*)(ws + WS_X1B), (float*)(ws + WS_SS)};
        pg8::gemm_phase(lds, 1024, S, E);
        Fin4 F{args.in[I_XS], (float*)(ws + WS_X1), (bf16_t*)(ws + WS_X1B), (float*)(ws + WS_SS)};
        tail_gemm<1>(lds, (const bf16_t*)(ws + WS_MG), nullptr, nullptr, (const bf16_t*)(ws + WS_WO), 1024, nullptr, F, G, bx); );
    PHASE(5,
        SchedT S{(const char*)(ws + WS_X1B), (const char*)(ws + WS_WFI), 66, 22, 1024, G, bx};
        Epi4 E{(const float*)(ws + WS_SS), (bf16_t*)(ws + WS_ACT)};
        pg8::gemm_phase(lds, 1024, S, E); );
    PHASE(6,
        SchedT S{(const char*)(ws + WS_ACT), (const char*)(ws + WS_WFO), 64, 4, DFF, G, bx};
        Epi5 E{(float*)(ws + WS_X1)};
        pg8::gemm_phase(lds, DFF, S, E);
        Fin6 F{(float*)(ws + WS_X1)};
        tail_gemm<1>(lds, (const bf16_t*)(ws + WS_ACT), nullptr, nullptr, (const bf16_t*)(ws + WS_WFO), DFF, nullptr, F, G, bx); );
    PHASE(7, p7_final(args, gw, NGW, lane); );
#undef PHASE
#undef IN
#undef SEAM
}

extern "C" void kernel_launch(void* const* d_in, const int* in_sizes, int n_in, void* d_out, int out_size, void* d_ws, size_t ws_size, hipStream_t stream) {
    static int grid = 0;
    if (grid == 0) {
        if (n_in != 36 || out_size != (int)O_END || ws_size < WS_END) { fprintf(stderr, "kernel_launch: unexpected problem (n_in %d, out %d, ws %zu); nothing launched\n", n_in, out_size, ws_size); grid = -1; return; }
        int dev = 0, cus = 0;
        if (hipGetDevice(&dev) != hipSuccess || hipDeviceGetAttribute(&cus, hipDeviceAttributeMultiprocessorCount, dev) != hipSuccess) { grid = -1; return; }
        int per_cu = 0;
        if (hipOccupancyMaxActiveBlocksPerMultiprocessor(&per_cu, (const void*)fwd_kernel, NWAVES * 64, 0) != hipSuccess || per_cu < 1)
            fprintf(stderr, "kernel_launch: note: occupancy query reports %d workgroups per CU\n", per_cu);
        (void)hipGetLastError();
        grid = cus;
    }
    if (grid < 0) return;
    (void)hipMemsetAsync((char*)d_ws + WS_CTL, 0, CTL_ZERO_BYTES, stream);
    Args a{};
    for (int i = 0; i < 36; ++i) a.in[i] = (const float*)d_in[i];
    a.out = (float*)d_out; a.ws = (unsigned char*)d_ws;
    if (MK_N_LAUNCHES == 1) { a.ph_lo = 0; a.ph_hi = N_PHASES; a.li = 0; hipLaunchKernelGGL(fwd_kernel, dim3(grid), dim3(NWAVES * 64), 0, stream, a); }
    else for (int li = 0; li < N_PHASES; ++li) { a.ph_lo = li; a.ph_hi = li + 1; a.li = li; hipLaunchKernelGGL(fwd_kernel, dim3(grid), dim3(NWAVES * 64), 0, stream, a); }
}
```
